# Optimizing an MI355X kernel written in HIP

```python
import jax, jax.numpy as jnp
from jax import lax
import numpy as np

D_MODEL = 1024
BATCH = 2
SEQ = 8192
DEPTH = 1

D_MIX = D_MODEL
N_HEADS = 8
N_KV_HEADS = 2
HEAD_DIM = 64
D_ATTN = N_HEADS * HEAD_DIM
D_KV = N_KV_HEADS * HEAD_DIM
WINDOW = 128
BLOCK = 128
D_GMLP = D_MIX - D_ATTN
CHUNK = 128
N_GMLP_GROUPS = 8
GMLP_GROUP_DIM = D_GMLP // N_GMLP_GROUPS
D_IN = D_ATTN + 2 * D_KV + 2 * D_GMLP
N_EXPERTS = 16
CAPACITY_FACTOR = 2
D_FF_EXPERT = 2816
EPS = 1e-6
MASK_VALUE = -1e30

kernel_name = "hymba_ec_hybrid_encoder_block"


def rms_norm(x, g):
    xf = x.astype(jnp.float32)
    y = xf * lax.rsqrt(jnp.mean(xf * xf, axis=-1, keepdims=True) + EPS)
    return (y * g.astype(jnp.float32)).astype(x.dtype)


def layer_norm(x, g, b):
    xf = x.astype(jnp.float32)
    mu = jnp.mean(xf, axis=-1, keepdims=True)
    xc = xf - mu
    y = xc * lax.rsqrt(jnp.mean(xc * xc, axis=-1, keepdims=True) + EPS)
    return (y * g.astype(jnp.float32) + b.astype(jnp.float32)).astype(x.dtype)


def modulate(h, shift, scale):
    return h * (1 + scale[:, None, :]) + shift[:, None, :]


def alibi_slopes(n):
    return jnp.exp2(-8.0 * jnp.arange(1, n + 1, dtype=jnp.float32) / n)


def windowed_gqa(q, k, v, sink):
    b, s = q.shape[:2]
    nb = s // BLOCK
    g = N_HEADS // N_KV_HEADS
    qb = q.reshape(b, nb, BLOCK, N_KV_HEADS, g, HEAD_DIM)

    def band(t):
        tp = jnp.pad(t, ((0, 0), (BLOCK, BLOCK), (0, 0), (0, 0)))
        tp = tp.reshape(b, nb + 2, BLOCK, N_KV_HEADS, HEAD_DIM)
        return jnp.concatenate([tp[:, :-2], tp[:, 1:-1], tp[:, 2:]], axis=2)

    kb, vb = band(k), band(v)
    scores = jnp.einsum('bnqkgd,bnskd->bnkgqs', qb, kb).astype(jnp.float32) * (HEAD_DIM ** -0.5)
    blk = jnp.arange(nb)[:, None] * BLOCK
    q_pos = blk + jnp.arange(BLOCK)[None, :]
    k_pos = blk - BLOCK + jnp.arange(3 * BLOCK)[None, :]
    dist = jnp.abs(q_pos[:, :, None] - k_pos[:, None, :])
    valid = (dist <= WINDOW) & (k_pos[:, None, :] >= 0) & (k_pos[:, None, :] < s)
    slopes = alibi_slopes(N_HEADS).reshape(N_KV_HEADS, g)
    scores = scores - slopes[:, :, None, None] * dist[None, :, None, None].astype(jnp.float32)
    scores = jnp.where(valid[None, :, None, None], scores, MASK_VALUE)
    sink_l = sink.astype(jnp.float32).reshape(N_KV_HEADS, g)[:, :, None]
    m = jnp.maximum(scores.max(axis=-1), sink_l)
    p = jnp.exp(scores - m[..., None])
    denom = p.sum(axis=-1) + jnp.exp(sink_l - m)
    probs = (p / denom[..., None]).astype(v.dtype)
    out = jnp.einsum('bnkgqs,bnskd->bnqkgd', probs, vb)
    return out.reshape(b, s, D_ATTN)


def spatial_gating(u, v, ln_g, ln_b, w_s, b_s):
    b, s = v.shape[:2]
    nb = s // CHUNK
    vn = layer_norm(v, ln_g, ln_b).reshape(b, nb, CHUNK, N_GMLP_GROUPS, GMLP_GROUP_DIM)
    z = jnp.einsum('gts,bnsgc->bntgc', w_s, vn) + b_s.T[:, :, None]
    return u * z.reshape(b, s, D_GMLP)


def expert_choice_ffn(h, w_router, w_gate, w_up, w_down):
    b, s, d = h.shape
    cap = CAPACITY_FACTOR * s // N_EXPERTS
    aff = jax.nn.softmax((h @ w_router).astype(jnp.float32), axis=-1)
    gates, idx = lax.top_k(jnp.swapaxes(aff, 1, 2), cap)
    xs = jax.vmap(lambda hb, ib: hb[ib])(h, idx)
    hid = jax.nn.silu(jnp.einsum('becd,edf->becf', xs, w_gate)) * jnp.einsum('becd,edf->becf', xs, w_up)
    out = jnp.einsum('becf,efd->becd', hid, w_down) * gates[..., None].astype(h.dtype)
    return jax.vmap(lambda ob, ib: jnp.zeros((s, d), h.dtype).at[ib.reshape(-1)].add(ob.reshape(-1, d)))(out, idx)


def setup_inputs(seed: int = 0) -> dict:
    key = jax.random.key(seed)
    ks = jax.random.split(key, 24)
    nrm = jax.random.normal
    L, D = DEPTH, D_MODEL
    return {
        "x": nrm(ks[0], (BATCH, SEQ, D), jnp.float32),
        "c": nrm(ks[1], (BATCH, D), jnp.float32),
        "w_ada": nrm(ks[2], (L, D, 6 * D), jnp.float32) * (0.5 * D ** -0.5),
        "b_ada": 0.01 * nrm(ks[3], (L, 6 * D), jnp.float32),
        "norm_pre_mix": 1.0 + 0.1 * nrm(ks[4], (L, D), jnp.float32),
        "norm_post_mix": 1.0 + 0.1 * nrm(ks[5], (L, D), jnp.float32),
        "w_in": nrm(ks[6], (L, D, D_IN), jnp.float32) * D ** -0.5,
        "sink": 0.5 * nrm(ks[7], (L, N_HEADS), jnp.float32),
        "sgu_ln_g": 1.0 + 0.1 * nrm(ks[8], (L, D_GMLP), jnp.float32),
        "sgu_ln_b": 0.01 * nrm(ks[9], (L, D_GMLP), jnp.float32),
        "w_s": nrm(ks[10], (L, N_GMLP_GROUPS, CHUNK, CHUNK), jnp.float32) * CHUNK ** -0.5,
        "b_s": 1.0 + 0.1 * nrm(ks[11], (L, N_GMLP_GROUPS, CHUNK), jnp.float32),
        "norm_out_attn": 1.0 + 0.1 * nrm(ks[12], (L, D_ATTN), jnp.float32),
        "norm_out_gmlp": 1.0 + 0.1 * nrm(ks[13], (L, D_GMLP), jnp.float32),
        "w_out": nrm(ks[14], (L, D_MIX, D), jnp.float32) * D_MIX ** -0.5,
        "norm_pre_ffn": 1.0 + 0.1 * nrm(ks[15], (L, D), jnp.float32),
        "norm_post_ffn": 1.0 + 0.1 * nrm(ks[16], (L, D), jnp.float32),
        "w_router": nrm(ks[17], (L, D, N_EXPERTS), jnp.float32) * D ** -0.5,
        "w_gate": nrm(ks[18], (L, N_EXPERTS, D, D_FF_EXPERT), jnp.float32) * D ** -0.5,
        "w_up": nrm(ks[19], (L, N_EXPERTS, D, D_FF_EXPERT), jnp.float32) * D ** -0.5,
        "w_down": nrm(ks[20], (L, N_EXPERTS, D_FF_EXPERT, D), jnp.float32) * D_FF_EXPERT ** -0.5,
    }


def reference(x, c, w_ada, b_ada, norm_pre_mix, norm_post_mix, w_in, sink, sgu_ln_g, sgu_ln_b,
              w_s, b_s, norm_out_attn, norm_out_gmlp, w_out, norm_pre_ffn, norm_post_ffn,
              w_router, w_gate, w_up, w_down):
    b, s, _ = x.shape
    for l in range(DEPTH):
        mod = jax.nn.silu(c) @ w_ada[l] + b_ada[l]
        shift1, scale1, gate1, shift2, scale2, gate2 = jnp.split(mod, 6, axis=-1)

        h = modulate(rms_norm(x, norm_pre_mix[l]), shift1, scale1)
        proj = h @ w_in[l]
        q, k, v, zg = jnp.split(proj, [D_ATTN, D_ATTN + D_KV, D_ATTN + 2 * D_KV], axis=-1)
        attn = windowed_gqa(q.reshape(b, s, N_HEADS, HEAD_DIM),
                            k.reshape(b, s, N_KV_HEADS, HEAD_DIM),
                            v.reshape(b, s, N_KV_HEADS, HEAD_DIM), sink[l])
        u, vg = jnp.split(jax.nn.gelu(zg), 2, axis=-1)
        gm = spatial_gating(u, vg, sgu_ln_g[l], sgu_ln_b[l], w_s[l], b_s[l])
        mix = jnp.concatenate([rms_norm(attn, norm_out_attn[l]), rms_norm(gm, norm_out_gmlp[l])], axis=-1)
        x = x + gate1[:, None, :] * rms_norm(mix @ w_out[l], norm_post_mix[l])

        h2 = modulate(rms_norm(x, norm_pre_ffn[l]), shift2, scale2)
        y = expert_choice_ffn(h2, w_router[l], w_gate[l], w_up[l], w_down[l])
        x = x + gate2[:, None, :] * rms_norm(y, norm_post_ffn[l])
    return x
```

```cpp
#include <hip/hip_runtime.h>
#include <cstdio>
#include <cstdint>
namespace pg8 {
#define PG8_LAS __attribute__((address_space(3)))
typedef unsigned short bf16_t;
typedef short bf16x8 __attribute__((ext_vector_type(8)));
typedef float f32x4 __attribute__((ext_vector_type(4)));
typedef unsigned u32x4 __attribute__((ext_vector_type(4)));
constexpr int BM = 256, BK = 64, HALF = 128, HTB = HALF * BK * 2  , STAGE_BYTES = 8 * HTB, NXCD = 8, WGM = 8;

__host__ __device__ __forceinline__ int lds_byte(int r, int c) { const int st = (r >> 4) * 2 + (c >> 5), rr = r & 15, cc = c & 31, ob = rr * 64 + cc * 2; return st * 1024 + (ob ^ (((ob >> 9) & 1) << 5)); }
__host__ __device__ __forceinline__ void stage_rc(int b, int& R, int& C) { const int st = b / 1024, sb = b % 1024, swz = sb ^ (((sb >> 9) & 1) << 5); R = (st >> 1) * 16 + swz / 64; C = (st & 1) * 32 + (swz % 64) / 2; }
__host__ __device__ __forceinline__ int perm32(int rho) { const int n = rho >> 4, i = rho & 15; return 8 * (i >> 2) + 4 * n + (i & 3); }

struct Unit { int pm, pn; };
struct Gemm { const bf16_t* A; const bf16_t* Bt; int M, N, K; };

struct StaticOrder {
    int nM, nN, nwg, G, c;
    __host__ __device__ void init(int M, int N, int G_, int c_) { nM = M / BM; nN = N / BM; nwg = nM * nN; G = G_; c = c_; }
    __host__ __device__ bool next(int i, Unit& u) const {
        const long L = (long)i * G + c; if (L >= nwg) return false;
        int wgid = (int)L; { const int q = nwg / NXCD, r = nwg % NXCD, xcd = wgid % NXCD, off = wgid / NXCD; wgid = (xcd < r ? xcd * (q + 1) : r * (q + 1) + (xcd - r) * q) + off; }
        const int nig = WGM * nN, gid = wgid / nig, fm = gid * WGM, gsz = (nM - fm) < WGM ? (nM - fm) : WGM;
        u.pm = fm + ((wgid % nig) % gsz); u.pn = (wgid % nig) / gsz; return true;
    }
    __device__ __forceinline__ void a_ready(const Unit&) const {}
    __device__ __forceinline__ void done(const Unit&) const {}
};


typedef float f32x2_t __attribute__((ext_vector_type(2))); typedef __bf16 bf16x2_t __attribute__((ext_vector_type(2)));
__device__ __forceinline__ unsigned cvtpk(float lo, float hi) { f32x2_t v = {lo, hi}; bf16x2_t b = __builtin_convertvector(v, bf16x2_t); return __builtin_bit_cast(unsigned, b); }
__device__ __forceinline__ bf16_t f2bf1(float f) { return (bf16_t)(cvtpk(f, 0.f) & 0xffffu); }
__device__ __forceinline__ void store8(bf16_t* p, const f32x4 v0, const f32x4 v1) {
    u32x4 w; w.x = cvtpk(v0[0], v0[1]); w.y = cvtpk(v0[2], v0[3]); w.z = cvtpk(v1[0], v1[1]); w.w = cvtpk(v1[2], v1[3]); *(u32x4*)p = w; }
__device__ __forceinline__ float gelu_tanh(float x) {
    const float y = 0.7978845608028654f * (x + 0.044715f * x * x * x);
    return x / (1.f + __expf(-2.f * y));
}
__device__ __forceinline__ float silu_f(float x) { return x / (1.f + __expf(-x)); }

struct MoeOrder {
    int nE, nM, nN, U, G, c;
    __device__ void init(int nE_, int nM_, int nN_, int G_, int c_) { nE = nE_; nM = nM_; nN = nN_; U = nE * nM * nN; G = G_; c = c_; }
    __device__ bool next(int i, Unit& u) const {
        int gl;
        if ((G & 7) == 0 && (U & 7) == 0) { const int x = c & 7, j = c >> 3, per = G >> 3, li = i * per + j, ux = U >> 3; if (li >= ux) return false; gl = x * ux + li; }
        else { const long L = (long)i * G + c; if (L >= U) return false; gl = (int)L; }
        const int per_e = nM * nN, e = gl / per_e, r = gl % per_e;
        u.pm = e * nM + (r % nM); u.pn = e * nN + (r / nM); return true;
    }
    __device__ __forceinline__ void a_ready(const Unit&) const {}
    __device__ __forceinline__ void done(const Unit&) const {}
};

struct EpiProj {
    static constexpr bool PERM = true, AFTER_DRAIN = false;
    bf16_t *q, *k, *vT, *u, *vgT;
    __device__ __forceinline__ void operator()(const f32x4 (&acc)[2][2][4][2], const Unit& un, int wr, int wc, int fr, int fq) const {
        const int row0 = un.pm * BM + wr * 64 + fr, pn = un.pn, cw = wc * 32 + 8 * fq;
        const int b = (un.pm * BM) >> 13;
        if (pn < 2) {
#pragma unroll
            for (int ai = 0; ai < 2; ++ai)
#pragma unroll
                for (int m = 0; m < 4; ++m) { bf16_t* rowp = q + (size_t)(row0 + ai * HALF + m * 16) * 512 + pn * 256 + cw;
#pragma unroll
                    for (int bj = 0; bj < 2; ++bj) store8(rowp + bj * HALF, acc[ai][bj][m][0], acc[ai][bj][m][1]); }
        } else if (pn == 2) {
#pragma unroll
            for (int ai = 0; ai < 2; ++ai)
#pragma unroll
                for (int m = 0; m < 4; ++m) { const int r = row0 + ai * HALF + m * 16, s = r & 8191;
                    store8(k + (size_t)r * 128 + cw, acc[ai][0][m][0], acc[ai][0][m][1]);
#pragma unroll
                    for (int n = 0; n < 2; ++n)
#pragma unroll
                        for (int j = 0; j < 4; ++j) vT[(size_t)(b * 128 + cw + 4 * n + j) * 8192 + s] = f2bf1(acc[ai][1][m][n][j]); }
        } else if (pn < 5) {
#pragma unroll
            for (int ai = 0; ai < 2; ++ai)
#pragma unroll
                for (int m = 0; m < 4; ++m) { bf16_t* rowp = u + (size_t)(row0 + ai * HALF + m * 16) * 512 + (pn - 3) * 256 + cw;
#pragma unroll
                    for (int bj = 0; bj < 2; ++bj) { f32x4 v0 = acc[ai][bj][m][0], v1 = acc[ai][bj][m][1];
#pragma unroll
                        for (int j = 0; j < 4; ++j) { v0[j] = gelu_tanh(v0[j]); v1[j] = gelu_tanh(v1[j]); }
                        store8(rowp + bj * HALF, v0, v1); } }
        } else {
#pragma unroll
            for (int ai = 0; ai < 2; ++ai)
#pragma unroll
                for (int m = 0; m < 4; ++m) { const int r = row0 + ai * HALF + m * 16, s = r & 8191;
#pragma unroll
                    for (int bj = 0; bj < 2; ++bj)
#pragma unroll
                        for (int n = 0; n < 2; ++n)
#pragma unroll
                            for (int j = 0; j < 4; ++j) vgT[(size_t)(b * 512 + (pn - 5) * 256 + bj * HALF + cw + 4 * n + j) * 8192 + s] = f2bf1(gelu_tanh(acc[ai][bj][m][n][j])); }
        }
    }
};

struct EpiF32 {
    static constexpr bool PERM = false, AFTER_DRAIN = false;
    float* C; int ldc;
    __device__ __forceinline__ void operator()(const f32x4 (&acc)[2][2][4][2], const Unit& u, int wr, int wc, int fr, int fq) const {
        const int row0 = u.pm * BM + wr * 64 + fr, col0 = u.pn * BM + wc * 32 + 4 * fq;
#pragma unroll
        for (int ai = 0; ai < 2; ++ai)
#pragma unroll
            for (int m = 0; m < 4; ++m) { float* rowp = C + (size_t)(row0 + ai * HALF + m * 16) * ldc + col0;
#pragma unroll
                for (int bj = 0; bj < 2; ++bj)
#pragma unroll
                    for (int n = 0; n < 2; ++n) *(f32x4*)(rowp + bj * HALF + n * 16) = acc[ai][bj][m][n]; }
    }
};

struct EpiSwiGLU {
    static constexpr bool PERM = true, AFTER_DRAIN = false;
    bf16_t* hid; int nN;
    __device__ __forceinline__ void operator()(const f32x4 (&acc)[2][2][4][2], const Unit& un, int wr, int wc, int fr, int fq) const {
        const int row0 = un.pm * BM + wr * 64 + fr, pnl = un.pn % nN, col0 = pnl * HALF + wc * 32 + 8 * fq;
#pragma unroll
        for (int ai = 0; ai < 2; ++ai)
#pragma unroll
            for (int m = 0; m < 4; ++m) { bf16_t* rowp = hid + (size_t)(row0 + ai * HALF + m * 16) * 2816 + col0;
                f32x4 v0, v1;
#pragma unroll
                for (int j = 0; j < 4; ++j) { v0[j] = silu_f(acc[ai][0][m][0][j]) * acc[ai][1][m][0][j]; v1[j] = silu_f(acc[ai][0][m][1][j]) * acc[ai][1][m][1][j]; }
                store8(rowp, v0, v1); }
    }
};

struct EpiDown {
    static constexpr bool PERM = true, AFTER_DRAIN = false;
    bf16_t* y; int nN;
    __device__ __forceinline__ void operator()(const f32x4 (&acc)[2][2][4][2], const Unit& un, int wr, int wc, int fr, int fq) const {
        const int row0 = un.pm * BM + wr * 64 + fr, pnl = un.pn % nN, col0 = pnl * BM + wc * 32 + 8 * fq;
#pragma unroll
        for (int ai = 0; ai < 2; ++ai)
#pragma unroll
            for (int m = 0; m < 4; ++m) { bf16_t* rowp = y + (size_t)(row0 + ai * HALF + m * 16) * 1024 + col0;
#pragma unroll
                for (int bj = 0; bj < 2; ++bj) store8(rowp + bj * HALF, acc[ai][bj][m][0], acc[ai][bj][m][1]); }
    }
};
template <class Epi, class Sched, bool ALIGN_EPI = false, bool SP2 = false>
__device__ __forceinline__ void gemm_phase(PG8_LAS unsigned char* lds, const Gemm g, const Sched& S, const Epi& E) {
    const int tid = threadIdx.x, wid = __builtin_amdgcn_readfirstlane(tid >> 6), lane = tid & 63, wr = wid >> 2, wc = wid & 3, fr = lane & 15, fq = lane >> 4;
    const int K = g.K, nt = K / BK;
    unsigned voffA[2], voffB[2];
#pragma unroll
    for (int i = 0; i < 2; ++i) { int R, C; stage_rc(tid * 16 + i * 8192, R, C); const int Rb = Epi::PERM ? ((R & ~31) + perm32(R & 31)) : R;
        voffA[i] = (unsigned)(R * K + C) * 2u; voffB[i] = (unsigned)(Rb * K + C) * 2u; }
    const size_t kstep = (size_t)(BK * 2);
    const size_t hstep = (size_t)HALF * K * 2;
    const size_t tstep = 2 * hstep;
    const unsigned ldsw = (unsigned)wid * 1024u;
    const int aoff = lds_byte(wr * 64 + fr, fq * 8), boff = lds_byte(wc * 32 + fr, fq * 8);
#define PG8_SA(b, h) (((b) * 2 + (h)) * HTB)
#define PG8_SB(b, h) ((4 + (b) * 2 + (h)) * HTB)
#define PG8_STAGE(bufoff, gbase, voff) do { _Pragma("unroll") for (int _i = 0; _i < 2; ++_i) \
        __builtin_amdgcn_global_load_lds((const unsigned*)((const char*)(gbase) + (voff)[_i]), (PG8_LAS unsigned*)(lds + (bufoff) + ldsw + _i * 8192), 16, 0, 0); } while (0)
#define PG8_LDA(dst, b, h) do { _Pragma("unroll") for (int m = 0; m < 4; ++m) _Pragma("unroll") for (int k = 0; k < 2; ++k) dst[m][k] = *(const PG8_LAS bf16x8*)(lds + PG8_SA(b, h) + aoff + m * 2048 + k * 1024); } while (0)
#define PG8_LDB(dst, b, h) do { _Pragma("unroll") for (int n = 0; n < 2; ++n) _Pragma("unroll") for (int k = 0; k < 2; ++k) dst[n][k] = *(const PG8_LAS bf16x8*)(lds + PG8_SB(b, h) + boff + n * 2048 + k * 1024); } while (0)
#define PG8_MMA(ai, bj, At, Bt) do { __builtin_amdgcn_s_setprio(1); _Pragma("unroll") for (int m = 0; m < 4; ++m) _Pragma("unroll") for (int n = 0; n < 2; ++n) _Pragma("unroll") for (int k = 0; k < 2; ++k) \
        acc[ai][bj][m][n] = __builtin_amdgcn_mfma_f32_16x16x32_bf16(Bt[n][k], At[m][k], acc[ai][bj][m][n], 0, 0, 0); __builtin_amdgcn_s_setprio(0); } while (0)
#define PG8_WAIT_V(n) asm volatile("s_waitcnt vmcnt(" #n ")" ::: "memory")
#define PG8_WAIT_L(n) asm volatile("s_waitcnt lgkmcnt(" #n ")" ::: "memory")
#define PG8_BAR __builtin_amdgcn_s_barrier()
#define PG8_SCHED __builtin_amdgcn_sched_barrier(0)
    Unit cur, nxt; int ui = 0;
    if (!S.next(0, cur)) return;
    f32x4 acc[2][2][4][2];
#pragma unroll
    for (int a = 0; a < 2; ++a)
#pragma unroll
        for (int b = 0; b < 2; ++b)
#pragma unroll
            for (int m = 0; m < 4; ++m)
#pragma unroll
                for (int n = 0; n < 2; ++n) acc[a][b][m][n] = (f32x4){0.f, 0.f, 0.f, 0.f};
    bf16x8 At[4][2], B0[2][2], B1[2][2];
    const char* cA = (const char*)g.A + (size_t)cur.pm * tstep; const char* cB = (const char*)g.Bt + (size_t)cur.pn * tstep;
    S.a_ready(cur);
    if constexpr (SP2) {
        PG8_STAGE(PG8_SB(0, 0), cB, voffB); PG8_STAGE(PG8_SB(0, 1), cB + hstep, voffB); PG8_STAGE(PG8_SA(0, 0), cA, voffA); PG8_STAGE(PG8_SA(0, 1), cA + hstep, voffA);
        if (wr == 1) PG8_BAR;
        PG8_WAIT_V(2); PG8_BAR;
        PG8_STAGE(PG8_SB(1, 0), cB + kstep, voffB); PG8_STAGE(PG8_SA(1, 0), cA + kstep, voffA); PG8_STAGE(PG8_SB(1, 1), cB + hstep + kstep, voffB);
        PG8_WAIT_V(6); PG8_BAR;
    } else {
        PG8_STAGE(PG8_SB(0, 0), cB, voffB); PG8_STAGE(PG8_SA(0, 0), cA, voffA); PG8_STAGE(PG8_SB(0, 1), cB + hstep, voffB); PG8_STAGE(PG8_SA(0, 1), cA + hstep, voffA);
        if (wr == 1) PG8_BAR;
        PG8_WAIT_V(4); PG8_BAR;
        PG8_STAGE(PG8_SB(1, 0), cB + kstep, voffB); PG8_STAGE(PG8_SA(1, 0), cA + kstep, voffA); PG8_STAGE(PG8_SB(1, 1), cB + hstep + kstep, voffB);
        PG8_WAIT_V(6); PG8_BAR;
    }
    for (;;) {
        const bool has_next = S.next(ui + 1, nxt);
        const char* nA = has_next ? (const char*)g.A + (size_t)nxt.pm * tstep : cA; const char* nB = has_next ? (const char*)g.Bt + (size_t)nxt.pn * tstep : cB;
        for (int t = 0; t < nt; t += 2) {
            const bool last = (t == nt - 2);
            const char* a1 = cA + (size_t)(t + 1) * kstep;
            const char* a2 = last ? nA : cA + (size_t)(t + 2) * kstep; const char* b2 = last ? nB : cB + (size_t)(t + 2) * kstep;
            const char* a3 = a2 + kstep; const char* b3 = b2 + kstep;
            if (last && has_next) S.a_ready(nxt);
            if constexpr (SP2) {
            PG8_LDB(B0, 0, 0); PG8_LDB(B1, 0, 1); PG8_SCHED; PG8_LDA(At, 0, 0); PG8_STAGE(PG8_SA(1, 1), a1 + hstep, voffA);
            PG8_WAIT_V(8); PG8_WAIT_L(0); PG8_BAR; PG8_MMA(0, 0, At, B0); PG8_MMA(0, 1, At, B1); PG8_BAR; PG8_SCHED;
            PG8_LDA(At, 0, 1); PG8_STAGE(PG8_SB(0, 0), b2, voffB); PG8_STAGE(PG8_SB(0, 1), b2 + hstep, voffB); PG8_STAGE(PG8_SA(0, 0), a2, voffA);
            PG8_WAIT_V(8); PG8_WAIT_L(0); PG8_BAR; PG8_MMA(1, 0, At, B0); PG8_MMA(1, 1, At, B1); PG8_BAR; PG8_SCHED;
            PG8_LDB(B0, 1, 0); PG8_LDB(B1, 1, 1); PG8_SCHED; PG8_LDA(At, 1, 0); PG8_STAGE(PG8_SA(0, 1), a2 + hstep, voffA);
            PG8_WAIT_V(8); PG8_WAIT_L(0); PG8_BAR; PG8_MMA(0, 0, At, B0); PG8_MMA(0, 1, At, B1); PG8_BAR; PG8_SCHED;
            PG8_LDA(At, 1, 1); PG8_STAGE(PG8_SB(1, 0), b3, voffB); PG8_STAGE(PG8_SB(1, 1), b3 + hstep, voffB); PG8_STAGE(PG8_SA(1, 0), a3, voffA);
            PG8_WAIT_V(8); PG8_WAIT_L(0); PG8_BAR; PG8_MMA(1, 0, At, B0); PG8_MMA(1, 1, At, B1); PG8_BAR; PG8_SCHED;
            } else {
            PG8_LDB(B0, 0, 0); PG8_SCHED; PG8_LDA(At, 0, 0); PG8_STAGE(PG8_SA(1, 1), a1 + hstep, voffA);
            PG8_WAIT_L(8); PG8_BAR; PG8_WAIT_L(0); PG8_MMA(0, 0, At, B0); PG8_BAR; PG8_SCHED;
            PG8_LDB(B1, 0, 1); PG8_STAGE(PG8_SB(0, 0), b2, voffB);
            PG8_BAR; PG8_WAIT_L(0); PG8_MMA(0, 1, At, B1); PG8_BAR;
            PG8_LDA(At, 0, 1); PG8_STAGE(PG8_SA(0, 0), a2, voffA);
            PG8_BAR; PG8_WAIT_L(0); PG8_MMA(1, 0, At, B0); PG8_BAR; PG8_SCHED;
            PG8_STAGE(PG8_SB(0, 1), b2 + hstep, voffB);
            PG8_WAIT_V(6); PG8_BAR; PG8_MMA(1, 1, At, B1); PG8_BAR;
            PG8_LDB(B0, 1, 0); PG8_SCHED; PG8_LDA(At, 1, 0); PG8_STAGE(PG8_SA(0, 1), a2 + hstep, voffA);
            PG8_WAIT_L(8); PG8_BAR; PG8_WAIT_L(0); PG8_MMA(0, 0, At, B0); PG8_BAR; PG8_SCHED;
            PG8_LDB(B1, 1, 1); PG8_STAGE(PG8_SB(1, 0), b3, voffB);
            PG8_BAR; PG8_WAIT_L(0); PG8_MMA(0, 1, At, B1); PG8_BAR;
            PG8_LDA(At, 1, 1); PG8_STAGE(PG8_SA(1, 0), a3, voffA);
            PG8_BAR; PG8_WAIT_L(0); PG8_MMA(1, 0, At, B0); PG8_BAR; PG8_SCHED;
            PG8_STAGE(PG8_SB(1, 1), b3 + hstep, voffB);
            PG8_WAIT_V(6); PG8_BAR; PG8_MMA(1, 1, At, B1); PG8_BAR;
            }
        }
        if constexpr (ALIGN_EPI) { if (wr == 0) PG8_BAR; }
        if constexpr (!Epi::AFTER_DRAIN) { E(acc, cur, wr, wc, fr, fq); S.done(cur); }
        if (!has_next) break;
#pragma unroll
        for (int a = 0; a < 2; ++a)
#pragma unroll
            for (int b = 0; b < 2; ++b)
#pragma unroll
                for (int m = 0; m < 4; ++m)
#pragma unroll
                    for (int n = 0; n < 2; ++n) acc[a][b][m][n] = (f32x4){0.f, 0.f, 0.f, 0.f};
        cur = nxt; cA = nA; cB = nB; ++ui;
        if constexpr (ALIGN_EPI) { if (wr == 1) PG8_BAR; }
    }
    PG8_WAIT_V(0);
    if constexpr (!ALIGN_EPI) { if (wr == 0) PG8_BAR; }
    PG8_BAR;
    if constexpr (Epi::AFTER_DRAIN) { E.fused(acc, cur, wr, wc, fr, fq, lds, wid, lane); S.done(cur); }
#undef PG8_SA
#undef PG8_SB
#undef PG8_STAGE
#undef PG8_LDA
#undef PG8_LDB
#undef PG8_MMA
#undef PG8_WAIT_V
#undef PG8_WAIT_L
#undef PG8_BAR
#undef PG8_SCHED
}
}
#define GAS __attribute__((address_space(1)))
#define LAS __attribute__((address_space(3)))
typedef unsigned short bf16;
typedef unsigned v4u __attribute__((ext_vector_type(4)));
typedef float f32x4 __attribute__((ext_vector_type(4)));
typedef short bf16x8 __attribute__((ext_vector_type(8)));
typedef GAS unsigned gu32;
typedef GAS unsigned long long gu64;
#define RLX_AGENT __ATOMIC_RELAXED, __HIP_MEMORY_SCOPE_AGENT
#define LDS_WAIT() asm volatile("s_waitcnt lgkmcnt(0)" ::: "memory")
#define VM_WAIT() asm volatile("s_waitcnt vmcnt(0)" ::: "memory")
__device__ __forceinline__ unsigned long long rt() { return __builtin_amdgcn_s_memrealtime(); }
__device__ __forceinline__ unsigned f2bf(float f) { unsigned u = __builtin_bit_cast(unsigned, f); return (u + 0x7fffu + ((u >> 16) & 1u)) >> 16; }
__device__ __forceinline__ unsigned pk2(float lo, float hi) { return f2bf(lo) | (f2bf(hi) << 16); }

#define XB_TMO      128
#define XB_XCNT(j)  (256  + 64 * (j))
#define XB_XSUB(j)  (1280 + 64 * (j))
#define XB_XGEN(j)  (2304 + 64 * (j))
#define XB_TOP      3328
#define XB_TOPGEN   3392
#define XCD_BAR_WORDS 3456
#define XB_SPIN_CAP (1u << 18)

__device__ __forceinline__ unsigned xb_ld(unsigned* p)              { return __hip_atomic_load(p, __ATOMIC_RELAXED, __HIP_MEMORY_SCOPE_AGENT); }
__device__ __forceinline__ unsigned xb_add(unsigned* p, unsigned v) { return __hip_atomic_fetch_add(p, v, __ATOMIC_RELAXED, __HIP_MEMORY_SCOPE_AGENT); }
__device__ __forceinline__ unsigned xb_xcc_id() { return (unsigned)__builtin_amdgcn_s_getreg((3 << 11) | 20) & 0xFu; }
#define XB_SPIN(cond, bar) do { unsigned _sp = 0; while (cond) { __builtin_amdgcn_s_sleep(1); \
    if ((++_sp & 255u) == 0u) { if (xb_ld(&(bar)[XB_TMO])) break; if (_sp > XB_SPIN_CAP) { atomicAdd(&(bar)[XB_TMO], 1u); break; } } } } while (0)

struct XcdBarrier {
    unsigned* bar; unsigned x;
    volatile LAS unsigned* st;
};

__device__ __forceinline__ XcdBarrier xcd_barrier_post(unsigned* bar, volatile LAS unsigned* st) {
    XcdBarrier b; b.bar = bar; b.x = xb_xcc_id(); b.st = st;
    if (threadIdx.x == 0) (void)xb_add(&bar[XB_XCNT(b.x)], 1u);
    return b;
}
__device__ __forceinline__ void xcd_barrier_complete(unsigned* bar, unsigned x, unsigned& nloc, unsigned& nx) {
    const unsigned G = gridDim.x * gridDim.y * gridDim.z;
    unsigned sum, cnt, mine, sp = 0u;
    for (;;) {
        sum = 0u; cnt = 0u; mine = 0u;
#pragma unroll
        for (unsigned j = 0; j < 16; ++j) { const unsigned c = xb_ld(&bar[XB_XCNT(j)]); sum += c; cnt += (c > 0u) ? 1u : 0u; mine = (j == x) ? c : mine; }
        if (sum == G) break;
        __builtin_amdgcn_s_sleep(1);
        if ((++sp & 255u) == 0u) { if (xb_ld(&bar[XB_TMO])) break; if (sp > XB_SPIN_CAP) { atomicAdd(&bar[XB_TMO], 1u); break; } }
    }
    nloc = mine > 0u ? mine : 1u; nx = cnt > 0u ? cnt : 1u;
}

__device__ __forceinline__ void xcd_barrier(const XcdBarrier& b) {
    asm volatile("s_waitcnt vmcnt(0)" ::: "memory");
    __syncthreads();
    if (threadIdx.x == 0) {
        unsigned* bar = b.bar;
        __builtin_amdgcn_s_waitcnt(0);
        unsigned nloc = b.st[0], nx = b.st[1];
        if (nloc == 0u) { xcd_barrier_complete(bar, b.x, nloc, nx); b.st[0] = nloc; b.st[1] = nx; }
        const unsigned old = xb_add(&bar[XB_XSUB(b.x)], 1u);
        const unsigned gen = old / nloc;
        if (old + 1u == (gen + 1u) * nloc) {
            __builtin_amdgcn_fence(__ATOMIC_RELEASE, "agent");
            asm volatile("s_waitcnt vmcnt(0)" ::: "memory");
            const unsigned og = xb_add(&bar[XB_TOP], 1u);
            const unsigned tg = og / nx;
            if (og + 1u == (tg + 1u) * nx) xb_add(&bar[XB_TOPGEN], 1u);
            else XB_SPIN(xb_ld(&bar[XB_TOPGEN]) == tg, bar);
            __builtin_amdgcn_fence(__ATOMIC_ACQUIRE, "agent");
            xb_add(&bar[XB_XGEN(b.x)], 1u);
            asm volatile("s_waitcnt vmcnt(0)" ::: "memory");
        } else {
            XB_SPIN(xb_ld(&bar[XB_XGEN(b.x)]) == gen, bar);
            __builtin_amdgcn_fence(__ATOMIC_ACQUIRE, "agent");
            asm volatile("s_waitcnt vmcnt(0)" ::: "memory");
        }
    }
    __syncthreads();
}

constexpr int NWAVES = 8;
constexpr int BATCH = 2, SEQ = 8192, DM = 1024, NTOK = BATCH * SEQ;
constexpr int D_IN = 1792, D_FF = 2816, NEXP = 16, CAP = 1024;
constexpr int NROWS_E = NEXP * BATCH * CAP;
constexpr float EPS = 1e-6f;
constexpr int KS_ADA = 16;

constexpr size_t MiB = 1u << 20;
constexpr size_t WS_CTL = 0, CTL_ZERO_BYTES = 1 * MiB;
constexpr size_t WS_MODP = 1 * MiB;
constexpr size_t WS_AFF = 2 * MiB;
constexpr size_t WS_SLOTS = 3 * MiB;
constexpr size_t WS_IDX = 4 * MiB;
constexpr size_t WS_GATES = 4 * MiB + 128 * 1024;
constexpr size_t WS_WSB = 4 * MiB + 256 * 1024;
constexpr size_t WS_WINT = 5 * MiB;
constexpr size_t WS_WOUTT = 9 * MiB;
constexpr size_t WS_WGUT = 12 * MiB;
constexpr size_t WS_WDT = 188 * MiB;
constexpr size_t WS_H = 276 * MiB;
constexpr size_t WS_YROWS = 308 * MiB;
constexpr size_t WS_HID = 372 * MiB;
constexpr size_t WS_Q = 372 * MiB;
constexpr size_t WS_K = 388 * MiB;
constexpr size_t WS_VT = 392 * MiB;
constexpr size_t WS_U = 396 * MiB;
constexpr size_t WS_VGT = 412 * MiB;
constexpr size_t WS_MIX = 428 * MiB;
constexpr size_t WS_T = 460 * MiB;
constexpr size_t WS_XS = 548 * MiB;
constexpr size_t WS_END = 612 * MiB;
constexpr int CW_BAR = 4096;

constexpr int RING_OFF = 0, RING_BYTES = 131072;
constexpr int LDSCTL_OFF = RING_BYTES, MISC_OFF = LDSCTL_OFF + 320;
constexpr int LDS_BYTES = 147456;

struct Frame {
    LAS unsigned char* lds;
    volatile LAS unsigned* MISC;
    gu32* ctl;
    int tid, lane, wave;
    int vcu, G;
    const float* in[21];
    float* out;
    unsigned char* ws;
};
#define IN_X 0
#define IN_C 1
#define IN_WADA 2
#define IN_BADA 3
#define IN_NPREMIX 4
#define IN_NPOSTMIX 5
#define IN_WIN 6
#define IN_SINK 7
#define IN_LNG 8
#define IN_LNB 9
#define IN_WS 10
#define IN_BS 11
#define IN_NOATTN 12
#define IN_NOGMLP 13
#define IN_WOUT 14
#define IN_NPREFFN 15
#define IN_NPOSTFFN 16
#define IN_WROUTER 17
#define IN_WGATE 18
#define IN_WUP 19
#define IN_WDOWN 20

__device__ __forceinline__ float wave_sum(float v) {
#pragma unroll
    for (int o = 1; o < 64; o <<= 1) v += __shfl_xor(v, o);
    return v;
}
__device__ __forceinline__ float wave_max(float v) {
#pragma unroll
    for (int o = 1; o < 64; o <<= 1) v = fmaxf(v, __shfl_xor(v, o));
    return v;
}
__device__ __forceinline__ float bf2f(unsigned short b) { return __uint_as_float((unsigned)b << 16); }
__device__ __forceinline__ float bflo(unsigned u) { return __uint_as_float(u << 16); }
__device__ __forceinline__ float bfhi(unsigned u) { return __uint_as_float(u & 0xffff0000u); }

__device__ __forceinline__ void transpose_item(const float* W, int N, int k0, int n0, bf16* WT, int ldt, int dest_row0, LAS float* scr, int lane) {
#pragma unroll 8
    for (int i = 0; i < 32; ++i) { const int kk = 2 * i + (lane >> 5); scr[kk * 33 + (lane & 31)] = W[(size_t)(k0 + kk) * N + n0 + (lane & 31)]; }
    LDS_WAIT(); asm volatile("" ::: "memory");
    const int c = lane & 7;
#pragma unroll
    for (int j = 0; j < 4; ++j) { const int n = (lane >> 3) + 8 * j; const LAS float* s = scr + (8 * c) * 33 + n;
        v4u o; o.x = pk2(s[0 * 33], s[1 * 33]); o.y = pk2(s[2 * 33], s[3 * 33]); o.z = pk2(s[4 * 33], s[5 * 33]); o.w = pk2(s[6 * 33], s[7 * 33]);
        *(GAS v4u*)(WT + (size_t)(dest_row0 + n) * ldt + k0 + 8 * c) = o; }
    LDS_WAIT(); asm volatile("" ::: "memory");
}

__device__ __forceinline__ void p0_prologue(Frame& F) {
    LAS float* scr = (LAS float*)(F.lds + RING_OFF + F.wave * 16384);
    const int gw = F.vcu * NWAVES + F.wave, NGW = F.G * NWAVES, lane = F.lane;
    {
        const float* c = F.in[IN_C]; const float* W = F.in[IN_WADA]; float* modp = (float*)(F.ws + WS_MODP);
        constexpr int KPS = DM / KS_ADA;
        for (int it = gw; it < 96 * KS_ADA; it += NGW) {
            const int cg = it % 96, ks = it / 96, col = cg * 64 + lane;
            float a0 = 0.f, a1 = 0.f;
#pragma unroll 8
            for (int kk = 0; kk < KPS; ++kk) { const int k = ks * KPS + kk; const float w = W[(size_t)k * 6144 + col];
                const float c0 = c[k], c1 = c[DM + k];
                a0 += (c0 / (1.f + __expf(-c0))) * w; a1 += (c1 / (1.f + __expf(-c1))) * w; }
            modp[(size_t)(ks * 2 + 0) * 6144 + col] = a0; modp[(size_t)(ks * 2 + 1) * 6144 + col] = a1;
        }
    }
    {
        const float* wsf = F.in[IN_WS]; bf16* wsb = (bf16*)(F.ws + WS_WSB);
        for (int i = gw * 64 + lane; i < 8 * 128 * 128 / 4; i += NGW * 64) { const f32x4 v = *(const f32x4*)(wsf + 4 * i);
            *(unsigned long long*)(wsb + 4 * i) = (unsigned long long)pk2(v.x, v.y) | ((unsigned long long)pk2(v.z, v.w) << 32); }
    }
    constexpr int I_IN = (DM / 64) * (D_IN / 32), I_OUT = (DM / 64) * (DM / 32);
    constexpr int I_GE = (DM / 64) * (D_FF / 32);
    constexpr int I_DE = (D_FF / 64) * (DM / 32);
    constexpr int NITEMS = I_IN + I_OUT + NEXP * (2 * I_GE + I_DE);
    for (int it = gw; it < NITEMS; it += NGW) {
        int r = it;
        if (r < I_IN) { const int nb = D_IN / 32, kb = r / nb, n0 = 32 * (r % nb); transpose_item(F.in[IN_WIN], D_IN, 64 * kb, n0, (bf16*)(F.ws + WS_WINT), DM, n0, scr, lane); continue; } r -= I_IN;
        if (r < I_OUT) { const int nb = DM / 32, kb = r / nb, n0 = 32 * (r % nb); transpose_item(F.in[IN_WOUT], DM, 64 * kb, n0, (bf16*)(F.ws + WS_WOUTT), DM, n0, scr, lane); continue; } r -= I_OUT;
        if (r < NEXP * 2 * I_GE) {
            const int e = r / (2 * I_GE), r2 = r % (2 * I_GE), ty = r2 / I_GE, r3 = r2 % I_GE;
            const int nb = D_FF / 32, kb = r3 / nb, n0 = 32 * (r3 % nb);
            const float* W = (ty ? F.in[IN_WUP] : F.in[IN_WGATE]) + (size_t)e * DM * D_FF;
            bf16* WT = (bf16*)(F.ws + WS_WGUT) + (size_t)e * (2 * D_FF) * DM;
            const int drow = (n0 >> 7) * 256 + ty * 128 + (n0 & 127);
            transpose_item(W, D_FF, 64 * kb, n0, WT, DM, drow, scr, lane); continue; }
        r -= NEXP * 2 * I_GE;
        { const int e = r / I_DE, r3 = r % I_DE; const int nb = DM / 32, kb = r3 / nb, n0 = 32 * (r3 % nb);
          const float* W = F.in[IN_WDOWN] + (size_t)e * D_FF * DM; bf16* WT = (bf16*)(F.ws + WS_WDT) + (size_t)e * DM * D_FF;
          transpose_item(W, DM, 64 * kb, n0, WT, D_FF, n0, scr, lane); }
    }
}

__device__ __forceinline__ void mod_to_lds(Frame& F, LAS float* dst, int col0, int ncols) {
    const float* modp = (const float*)(F.ws + WS_MODP); const float* bada = F.in[IN_BADA];
    for (int i = F.tid; i < 2 * ncols; i += NWAVES * 64) { const int b = i / ncols, j = i % ncols; float s = bada[col0 + j];
#pragma unroll
        for (int ks = 0; ks < KS_ADA; ++ks) s += modp[(size_t)(ks * 2 + b) * 6144 + col0 + j];
        dst[i] = s; }
    __syncthreads();
}

__device__ __forceinline__ void p1_prenorm(Frame& F) {
    LAS float* md = (LAS float*)(F.lds + RING_OFF);
    mod_to_lds(F, md, 0, 2048);
    const int gw = F.vcu * NWAVES + F.wave, NGW = F.G * NWAVES, lane = F.lane;
    const float* x = F.in[IN_X]; const float* g = F.in[IN_NPREMIX]; bf16* h = (bf16*)(F.ws + WS_H);
    for (int m = gw; m < NTOK; m += NGW) {
        const int b = m >> 13; const f32x4* xr = (const f32x4*)(x + (size_t)m * DM) + lane;
        f32x4 v[4]; float ss = 0.f;
#pragma unroll
        for (int j = 0; j < 4; ++j) { v[j] = xr[64 * j]; ss += (v[j].x * v[j].x + v[j].y * v[j].y) + (v[j].z * v[j].z + v[j].w * v[j].w); }
        const float rstd = rsqrtf(wave_sum(ss) * (1.f / DM) + EPS);
        unsigned long long* o8 = (unsigned long long*)(h + (size_t)m * DM) + lane;
#pragma unroll
        for (int j = 0; j < 4; ++j) { const int col = 4 * lane + 256 * j; const f32x4 gg = *(const f32x4*)(g + col);
            const f32x4 sh = *(const LAS f32x4*)(md + b * 2048 + col), sc = *(const LAS f32x4*)(md + b * 2048 + 1024 + col);
            const f32x4 r = (v[j] * rstd * gg) * (sc + 1.f) + sh;
            o8[64 * j] = (unsigned long long)pk2(r.x, r.y) | ((unsigned long long)pk2(r.z, r.w) << 32); }
    }
    __syncthreads();
}

__device__ __forceinline__ void p3_attn_naive(Frame& F) {
    const int gw = F.vcu * NWAVES + F.wave, NGW = F.G * NWAVES, lane = F.lane;
    LAS float* scr = (LAS float*)(F.lds + RING_OFF + F.wave * 4096);
    const bf16* q = (const bf16*)(F.ws + WS_Q); const bf16* k = (const bf16*)(F.ws + WS_K); const bf16* vT = (const bf16*)(F.ws + WS_VT);
    bf16* mix = (bf16*)(F.ws + WS_MIX); const float* sink = F.in[IN_SINK]; const float* gn = F.in[IN_NOATTN];
    for (int tok = gw; tok < NTOK; tok += NGW) {
        const int b = tok >> 13, s = tok & 8191; float sumsq = 0.f;
#pragma unroll 1
        for (int hh = 0; hh < 8; ++hh) {
            const int kvh = hh >> 2; const float slope = exp2f(-(float)(hh + 1)), sinkv = sink[hh];
            v4u qv[8];
#pragma unroll
            for (int c = 0; c < 8; ++c) qv[c] = *(const v4u*)(q + (size_t)tok * 512 + hh * 64 + 8 * c);
            float sc[5];
#pragma unroll
            for (int i = 0; i < 5; ++i) { const int j = lane + 64 * i, p = s - 128 + j; const bool valid = (j < 257) && (p >= 0) && (p < SEQ);
                float dot = 0.f;
                if (valid) { const v4u* kp = (const v4u*)(k + (size_t)(b * SEQ + p) * 128 + kvh * 64);
#pragma unroll
                    for (int c = 0; c < 8; ++c) { const v4u kv = kp[c];
                        dot += bflo(qv[c].x) * bflo(kv.x) + bfhi(qv[c].x) * bfhi(kv.x); dot += bflo(qv[c].y) * bflo(kv.y) + bfhi(qv[c].y) * bfhi(kv.y);
                        dot += bflo(qv[c].z) * bflo(kv.z) + bfhi(qv[c].z) * bfhi(kv.z); dot += bflo(qv[c].w) * bflo(kv.w) + bfhi(qv[c].w) * bfhi(kv.w); } }
                const int dist = p > s ? p - s : s - p;
                sc[i] = valid ? dot * 0.125f - slope * (float)dist : -1e30f; }
            float mx = fmaxf(fmaxf(fmaxf(sc[0], sc[1]), fmaxf(sc[2], sc[3])), sc[4]);
            mx = fmaxf(wave_max(mx), sinkv);
            float pr[5]; float ps = 0.f;
#pragma unroll
            for (int i = 0; i < 5; ++i) { pr[i] = __expf(sc[i] - mx); ps += pr[i]; }
            const float denom = wave_sum(ps) + __expf(sinkv - mx);
            const bf16* vrow = vT + (size_t)(b * 128 + kvh * 64 + lane) * SEQ;
            float acc = 0.f;
#pragma unroll
            for (int i = 0; i < 5; ++i) {
                const int jn = (i < 4) ? 64 : 1;
#pragma unroll 4
                for (int jj = 0; jj < jn; ++jj) { const int p = s - 128 + jj + 64 * i; const float pj = __shfl(pr[i], jj);
                    if (p >= 0 && p < SEQ) acc += pj * bf2f(vrow[p]); }
            }
            const float o = acc / denom; scr[hh * 64 + lane] = o; sumsq += o * o;
        }
        const float rstd = rsqrtf(wave_sum(sumsq) * (1.f / 512.f) + EPS);
        LDS_WAIT();
#pragma unroll
        for (int hh = 0; hh < 8; ++hh) mix[(size_t)tok * DM + hh * 64 + lane] = (bf16)(pk2(scr[hh * 64 + lane] * rstd * gn[hh * 64 + lane], 0.f) & 0xffffu);
        LDS_WAIT();
    }
}

__device__ __forceinline__ void p3_gmlp_naive(Frame& F) {
    __syncthreads();
    const int lane = F.lane, w = F.wave;
    LAS float* L = (LAS float*)(F.lds + RING_OFF + 65536);
    LAS float* P1s = L; LAS float* P2s = L + 1024; LAS float* MU = L + 2048; LAS float* RS = L + 2176; LAS float* SQ = L + 2304; LAS float* GM = L + 2432;
    const bf16* vgT = (const bf16*)(F.ws + WS_VGT); const bf16* u = (const bf16*)(F.ws + WS_U); bf16* mix = (bf16*)(F.ws + WS_MIX);
    const float* wsf = F.in[IN_WS]; const float* bs = F.in[IN_BS]; const float* lng = F.in[IN_LNG]; const float* lnb = F.in[IN_LNB]; const float* gn = F.in[IN_NOGMLP];
    for (int unit = F.vcu; unit < BATCH * (SEQ / 128); unit += F.G) {
        const int b = unit >> 6, s0 = (unit & 63) * 128;
        { float a1 = 0.f, a2 = 0.f, c1 = 0.f, c2 = 0.f;
          for (int cc = 0; cc < 64; ++cc) { const bf16* rp = vgT + (size_t)(b * 512 + 64 * w + cc) * SEQ + s0; const float va = bf2f(rp[lane]), vb = bf2f(rp[lane + 64]);
              a1 += va; a2 += va * va; c1 += vb; c2 += vb * vb; }
          P1s[w * 128 + lane] = a1; P2s[w * 128 + lane] = a2; P1s[w * 128 + 64 + lane] = c1; P2s[w * 128 + 64 + lane] = c2; }
        __syncthreads();
        if (F.tid < 128) { float s1 = 0.f, s2 = 0.f;
#pragma unroll
            for (int ww = 0; ww < 8; ++ww) { s1 += P1s[ww * 128 + F.tid]; s2 += P2s[ww * 128 + F.tid]; }
            const float mean = s1 * (1.f / 512.f); float var = s2 * (1.f / 512.f) - mean * mean; var = var < 0.f ? 0.f : var;
            MU[F.tid] = mean; RS[F.tid] = rsqrtf(var + EPS); }
        __syncthreads();
        const int ch = w * 64 + lane; const float lg = lng[ch], lb = lnb[ch];
        float vn[128];
        { const v4u* rp = (const v4u*)(vgT + (size_t)(b * 512 + ch) * SEQ + s0);
#pragma unroll
          for (int c = 0; c < 16; ++c) { const v4u t = rp[c]; const unsigned uu[4] = {t.x, t.y, t.z, t.w};
#pragma unroll
              for (int e = 0; e < 4; ++e) { const int sA = 8 * c + 2 * e;
                  vn[sA] = (bflo(uu[e]) - MU[sA]) * RS[sA] * lg + lb; vn[sA + 1] = (bfhi(uu[e]) - MU[sA + 1]) * RS[sA + 1] * lg + lb; } } }
        for (int tc = 0; tc < 8; ++tc) {
#pragma unroll 1
            for (int tt = 0; tt < 16; ++tt) { const int t = tc * 16 + tt; const float* wr = wsf + (size_t)(w * 128 + t) * 128;
                float z0 = 0.f, z1 = 0.f;
#pragma unroll
                for (int sA = 0; sA < 128; sA += 2) { z0 += wr[sA] * vn[sA]; z1 += wr[sA + 1] * vn[sA + 1]; }
                const float z = (z0 + z1) + bs[w * 128 + t];
                const float gm = bf2f(u[(size_t)(b * SEQ + s0 + t) * 512 + ch]) * z;
                GM[(w * 16 + tt) * 64 + lane] = gm; const float sq = wave_sum(gm * gm); if (lane == 0) SQ[w * 16 + tt] = sq; }
            __syncthreads();
#pragma unroll 1
            for (int tt = 0; tt < 16; ++tt) { const int t = tc * 16 + tt; float sq = 0.f;
#pragma unroll
                for (int ww = 0; ww < 8; ++ww) sq += SQ[ww * 16 + tt];
                const float rstd = rsqrtf(sq * (1.f / 512.f) + EPS);
                mix[(size_t)(b * SEQ + s0 + t) * DM + 512 + ch] = (bf16)(pk2(GM[(w * 16 + tt) * 64 + lane] * rstd * gn[ch], 0.f) & 0xffffu); }
            __syncthreads();
        }
    }
}

__device__ __forceinline__ void p5_postmix(Frame& F) {
    LAS float* md = (LAS float*)(F.lds + RING_OFF);
    LAS float* wrT = (LAS float*)(F.lds + RING_OFF + 32768);
    for (int i = F.tid; i < DM * NEXP; i += NWAVES * 64) { const int col = i >> 4, e = i & 15; wrT[e * DM + col] = F.in[IN_WROUTER][i]; }
    mod_to_lds(F, md, 2048, 3072);
    const int gw = F.vcu * NWAVES + F.wave, NGW = F.G * NWAVES, lane = F.lane;
    const float* x = F.in[IN_X]; const float* t = (const float*)(F.ws + WS_T); const float* g1 = F.in[IN_NPOSTMIX]; const float* g2 = F.in[IN_NPREFFN];
    bf16* h2 = (bf16*)(F.ws + WS_H); float* aff = (float*)(F.ws + WS_AFF);
    for (int m = gw; m < NTOK; m += NGW) {
        const int b = m >> 13, s = m & 8191;
        const f32x4* xr = (const f32x4*)(x + (size_t)m * DM) + lane; const f32x4* tr = (const f32x4*)(t + (size_t)m * DM) + lane;
        f32x4 tv[4], xv[4]; float ss = 0.f;
#pragma unroll
        for (int j = 0; j < 4; ++j) { tv[j] = tr[64 * j]; xv[j] = xr[64 * j]; ss += (tv[j].x * tv[j].x + tv[j].y * tv[j].y) + (tv[j].z * tv[j].z + tv[j].w * tv[j].w); }
        const float rstd1 = rsqrtf(wave_sum(ss) * (1.f / DM) + EPS);
        float ss2 = 0.f; f32x4* orow = (f32x4*)(F.out + (size_t)m * DM) + lane;
#pragma unroll
        for (int j = 0; j < 4; ++j) { const int col = 4 * lane + 256 * j; const f32x4 gg = *(const f32x4*)(g1 + col), ga = *(const LAS f32x4*)(md + b * 3072 + col);
            xv[j] = xv[j] + ga * (tv[j] * rstd1 * gg); orow[64 * j] = xv[j];
            ss2 += (xv[j].x * xv[j].x + xv[j].y * xv[j].y) + (xv[j].z * xv[j].z + xv[j].w * xv[j].w); }
        const float rstd2 = rsqrtf(wave_sum(ss2) * (1.f / DM) + EPS);
        unsigned long long* o8 = (unsigned long long*)(h2 + (size_t)m * DM) + lane;
        f32x4 hv[4];
#pragma unroll
        for (int j = 0; j < 4; ++j) { const int col = 4 * lane + 256 * j; const f32x4 gg = *(const f32x4*)(g2 + col);
            const f32x4 sh = *(const LAS f32x4*)(md + b * 3072 + 1024 + col), sc = *(const LAS f32x4*)(md + b * 3072 + 2048 + col);
            hv[j] = (xv[j] * rstd2 * gg) * (sc + 1.f) + sh;
            o8[64 * j] = (unsigned long long)pk2(hv[j].x, hv[j].y) | ((unsigned long long)pk2(hv[j].z, hv[j].w) << 32); }
        float lg[16];
#pragma unroll
        for (int e = 0; e < 16; ++e) { float a = 0.f;
#pragma unroll
            for (int j = 0; j < 4; ++j) { const f32x4 wv = *(const LAS f32x4*)(wrT + e * DM + 4 * lane + 256 * j); a += (hv[j].x * wv.x + hv[j].y * wv.y) + (hv[j].z * wv.z + hv[j].w * wv.w); }
            lg[e] = a; asm volatile("" ::: "memory"); }
        float mx = -3.0e38f;
#pragma unroll
        for (int e = 0; e < 16; ++e) { lg[e] = wave_sum(lg[e]); mx = fmaxf(mx, lg[e]); }
        float se = 0.f;
#pragma unroll
        for (int e = 0; e < 16; ++e) { lg[e] = __expf(lg[e] - mx); se += lg[e]; }
        const float inv = 1.f / se; float mine = 0.f;
#pragma unroll
        for (int e = 0; e < 16; ++e) mine = (lane == e) ? lg[e] * inv : mine;
        if (lane < 16) aff[(size_t)(b * NEXP + lane) * SEQ + s] = mine;
    }
    __syncthreads();
}

__device__ __forceinline__ void p6_topk(Frame& F) {
    LAS unsigned* vals = (LAS unsigned*)(F.lds + RING_OFF);
    LAS unsigned* hist = (LAS unsigned*)(F.lds + RING_OFF + 32768);
    LAS unsigned* misc = (LAS unsigned*)(F.lds + RING_OFF + 32768 + 1024);
    const int tid = F.tid, lane = F.lane, w = F.wave;
    const float* aff = (const float*)(F.ws + WS_AFF); int* slots = (int*)(F.ws + WS_SLOTS); int* idx = (int*)(F.ws + WS_IDX); float* gates = (float*)(F.ws + WS_GATES);
    for (int unit = F.vcu; unit < BATCH * NEXP; unit += F.G) {
        const int b = unit >> 4, e = unit & 15;
        __syncthreads();
        const unsigned* src = (const unsigned*)(aff + (size_t)unit * SEQ);
        for (int i = tid; i < SEQ; i += NWAVES * 64) vals[i] = src[i];
        unsigned prefix = 0u, mask = 0u, need = CAP;
#pragma unroll 1
        for (int pass = 0; pass < 4; ++pass) {
            const int shift = 24 - 8 * pass;
            if (tid < 256) hist[tid] = 0u;
            __syncthreads();
            for (int i = tid; i < SEQ; i += NWAVES * 64) { const unsigned v = vals[i]; if ((v & mask) == prefix) __hip_atomic_fetch_add(&hist[(v >> shift) & 255u], 1u, __ATOMIC_RELAXED, __HIP_MEMORY_SCOPE_WORKGROUP); }
            __syncthreads();
            if (w == 0) {
                const unsigned b0 = hist[4 * lane], b1 = hist[4 * lane + 1], b2 = hist[4 * lane + 2], b3 = hist[4 * lane + 3];
                const unsigned sl = b0 + b1 + b2 + b3; unsigned suf = sl;
#pragma unroll
                for (int o = 1; o < 64; o <<= 1) { const unsigned tv = __shfl_down(suf, o); if (lane + o < 64) suf += tv; }
                const unsigned above = suf - sl;
                if (above < need && need <= above + sl) {
                    unsigned cnt = above, dig, nn;
                    if (cnt + b3 >= need) { dig = 3; nn = need - cnt; } else { cnt += b3;
                    if (cnt + b2 >= need) { dig = 2; nn = need - cnt; } else { cnt += b2;
                    if (cnt + b1 >= need) { dig = 1; nn = need - cnt; } else { cnt += b1; dig = 0; nn = need - cnt; } } }
                    misc[0] = 4u * lane + dig; misc[1] = nn; }
            }
            __syncthreads();
            prefix |= misc[0] << shift; mask |= 255u << shift; need = misc[1];
            __syncthreads();
        }
        const unsigned T = prefix; unsigned gt = 0u, eq = 0u; unsigned v16[16];
#pragma unroll
        for (int i = 0; i < 16; ++i) { v16[i] = vals[16 * tid + i]; gt += (v16[i] > T) ? 1u : 0u; eq += (v16[i] == T) ? 1u : 0u; }
        unsigned pk = gt | (eq << 16), inc = pk;
#pragma unroll
        for (int o = 1; o < 64; o <<= 1) { const unsigned tv = __shfl_up(inc, o); if (lane >= o) inc += tv; }
        if (lane == 63) misc[16 + w] = inc;
        __syncthreads();
        unsigned base = 0u;
#pragma unroll
        for (int ww = 0; ww < 8; ++ww) base += (ww < w) ? misc[16 + ww] : 0u;
        const unsigned exc = base + inc - pk; unsigned gtb = exc & 0xffffu, eqb = exc >> 16;
#pragma unroll
        for (int i = 0; i < 16; ++i) { const int tok = 16 * tid + i; const unsigned v = v16[i]; int slot = -1;
            if (v > T) { slot = (int)(gtb + (eqb < need ? eqb : need)); ++gtb; }
            else if (v == T) { if (eqb < need) slot = (int)(gtb + eqb); ++eqb; }
            slots[(size_t)(b * SEQ + tok) * NEXP + e] = slot;
            if (slot >= 0) { idx[unit * CAP + slot] = tok; gates[unit * CAP + slot] = __uint_as_float(v); } }
    }
    __syncthreads();
}

__device__ __forceinline__ void p6b_gather(Frame& F) {
    const int gw = F.vcu * NWAVES + F.wave, NGW = F.G * NWAVES, lane = F.lane;
    const int* idx = (const int*)(F.ws + WS_IDX); const bf16* h2 = (const bf16*)(F.ws + WS_H); bf16* xs = (bf16*)(F.ws + WS_XS);
    for (int r = gw; r < NROWS_E; r += NGW) { const int e = r >> 11, b = (r >> 10) & 1, c = r & 1023; const int tok = idx[(b * NEXP + e) * CAP + c];
        const v4u* sp = (const v4u*)(h2 + (size_t)(b * SEQ + tok) * DM) + lane; v4u* dp = (v4u*)(xs + (size_t)r * DM) + lane;
        const v4u a = sp[0], c2 = sp[64]; dp[0] = a; dp[64] = c2; }
}

__device__ __forceinline__ void p9_combine(Frame& F) {
    LAS float* md = (LAS float*)(F.lds + RING_OFF);
    mod_to_lds(F, md, 5120, 1024);
    const int gw = F.vcu * NWAVES + F.wave, NGW = F.G * NWAVES, lane = F.lane;
    const int* slots = (const int*)(F.ws + WS_SLOTS); const float* gates = (const float*)(F.ws + WS_GATES); const bf16* yrows = (const bf16*)(F.ws + WS_YROWS);
    const float* gn = F.in[IN_NPOSTFFN];
    for (int m = gw; m < NTOK; m += NGW) {
        const int b = m >> 13;
        const int slotv = (lane < 16) ? slots[(size_t)m * NEXP + lane] : -1;
        float y[16];
#pragma unroll
        for (int i = 0; i < 16; ++i) y[i] = 0.f;
#pragma unroll
        for (int e = 0; e < 16; ++e) { const int sl = __builtin_amdgcn_readlane(slotv, e);
            if (sl >= 0) { const float gt = gates[(b * NEXP + e) * CAP + sl]; const bf16* yr = yrows + (size_t)(e * 2048 + b * 1024 + sl) * DM;
                const v4u a = *(const v4u*)(yr + 8 * lane), c = *(const v4u*)(yr + 512 + 8 * lane);
                y[0] += gt * bflo(a.x); y[1] += gt * bfhi(a.x); y[2] += gt * bflo(a.y); y[3] += gt * bfhi(a.y); y[4] += gt * bflo(a.z); y[5] += gt * bfhi(a.z); y[6] += gt * bflo(a.w); y[7] += gt * bfhi(a.w);
                y[8] += gt * bflo(c.x); y[9] += gt * bfhi(c.x); y[10] += gt * bflo(c.y); y[11] += gt * bfhi(c.y); y[12] += gt * bflo(c.z); y[13] += gt * bfhi(c.z); y[14] += gt * bflo(c.w); y[15] += gt * bfhi(c.w); } }
        float ss = 0.f;
#pragma unroll
        for (int i = 0; i < 16; ++i) ss += y[i] * y[i];
        const float rstd = rsqrtf(wave_sum(ss) * (1.f / DM) + EPS);
        float* orow = F.out + (size_t)m * DM;
#pragma unroll
        for (int hf = 0; hf < 2; ++hf)
#pragma unroll
            for (int qd = 0; qd < 2; ++qd) { const int col = hf * 512 + 8 * lane + 4 * qd; const f32x4 x1 = *(const f32x4*)(orow + col), gg = *(const f32x4*)(gn + col), ga = *(const LAS f32x4*)(md + b * 1024 + col);
                f32x4 yv; yv.x = y[hf * 8 + qd * 4 + 0]; yv.y = y[hf * 8 + qd * 4 + 1]; yv.z = y[hf * 8 + qd * 4 + 2]; yv.w = y[hf * 8 + qd * 4 + 3];
                *(f32x4*)(orow + col) = x1 + ga * (yv * rstd * gg); }
    }
}

constexpr int NPHASES = 11;
#ifndef MK_N_LAUNCHES
#define MK_N_LAUNCHES 11
#endif
struct Args { const float* in[21]; float* out; unsigned char* ws; int ph_lo, ph_hi, li, pad; };
__global__ void __launch_bounds__(NWAVES * 64, 2) hymba_fwd(Args args) {
    extern __shared__ __attribute__((aligned(16))) unsigned char lds[];
    Frame F;
    F.lds = (LAS unsigned char*)lds;
    F.MISC = (volatile LAS unsigned*)(F.lds + MISC_OFF);
    F.tid = threadIdx.x; F.lane = F.tid & 63; F.wave = __builtin_amdgcn_readfirstlane(F.tid >> 6);
    F.G = gridDim.x; { const int bx = blockIdx.x; F.vcu = (F.G % 8 == 0) ? (bx % 8) * (F.G / 8) + bx / 8 : bx; }
#pragma unroll
    for (int i = 0; i < 21; ++i) F.in[i] = args.in[i];
    F.out = args.out; F.ws = args.ws; F.ctl = (gu32*)(args.ws + WS_CTL);
    for (int u = F.tid; u < (LDS_BYTES - LDSCTL_OFF) / 4; u += NWAVES * 64) ((LAS unsigned*)(F.lds + LDSCTL_OFF))[u] = 0u;
    __syncthreads();
    XcdBarrier bar; bar.bar = (unsigned*)(F.ctl + CW_BAR); bar.x = 0; bar.st = nullptr;
    const bool one_launch = (args.ph_hi - args.ph_lo) > 1;
    if (one_launch) bar = xcd_barrier_post((unsigned*)(F.ctl + CW_BAR), F.MISC + 8);
    const int lo = args.ph_lo, hi = args.ph_hi;
#ifndef PHASE_MASK
#define PHASE_MASK 0x7ff
#endif
#define IN(k) (((PHASE_MASK >> (k)) & 1) && lo <= (k) && (k) < hi)
#define BOTH(k) (IN(k) && IN((k) + 1))
#define GRID_BAR() xcd_barrier(bar)
    if (IN(0)) { p0_prologue(F); if (BOTH(0)) GRID_BAR(); }
    if (IN(1)) { p1_prenorm(F); if (BOTH(1)) GRID_BAR(); }
    if (IN(2)) {
        pg8::Gemm g{(const pg8::bf16_t*)(F.ws + WS_H), (const pg8::bf16_t*)(F.ws + WS_WINT), NTOK, D_IN, DM}; pg8::StaticOrder S; S.init(NTOK, D_IN, F.G, (int)blockIdx.x);
        pg8::EpiProj E{(pg8::bf16_t*)(F.ws + WS_Q), (pg8::bf16_t*)(F.ws + WS_K), (pg8::bf16_t*)(F.ws + WS_VT), (pg8::bf16_t*)(F.ws + WS_U), (pg8::bf16_t*)(F.ws + WS_VGT)};
        pg8::gemm_phase<pg8::EpiProj, pg8::StaticOrder, true, true>(F.lds + RING_OFF, g, S, E);
        if (BOTH(2)) GRID_BAR();
    }
    if (IN(3)) { p3_attn_naive(F); p3_gmlp_naive(F); if (BOTH(3)) GRID_BAR(); }
    if (IN(4)) {
        pg8::Gemm g{(const pg8::bf16_t*)(F.ws + WS_MIX), (const pg8::bf16_t*)(F.ws + WS_WOUTT), NTOK, DM, DM}; pg8::StaticOrder S; S.init(NTOK, DM, F.G, (int)blockIdx.x);
        pg8::EpiF32 E{(float*)(F.ws + WS_T), DM};
        pg8::gemm_phase<pg8::EpiF32, pg8::StaticOrder, true, true>(F.lds + RING_OFF, g, S, E);
        if (BOTH(4)) GRID_BAR();
    }
    if (IN(5)) { p5_postmix(F); if (BOTH(5)) GRID_BAR(); }
    if (IN(6)) { p6_topk(F); if (BOTH(6)) GRID_BAR(); }
    if (IN(7)) { p6b_gather(F); if (BOTH(7)) GRID_BAR(); }
    if (IN(8)) {
        pg8::Gemm g{(const pg8::bf16_t*)(F.ws + WS_XS), (const pg8::bf16_t*)(F.ws + WS_WGUT), NROWS_E, 2 * D_FF, DM}; pg8::MoeOrder S; S.init(NEXP, 8, 22, F.G, (int)blockIdx.x);
        pg8::EpiSwiGLU E{(pg8::bf16_t*)(F.ws + WS_HID), 22};
        pg8::gemm_phase<pg8::EpiSwiGLU, pg8::MoeOrder, true, true>(F.lds + RING_OFF, g, S, E);
        if (BOTH(8)) GRID_BAR();
    }
    if (IN(9)) {
        pg8::Gemm g{(const pg8::bf16_t*)(F.ws + WS_HID), (const pg8::bf16_t*)(F.ws + WS_WDT), NROWS_E, DM, D_FF}; pg8::MoeOrder S; S.init(NEXP, 8, 4, F.G, (int)blockIdx.x);
        pg8::EpiDown E{(pg8::bf16_t*)(F.ws + WS_YROWS), 4};
        pg8::gemm_phase<pg8::EpiDown, pg8::MoeOrder, true, true>(F.lds + RING_OFF, g, S, E);
        if (BOTH(9)) GRID_BAR();
    }
    if (IN(10)) { p9_combine(F); }
#undef IN
#undef BOTH
#undef GRID_BAR
}

extern "C" void kernel_launch(void* const* d_in, const int* in_sizes, int n_in, void* d_out, int out_size, void* d_ws, size_t ws_size, hipStream_t stream) {
    static int grid = 0;
    if (grid == 0) {
        if (n_in != 21 || out_size != NTOK * DM || ws_size < WS_END) { fprintf(stderr, "kernel_launch: unexpected shapes (n_in %d out %d ws %zu)\n", n_in, out_size, ws_size); grid = -1; return; }
        int dev = 0, cus = 0;
        if (hipGetDevice(&dev) != hipSuccess || hipDeviceGetAttribute(&cus, hipDeviceAttributeMultiprocessorCount, dev) != hipSuccess) { grid = -1; return; }
        if (hipFuncSetAttribute((const void*)hymba_fwd, hipFuncAttributeMaxDynamicSharedMemorySize, LDS_BYTES) != hipSuccess) { fprintf(stderr, "kernel_launch: hipFuncSetAttribute failed\n"); grid = -1; return; }
        int per_cu = 0;
        if (hipOccupancyMaxActiveBlocksPerMultiprocessor(&per_cu, (const void*)hymba_fwd, NWAVES * 64, LDS_BYTES) != hipSuccess || per_cu < 1) fprintf(stderr, "kernel_launch: occupancy query reports %d\n", per_cu);
        (void)hipGetLastError();
        grid = cus;
    }
    if (grid < 0) return;
    (void)hipMemsetAsync((char*)d_ws + WS_CTL, 0, CTL_ZERO_BYTES, stream);
    Args a{};
    for (int i = 0; i < 21; ++i) a.in[i] = (const float*)d_in[i];
    a.out = (float*)d_out; a.ws = (unsigned char*)d_ws;
    if (MK_N_LAUNCHES == 1) { a.ph_lo = 0; a.ph_hi = NPHASES; a.li = 0; hipLaunchKernelGGL(hymba_fwd, dim3(grid), dim3(NWAVES * 64), LDS_BYTES, stream, a); }
    else for (int li = 0; li < NPHASES; ++li) { a.ph_lo = li; a.ph_hi = li + 1; a.li = li; hipLaunchKernelGGL(hymba_fwd, dim3(grid), dim3(NWAVES * 64), LDS_BYTES, stream, a); }
}
```

```cpp
#include <hip/hip_runtime.h>
#include <cstdio>
#include <cstdint>
namespace pg8 {
#define PG8_LAS __attribute__((address_space(3)))
typedef unsigned short bf16_t;
typedef short bf16x8 __attribute__((ext_vector_type(8)));
typedef float f32x4 __attribute__((ext_vector_type(4)));
typedef unsigned u32x4 __attribute__((ext_vector_type(4)));
constexpr int BM = 256, BK = 64, HALF = 128, HTB = HALF * BK * 2  , STAGE_BYTES = 8 * HTB, NXCD = 8, WGM = 8;

__host__ __device__ __forceinline__ int lds_byte(int r, int c) { const int st = (r >> 4) * 2 + (c >> 5), rr = r & 15, cc = c & 31, ob = rr * 64 + cc * 2; return st * 1024 + (ob ^ (((ob >> 9) & 1) << 5)); }
__host__ __device__ __forceinline__ void stage_rc(int b, int& R, int& C) { const int st = b / 1024, sb = b % 1024, swz = sb ^ (((sb >> 9) & 1) << 5); R = (st >> 1) * 16 + swz / 64; C = (st & 1) * 32 + (swz % 64) / 2; }
__host__ __device__ __forceinline__ int perm32(int rho) { const int n = rho >> 4, i = rho & 15; return 8 * (i >> 2) + 4 * n + (i & 3); }

struct Unit { int pm, pn; };
struct Gemm { const bf16_t* A; const bf16_t* Bt; int M, N, K; const int* rowmap; };

struct StaticOrder {
    int nM, nN, nwg, G, c;
    __host__ __device__ void init(int M, int N, int G_, int c_) { nM = M / BM; nN = N / BM; nwg = nM * nN; G = G_; c = c_; }
    __host__ __device__ bool next(int i, Unit& u) const {
        const long L = (long)i * G + c; if (L >= nwg) return false;
        int wgid = (int)L; { const int q = nwg / NXCD, r = nwg % NXCD, xcd = wgid % NXCD, off = wgid / NXCD; wgid = (xcd < r ? xcd * (q + 1) : r * (q + 1) + (xcd - r) * q) + off; }
        const int nig = WGM * nN, gid = wgid / nig, fm = gid * WGM, gsz = (nM - fm) < WGM ? (nM - fm) : WGM;
        u.pm = fm + ((wgid % nig) % gsz); u.pn = (wgid % nig) / gsz; return true;
    }
    __device__ __forceinline__ void a_ready(const Unit&) const {}
    __device__ __forceinline__ void done(const Unit&) const {}
};


typedef float f32x2 __attribute__((ext_vector_type(2))); typedef float f32x2_t __attribute__((ext_vector_type(2))); typedef __bf16 bf16x2_t __attribute__((ext_vector_type(2))); typedef int i32x4_t __attribute__((ext_vector_type(4)));
__device__ __forceinline__ unsigned cvtpk(float lo, float hi) { f32x2_t v = {lo, hi}; bf16x2_t b = __builtin_convertvector(v, bf16x2_t); return __builtin_bit_cast(unsigned, b); }
__device__ __forceinline__ bf16_t f2bf1(float f) { return (bf16_t)(cvtpk(f, 0.f) & 0xffffu); }
__device__ __forceinline__ void store8(bf16_t* p, const f32x4 v0, const f32x4 v1) {
    u32x4 w; w.x = cvtpk(v0[0], v0[1]); w.y = cvtpk(v0[2], v0[3]); w.z = cvtpk(v1[0], v1[1]); w.w = cvtpk(v1[2], v1[3]); *(u32x4*)p = w; }
__device__ __forceinline__ float gelu_tanh(float x) {
    const float t = x * __builtin_fmaf(x * x, -0.10294324f, -2.30220823f);
    return x * __builtin_amdgcn_rcpf(1.f + __builtin_amdgcn_exp2f(t));
}
__device__ __forceinline__ float silu_f(float x) { return x / (1.f + __expf(-x)); }

struct MoeOrder {
    int nE, nM, nN, U, G, c;
    __device__ void init(int nE_, int nM_, int nN_, int G_, int c_) { nE = nE_; nM = nM_; nN = nN_; U = nE * nM * nN; G = G_; c = c_; }
    __device__ bool next(int i, Unit& u) const {
        int gl;
        if ((G & 7) == 0 && (U & 7) == 0) { const int x = c & 7, j = c >> 3, per = G >> 3, li = i * per + j, ux = U >> 3; if (li >= ux) return false; gl = x * ux + li; }
        else { const long L = (long)i * G + c; if (L >= U) return false; gl = (int)L; }
        const int per_e = nM * nN, e = gl / per_e, r = gl % per_e;
        u.pm = e * nM + (r % nM); u.pn = e * nN + (r / nM); return true;
    }
    __device__ __forceinline__ void a_ready(const Unit&) const {}
    __device__ __forceinline__ void done(const Unit&) const {}
};

struct SubOrder {
    MoeOrder S; int base, cnt;
    __device__ bool next(int i, Unit& u) const { return i < cnt && S.next(base + i, u); }
    __device__ __forceinline__ void a_ready(const Unit&) const {}
    __device__ __forceinline__ void done(const Unit&) const {}
};

struct PanelReadyOrder : StaticOrder {
    const unsigned* ready; unsigned need;
    __device__ __forceinline__ void a_ready(const Unit& u) const {
        if (threadIdx.x < 64) { unsigned sp = 0;
            while ((unsigned)__builtin_amdgcn_readfirstlane((int)__hip_atomic_load(ready + 64 * u.pm, __ATOMIC_RELAXED, __HIP_MEMORY_SCOPE_AGENT)) < need) { __builtin_amdgcn_s_sleep(2); if (++sp > (1u << 22)) break; }
            __builtin_amdgcn_fence(__ATOMIC_ACQUIRE, "agent");
            asm volatile("s_waitcnt vmcnt(0)" ::: "memory"); }
        asm volatile("" ::: "memory"); __builtin_amdgcn_s_barrier(); asm volatile("" ::: "memory");
    }
};

struct EpiProj {
    static constexpr bool PERM = true, AFTER_DRAIN = false;
    bf16_t *q, *k, *vT, *u, *vgT; float* vstat;
    __device__ __forceinline__ void operator()(const f32x4 (&acc)[2][2][4][2], const Unit& un, int wr, int wc, int fr, int fq) const {
        const int row0 = un.pm * BM + wr * 64 + fr, pn = un.pn, cw = wc * 32 + 8 * fq;
        const int b = (un.pm * BM) >> 13;
        if (pn < 2) {
#pragma unroll
            for (int ai = 0; ai < 2; ++ai)
#pragma unroll
                for (int m = 0; m < 4; ++m) { bf16_t* rowp = q + (size_t)(row0 + ai * HALF + m * 16) * 512 + pn * 256 + cw;
#pragma unroll
                    for (int bj = 0; bj < 2; ++bj) store8(rowp + bj * HALF, acc[ai][bj][m][0], acc[ai][bj][m][1]); }
        } else if (pn == 2) {
#pragma unroll
            for (int ai = 0; ai < 2; ++ai)
#pragma unroll
                for (int m = 0; m < 4; ++m) { const int r = row0 + ai * HALF + m * 16, s = r & 8191;
                    store8(k + (size_t)r * 128 + cw, acc[ai][0][m][0], acc[ai][0][m][1]);
#pragma unroll
                    for (int n = 0; n < 2; ++n)
#pragma unroll
                        for (int j = 0; j < 4; ++j) vT[(size_t)(b * 128 + cw + 4 * n + j) * 8192 + s] = f2bf1(acc[ai][1][m][n][j]); }
        } else if (pn < 5) {
#pragma unroll
            for (int ai = 0; ai < 2; ++ai)
#pragma unroll
                for (int m = 0; m < 4; ++m) { bf16_t* rowp = u + (size_t)(row0 + ai * HALF + m * 16) * 512 + (pn - 3) * 256 + cw;
#pragma unroll
                    for (int bj = 0; bj < 2; ++bj) { f32x4 v0 = acc[ai][bj][m][0], v1 = acc[ai][bj][m][1];
#pragma unroll
                        for (int j = 0; j < 4; ++j) { v0[j] = gelu_tanh(v0[j]); v1[j] = gelu_tanh(v1[j]); }
                        store8(rowp + bj * HALF, v0, v1); } }
        } else {
#pragma unroll
            for (int ai = 0; ai < 2; ++ai)
#pragma unroll
                for (int m = 0; m < 4; ++m) { const int r = row0 + ai * HALF + m * 16, s = r & 8191, nch = s >> 7, sl = s & 127, ks = sl >> 4, hi = (sl >> 3) & 1, jj = sl & 7;
                    float ps = 0.f, pq = 0.f;
#pragma unroll
                    for (int bj = 0; bj < 2; ++bj)
#pragma unroll
                        for (int n = 0; n < 2; ++n)
#pragma unroll
                            for (int j = 0; j < 4; ++j) { const int ch = (pn - 5) * 256 + bj * HALF + cw + 4 * n + j, g = ch >> 6, cb = (ch >> 5) & 1, r32 = ch & 31;
                                const bf16_t hb = f2bf1(gelu_tanh(acc[ai][bj][m][n][j])); const float hv = __uint_as_float((unsigned)hb << 16); ps += hv; pq += hv * hv;
                                vgT[((((size_t)(b * 64 + nch) * 8 + g) * 2 + cb) * 8 + ks) * 512 + (hi * 32 + r32) * 8 + jj] = hb; }
                    ps += __shfl_xor(ps, 16); ps += __shfl_xor(ps, 32); pq += __shfl_xor(pq, 16); pq += __shfl_xor(pq, 32);
                    if (fq == 0) { f32x2 st2 = {ps, pq}; *(f32x2*)(vstat + ((size_t)((pn - 5) * 4 + wc) * 16384 + r) * 2) = st2; } }
        }
    }
};

struct EpiF32 {
    static constexpr bool PERM = false, AFTER_DRAIN = false;
    float* C; int ldc;
    __device__ __forceinline__ void operator()(const f32x4 (&acc)[2][2][4][2], const Unit& u, int wr, int wc, int fr, int fq) const {
        const int row0 = u.pm * BM + wr * 64 + fr, col0 = u.pn * BM + wc * 32 + 4 * fq;
#pragma unroll
        for (int ai = 0; ai < 2; ++ai)
#pragma unroll
            for (int m = 0; m < 4; ++m) { float* rowp = C + (size_t)(row0 + ai * HALF + m * 16) * ldc + col0;
#pragma unroll
                for (int bj = 0; bj < 2; ++bj)
#pragma unroll
                    for (int n = 0; n < 2; ++n) *(f32x4*)(rowp + bj * HALF + n * 16) = acc[ai][bj][m][n]; }
    }
};

struct EpiSwiGLU {
    static constexpr bool PERM = true, AFTER_DRAIN = false;
    bf16_t* hid; int nN;
    __device__ __forceinline__ void operator()(const f32x4 (&acc)[2][2][4][2], const Unit& un, int wr, int wc, int fr, int fq) const {
        const int row0 = un.pm * BM + wr * 64 + fr, pnl = un.pn % nN, col0 = pnl * HALF + wc * 32 + 8 * fq;
#pragma unroll
        for (int ai = 0; ai < 2; ++ai)
#pragma unroll
            for (int m = 0; m < 4; ++m) { bf16_t* rowp = hid + (size_t)(row0 + ai * HALF + m * 16) * 2816 + col0;
                f32x4 v0, v1;
#pragma unroll
                for (int j = 0; j < 4; ++j) { v0[j] = silu_f(acc[ai][0][m][0][j]) * acc[ai][1][m][0][j]; v1[j] = silu_f(acc[ai][0][m][1][j]) * acc[ai][1][m][1][j]; }
                store8(rowp, v0, v1); }
    }
};

struct EpiDown {
    static constexpr bool PERM = true, AFTER_DRAIN = false;
    bf16_t* y; int nN;
    __device__ __forceinline__ void operator()(const f32x4 (&acc)[2][2][4][2], const Unit& un, int wr, int wc, int fr, int fq) const {
        const int row0 = un.pm * BM + wr * 64 + fr, pnl = un.pn % nN, col0 = pnl * BM + wc * 32 + 8 * fq;
#pragma unroll
        for (int ai = 0; ai < 2; ++ai)
#pragma unroll
            for (int m = 0; m < 4; ++m) { bf16_t* rowp = y + (size_t)(row0 + ai * HALF + m * 16) * 1024 + col0;
#pragma unroll
                for (int bj = 0; bj < 2; ++bj) store8(rowp + bj * HALF, acc[ai][bj][m][0], acc[ai][bj][m][1]); }
    }
};

__device__ __forceinline__ unsigned pk4_fp8(float a, float b, float c, float d) { int w = __builtin_amdgcn_cvt_pk_fp8_f32(a, b, 0, false); w = __builtin_amdgcn_cvt_pk_fp8_f32(c, d, w, true); return (unsigned)w; }
__device__ __forceinline__ float clamp448(float x) { return __builtin_fminf(__builtin_fmaxf(x, -448.f), 448.f); }
struct EpiSwiGLU8 {
    static constexpr bool PERM = true, AFTER_DRAIN = false;
    unsigned char* hid; int nN; float inv_scale;
    __device__ __forceinline__ void operator()(const f32x4 (&acc)[2][2][4][2], const Unit& un, int wr, int wc, int fr, int fq) const {
        const int row0 = un.pm * BM + wr * 64 + fr, pnl = un.pn % nN, col0 = pnl * HALF + wc * 32 + 8 * fq;
        const float c1 = -inv_scale * 1.4426950408889634f, s2 = inv_scale * inv_scale;
#pragma unroll
        for (int ai = 0; ai < 2; ++ai)
#pragma unroll
            for (int m = 0; m < 4; ++m) { unsigned char* rowp = hid + (size_t)(row0 + ai * HALF + m * 16) * 2816 + col0;
                float v[8];
#pragma unroll
                for (int n = 0; n < 2; ++n)
#pragma unroll
                    for (int j = 0; j < 4; j += 2) { const f32x2 g = {acc[ai][0][m][n][j], acc[ai][0][m][n][j + 1]}, u = {acc[ai][1][m][n][j], acc[ai][1][m][n][j + 1]};
                        const f32x2 p = (g * u) * s2, x = g * c1; f32x2 d; d.x = __builtin_amdgcn_exp2f(x.x); d.y = __builtin_amdgcn_exp2f(x.y); d = d + 1.0f;
                        f32x2 r; r.x = __builtin_amdgcn_rcpf(d.x); r.y = __builtin_amdgcn_rcpf(d.y); const f32x2 o = p * r;
                        v[4 * n + j] = __builtin_amdgcn_fmed3f(o.x, -448.f, 448.f); v[4 * n + j + 1] = __builtin_amdgcn_fmed3f(o.y, -448.f, 448.f); }
                uint2 w; w.x = pk4_fp8(v[0], v[1], v[2], v[3]); w.y = pk4_fp8(v[4], v[5], v[6], v[7]); *(uint2*)rowp = w; }
    }
};
struct EpiDown8 {
    static constexpr bool PERM = true, AFTER_DRAIN = false;
    unsigned char* y; int nN; float inv_scale;
    __device__ __forceinline__ void operator()(const f32x4 (&acc)[2][2][4][2], const Unit& un, int wr, int wc, int fr, int fq) const {
        const int row0 = un.pm * BM + wr * 64 + fr, pnl = un.pn % nN, col0 = pnl * BM + wc * 32 + 8 * fq;
#pragma unroll
        for (int ai = 0; ai < 2; ++ai)
#pragma unroll
            for (int m = 0; m < 4; ++m) { unsigned char* rowp = y + (size_t)(row0 + ai * HALF + m * 16) * 1024 + col0;
#pragma unroll
                for (int bj = 0; bj < 2; ++bj) { const f32x4 v0 = acc[ai][bj][m][0] * inv_scale, v1 = acc[ai][bj][m][1] * inv_scale;
                    uint2 w; w.x = pk4_fp8(__builtin_amdgcn_fmed3f(v0[0], -448.f, 448.f), __builtin_amdgcn_fmed3f(v0[1], -448.f, 448.f), __builtin_amdgcn_fmed3f(v0[2], -448.f, 448.f), __builtin_amdgcn_fmed3f(v0[3], -448.f, 448.f));
                    w.y = pk4_fp8(__builtin_amdgcn_fmed3f(v1[0], -448.f, 448.f), __builtin_amdgcn_fmed3f(v1[1], -448.f, 448.f), __builtin_amdgcn_fmed3f(v1[2], -448.f, 448.f), __builtin_amdgcn_fmed3f(v1[3], -448.f, 448.f));
                    *(uint2*)(rowp + bj * HALF) = w; } }
    }
};
typedef int i32x8_t __attribute__((ext_vector_type(8)));
template <bool FP8> struct OperandT { typedef bf16x8 type; };
template <> struct OperandT<true> { typedef i32x8_t type; };
__device__ __forceinline__ void ld_bf16(bf16x8& d, const PG8_LAS unsigned char* p) { d = *(const PG8_LAS bf16x8*)p; }
__device__ __forceinline__ void ld_bf16(i32x8_t&, const PG8_LAS unsigned char*) {}
__device__ __forceinline__ void ld_fp8(i32x8_t& d, const PG8_LAS unsigned char* p) { const i32x4_t lo = *(const PG8_LAS i32x4_t*)p, hi = *(const PG8_LAS i32x4_t*)(p + 1024); d = __builtin_shufflevector(lo, hi, 0, 1, 2, 3, 4, 5, 6, 7); }
__device__ __forceinline__ void ld_fp8(bf16x8&, const PG8_LAS unsigned char*) {}
__device__ __forceinline__ f32x4 mma_bf16(const bf16x8& a, const bf16x8& b, const f32x4& c) { return __builtin_amdgcn_mfma_f32_16x16x32_bf16(a, b, c, 0, 0, 0); }
__device__ __forceinline__ f32x4 mma_bf16(const i32x8_t&, const i32x8_t&, const f32x4& c) { return c; }
__device__ __forceinline__ f32x4 mma_fp8(const i32x8_t& a, const i32x8_t& b, const f32x4& c) { f32x4 d = c; const int sc = 0x7f7f7f7f;
    asm volatile("v_mfma_scale_f32_16x16x128_f8f6f4 %0, %1, %2, %0, %3, %3 op_sel_hi:[0,0,0]" : "+v"(d) : "v"(a), "v"(b), "v"(sc)); return d; }
__device__ __forceinline__ f32x4 mma_fp8(const bf16x8&, const bf16x8&, const f32x4& c) { return c; }
template <class Epi, class Sched, bool ALIGN_EPI = false, bool SP2 = false, bool FP8 = false, bool GATHER = false, int PF = 0>
__device__ __forceinline__ void gemm_phase(PG8_LAS unsigned char* lds, const Gemm g, const Sched& S, const Epi& E) {
    const int tid = threadIdx.x, wid = __builtin_amdgcn_readfirstlane(tid >> 6), lane = tid & 63, wr = wid >> 2, wc = wid & 3, fr = lane & 15, fq = lane >> 4;
    const int K = g.K, nt = K / BK;
    unsigned voffA[2], voffB[2];
#pragma unroll
    for (int i = 0; i < 2; ++i) { int R, C; stage_rc(tid * 16 + i * 8192, R, C); const int Rb = Epi::PERM ? ((R & ~31) + perm32(R & 31)) : R;
        voffA[i] = (unsigned)(R * K + C) * 2u; voffB[i] = (unsigned)(Rb * K + C) * 2u; }
    const size_t kstep = (size_t)(BK * 2);
    const size_t hstep = (size_t)HALF * K * 2;
    const size_t tstep = 2 * hstep;
    const unsigned ldsw = (unsigned)wid * 1024u;
    const int aoff = lds_byte(wr * 64 + fr, fq * 8), boff = lds_byte(wc * 32 + fr, fq * 8);
#define PG8_SA(b, h) (((b) * 2 + (h)) * HTB)
#define PG8_SB(b, h) ((4 + (b) * 2 + (h)) * HTB)
#define PG8_STAGE(bufoff, gbase, voff) do { _Pragma("unroll") for (int _i = 0; _i < 2; ++_i) \
        __builtin_amdgcn_global_load_lds((const unsigned*)((const char*)(gbase) + (voff)[_i]), (PG8_LAS unsigned*)(lds + (bufoff) + ldsw + _i * 8192), 16, 0, 0); } while (0)
#define PG8_STAGE_A(bufoff, gbase, h, usenext) do { if constexpr (GATHER) { _Pragma("unroll") for (int _i = 0; _i < 2; ++_i) \
        __builtin_amdgcn_global_load_lds((const unsigned*)((const char*)(gbase) + ((usenext) ? vgn[h][_i] : vgc[h][_i])), (PG8_LAS unsigned*)(lds + (bufoff) + ldsw + _i * 8192), 16, 0, 0); } \
    else { PG8_STAGE(bufoff, (gbase) + ((h) ? hstep : 0), voffA); } } while (0)
#define PG8_LD2(base) PG8_CAT(*(const PG8_LAS i32x4_t*)(base), *(const PG8_LAS i32x4_t*)((base) + 1024))
#define PG8_LDA(dst, b, h) do { _Pragma("unroll") for (int m = 0; m < 4; ++m) { if constexpr (FP8) { ld_fp8(dst[m][0], lds + PG8_SA(b, h) + aoff + m * 2048); } else { _Pragma("unroll") for (int k = 0; k < (FP8 ? 1 : 2); ++k) ld_bf16(dst[m][k], lds + PG8_SA(b, h) + aoff + m * 2048 + k * 1024); } } } while (0)
#define PG8_LDB(dst, b, h) do { _Pragma("unroll") for (int n = 0; n < 2; ++n) { if constexpr (FP8) { ld_fp8(dst[n][0], lds + PG8_SB(b, h) + boff + n * 2048); } else { _Pragma("unroll") for (int k = 0; k < (FP8 ? 1 : 2); ++k) ld_bf16(dst[n][k], lds + PG8_SB(b, h) + boff + n * 2048 + k * 1024); } } } while (0)
#define PG8_MMA(ai, bj, At, Bt) do { __builtin_amdgcn_s_setprio(1); _Pragma("unroll") for (int m = 0; m < 4; ++m) _Pragma("unroll") for (int n = 0; n < 2; ++n) { \
        if constexpr (FP8) { acc[ai][bj][m][n] = mma_fp8(Bt[n][0], At[m][0], acc[ai][bj][m][n]); } \
        else { _Pragma("unroll") for (int k = 0; k < (FP8 ? 1 : 2); ++k) acc[ai][bj][m][n] = mma_bf16(Bt[n][k], At[m][k], acc[ai][bj][m][n]); } } __builtin_amdgcn_s_setprio(0); } while (0)
#define PG8_WAIT_V(n) asm volatile("s_waitcnt vmcnt(" #n ")" ::: "memory")
#define PG8_WAIT_L(n) asm volatile("s_waitcnt lgkmcnt(" #n ")" ::: "memory")
#define PG8_BAR __builtin_amdgcn_s_barrier()
#define PG8_SCHED __builtin_amdgcn_sched_barrier(0)
    Unit cur, nxt; int ui = 0;
    if (!S.next(0, cur)) return;
    f32x4 acc[2][2][4][2];
#pragma unroll
    for (int a = 0; a < 2; ++a)
#pragma unroll
        for (int b = 0; b < 2; ++b)
#pragma unroll
            for (int m = 0; m < 4; ++m)
#pragma unroll
                for (int n = 0; n < 2; ++n) acc[a][b][m][n] = (f32x4){0.f, 0.f, 0.f, 0.f};
    typename OperandT<FP8>::type At[4][FP8 ? 1 : 2], B0[2][FP8 ? 1 : 2], B1[2][FP8 ? 1 : 2];
    const char* cA = GATHER ? (const char*)g.A : (const char*)g.A + (size_t)cur.pm * tstep; const char* cB = (const char*)g.Bt + (size_t)cur.pn * tstep;
    unsigned vgc[2][2], vgn[2][2]; int stR[2], stC[2];
#pragma unroll
    for (int i = 0; i < 2; ++i) { stage_rc(tid * 16 + i * 8192, stR[i], stC[i]); }
    constexpr int RM_MAXU = 12; PG8_LAS int* rml = (PG8_LAS int*)(lds + STAGE_BYTES);
    if constexpr (GATHER) { Unit uu;
        for (int i = 0; i < RM_MAXU && S.next(i, uu); ++i) { if (tid < BM) rml[i * BM + tid] = g.rowmap[uu.pm * BM + tid]; }
        asm volatile("s_waitcnt vmcnt(0) lgkmcnt(0)" ::: "memory"); __builtin_amdgcn_s_barrier(); asm volatile("" ::: "memory"); }
#define PG8_GOFF(dst, uidx, pmv) do { _Pragma("unroll") for (int _h = 0; _h < 2; ++_h) _Pragma("unroll") for (int _i = 0; _i < 2; ++_i) { \
        const int _r = _h * HALF + stR[_i]; const int _row = !GATHER ? 0 : rml[(uidx) * BM + _r]; \
        dst[_h][_i] = ((unsigned)_row * (unsigned)K + (unsigned)stC[_i]) * 2u; } } while (0)
    PG8_GOFF(vgc, 0, cur.pm);
    static_assert(PF == 0 || SP2, "the L2 prefetch is wired into the super-phase loop only");
    const size_t rowb = (size_t)K * 2;
#define PG8_PFBASE(un, uidx) ((tid < BM) ? (GATHER ? (unsigned)rml[(GATHER ? (uidx) : 0) * BM + (tid & (BM - 1))] * (unsigned)rowb : ((unsigned)(un).pm * BM + tid) * (unsigned)rowb) \
                                         : ((unsigned)(un).pn * BM + (tid - BM)) * (unsigned)rowb)
    unsigned pfc = PF ? PG8_PFBASE(cur, 0) : 0u; unsigned pfn = pfc;
#define PG8_PREFETCH(tt) do { if constexpr (PF > 0) { const int _tt = (tt); const bool _in = _tt < nt; const char* _b = (tid < BM) ? (const char*)g.A : (const char*)g.Bt; \
        const char* _p = (_in || !has_next) ? _b + pfc + (size_t)(_in ? _tt : 0) * kstep : _b + pfn + (size_t)(_tt - nt) * kstep; \
        __builtin_amdgcn_global_load_lds((const unsigned*)_p, (PG8_LAS unsigned*)(lds + STAGE_BYTES + 12032), 4, 0, 0); } } while (0)
#define PG8_WAIT_VL() do { if constexpr (PF > 0) PG8_WAIT_V(9); else PG8_WAIT_V(8); } while (0)
#pragma unroll
    for (int h_ = 0; h_ < 2; ++h_) { vgn[h_][0] = vgc[h_][0]; vgn[h_][1] = vgc[h_][1]; }
    S.a_ready(cur);
    if constexpr (SP2) {
        PG8_STAGE(PG8_SB(0, 0), cB, voffB); PG8_STAGE(PG8_SB(0, 1), cB + hstep, voffB); PG8_STAGE_A(PG8_SA(0, 0), cA, 0, false); PG8_STAGE_A(PG8_SA(0, 1), cA, 1, false);
        if (wr == 1) PG8_BAR;
        PG8_WAIT_V(2); PG8_BAR;
        PG8_STAGE(PG8_SB(1, 0), cB + kstep, voffB); PG8_STAGE_A(PG8_SA(1, 0), cA + kstep, 0, false); PG8_STAGE(PG8_SB(1, 1), cB + hstep + kstep, voffB);
        PG8_WAIT_V(6); PG8_BAR;
    } else {
        PG8_STAGE(PG8_SB(0, 0), cB, voffB); PG8_STAGE_A(PG8_SA(0, 0), cA, 0, false); PG8_STAGE(PG8_SB(0, 1), cB + hstep, voffB); PG8_STAGE_A(PG8_SA(0, 1), cA, 1, false);
        if (wr == 1) PG8_BAR;
        PG8_WAIT_V(4); PG8_BAR;
        PG8_STAGE(PG8_SB(1, 0), cB + kstep, voffB); PG8_STAGE_A(PG8_SA(1, 0), cA + kstep, 0, false); PG8_STAGE(PG8_SB(1, 1), cB + hstep + kstep, voffB);
        PG8_WAIT_V(6); PG8_BAR;
    }
    for (;;) {
        const bool has_next = S.next(ui + 1, nxt);
        if constexpr (GATHER) { if (has_next) PG8_GOFF(vgn, ui + 1, nxt.pm); }
        if constexpr (PF > 0) { if (has_next) pfn = PG8_PFBASE(nxt, ui + 1); }
        const char* nA = (has_next && !GATHER) ? (const char*)g.A + (size_t)nxt.pm * tstep : cA; const char* nB = has_next ? (const char*)g.Bt + (size_t)nxt.pn * tstep : cB;
#pragma unroll 1
        for (int t = 0; t < nt; t += 2) {
            const bool last = (t == nt - 2);
            const char* a1 = cA + (size_t)(t + 1) * kstep;
            const char* a2 = last ? nA : cA + (size_t)(t + 2) * kstep; const char* b2 = last ? nB : cB + (size_t)(t + 2) * kstep;
            const char* a3 = a2 + kstep; const char* b3 = b2 + kstep;
            if (last && has_next) S.a_ready(nxt);
            if constexpr (SP2) {
            PG8_LDB(B0, 0, 0); PG8_LDB(B1, 0, 1); PG8_SCHED; PG8_LDA(At, 0, 0); PG8_STAGE_A(PG8_SA(1, 1), a1, 1, false); PG8_PREFETCH(t + PF);
            PG8_WAIT_VL(); PG8_WAIT_L(0); PG8_BAR; PG8_MMA(0, 0, At, B0); PG8_MMA(0, 1, At, B1); PG8_BAR; PG8_SCHED;
            PG8_LDA(At, 0, 1); PG8_STAGE(PG8_SB(0, 0), b2, voffB); PG8_STAGE(PG8_SB(0, 1), b2 + hstep, voffB); PG8_STAGE_A(PG8_SA(0, 0), a2, 0, last);
            PG8_WAIT_VL(); PG8_WAIT_L(0); PG8_BAR; PG8_MMA(1, 0, At, B0); PG8_MMA(1, 1, At, B1); PG8_BAR; PG8_SCHED;
            PG8_LDB(B0, 1, 0); PG8_LDB(B1, 1, 1); PG8_SCHED; PG8_LDA(At, 1, 0); PG8_STAGE_A(PG8_SA(0, 1), a2, 1, last); PG8_PREFETCH(t + 1 + PF);
            PG8_WAIT_VL(); PG8_WAIT_L(0); PG8_BAR; PG8_MMA(0, 0, At, B0); PG8_MMA(0, 1, At, B1); PG8_BAR; PG8_SCHED;
            PG8_LDA(At, 1, 1); PG8_STAGE(PG8_SB(1, 0), b3, voffB); PG8_STAGE(PG8_SB(1, 1), b3 + hstep, voffB); PG8_STAGE_A(PG8_SA(1, 0), a3, 0, last);
            PG8_WAIT_VL(); PG8_WAIT_L(0); PG8_BAR; PG8_MMA(1, 0, At, B0); PG8_MMA(1, 1, At, B1); PG8_BAR; PG8_SCHED;
            } else {
            PG8_LDB(B0, 0, 0); PG8_SCHED; PG8_LDA(At, 0, 0); PG8_STAGE_A(PG8_SA(1, 1), a1, 1, false);
            PG8_WAIT_L(8); PG8_BAR; PG8_WAIT_L(0); PG8_MMA(0, 0, At, B0); PG8_BAR; PG8_SCHED;
            PG8_LDB(B1, 0, 1); PG8_STAGE(PG8_SB(0, 0), b2, voffB);
            PG8_BAR; PG8_WAIT_L(0); PG8_MMA(0, 1, At, B1); PG8_BAR;
            PG8_LDA(At, 0, 1); PG8_STAGE_A(PG8_SA(0, 0), a2, 0, last);
            PG8_BAR; PG8_WAIT_L(0); PG8_MMA(1, 0, At, B0); PG8_BAR; PG8_SCHED;
            PG8_STAGE(PG8_SB(0, 1), b2 + hstep, voffB);
            PG8_WAIT_V(6); PG8_BAR; PG8_MMA(1, 1, At, B1); PG8_BAR;
            PG8_LDB(B0, 1, 0); PG8_SCHED; PG8_LDA(At, 1, 0); PG8_STAGE_A(PG8_SA(0, 1), a2, 1, last);
            PG8_WAIT_L(8); PG8_BAR; PG8_WAIT_L(0); PG8_MMA(0, 0, At, B0); PG8_BAR; PG8_SCHED;
            PG8_LDB(B1, 1, 1); PG8_STAGE(PG8_SB(1, 0), b3, voffB);
            PG8_BAR; PG8_WAIT_L(0); PG8_MMA(0, 1, At, B1); PG8_BAR;
            PG8_LDA(At, 1, 1); PG8_STAGE_A(PG8_SA(1, 0), a3, 0, last);
            PG8_BAR; PG8_WAIT_L(0); PG8_MMA(1, 0, At, B0); PG8_BAR; PG8_SCHED;
            PG8_STAGE(PG8_SB(1, 1), b3 + hstep, voffB);
            PG8_WAIT_V(6); PG8_BAR; PG8_MMA(1, 1, At, B1); PG8_BAR;
            }
        }
        if constexpr (FP8) { asm volatile("s_nop 15\n\ts_nop 15" ::: "memory"); }
        if constexpr (ALIGN_EPI) { if (wr == 0) PG8_BAR; }
        if constexpr (!Epi::AFTER_DRAIN) { E(acc, cur, wr, wc, fr, fq); S.done(cur); }
        if (!has_next) break;
#pragma unroll
        for (int a = 0; a < 2; ++a)
#pragma unroll
            for (int b = 0; b < 2; ++b)
#pragma unroll
                for (int m = 0; m < 4; ++m)
#pragma unroll
                    for (int n = 0; n < 2; ++n) acc[a][b][m][n] = (f32x4){0.f, 0.f, 0.f, 0.f};
        cur = nxt; cA = nA; cB = nB; ++ui; pfc = pfn;
        if constexpr (GATHER) {
#pragma unroll
            for (int h_ = 0; h_ < 2; ++h_) { vgc[h_][0] = vgn[h_][0]; vgc[h_][1] = vgn[h_][1]; } }
        if constexpr (ALIGN_EPI) { if (wr == 1) PG8_BAR; }
    }
    PG8_WAIT_V(0);
    if constexpr (!ALIGN_EPI) { if (wr == 0) PG8_BAR; }
    PG8_BAR;
    if constexpr (Epi::AFTER_DRAIN) { E.fused(acc, cur, wr, wc, fr, fq, lds, wid, lane); S.done(cur); }
#undef PG8_SA
#undef PG8_SB
#undef PG8_STAGE
#undef PG8_STAGE_A
#undef PG8_GOFF
#undef PG8_PFBASE
#undef PG8_PREFETCH
#undef PG8_WAIT_VL
#undef PG8_LDA
#undef PG8_LDB
#undef PG8_MMA
#undef PG8_LD2
#undef PG8_WAIT_V
#undef PG8_WAIT_L
#undef PG8_BAR
#undef PG8_SCHED
}
}
#define GAS __attribute__((address_space(1)))
#define LAS __attribute__((address_space(3)))
typedef unsigned short bf16;
typedef unsigned v4u __attribute__((ext_vector_type(4)));
typedef float f32x4 __attribute__((ext_vector_type(4)));
typedef short bf16x8 __attribute__((ext_vector_type(8)));
typedef GAS unsigned gu32;
typedef GAS unsigned long long gu64;
#define RLX_AGENT __ATOMIC_RELAXED, __HIP_MEMORY_SCOPE_AGENT
#define LDS_WAIT() asm volatile("s_waitcnt lgkmcnt(0)" ::: "memory")
#define VM_WAIT() asm volatile("s_waitcnt vmcnt(0)" ::: "memory")
__device__ __forceinline__ unsigned long long rt() { return __builtin_amdgcn_s_memrealtime(); }
__device__ __forceinline__ unsigned f2bf(float f) { unsigned u = __builtin_bit_cast(unsigned, f); return (u + 0x7fffu + ((u >> 16) & 1u)) >> 16; }
__device__ __forceinline__ unsigned pk2(float lo, float hi) { return f2bf(lo) | (f2bf(hi) << 16); }

#define XB_TMO      128
#define XB_XCNT(j)  (256  + 64 * (j))
#define XB_XSUB(j)  (1280 + 64 * (j))
#define XB_XGEN(j)  (2304 + 64 * (j))
#define XB_TOP      3328
#define XB_TOPGEN   3392
#define XCD_BAR_WORDS 3456
#define XB_SPIN_CAP (1u << 18)

__device__ __forceinline__ unsigned xb_ld(unsigned* p)              { return __hip_atomic_load(p, __ATOMIC_RELAXED, __HIP_MEMORY_SCOPE_AGENT); }
__device__ __forceinline__ unsigned xb_add(unsigned* p, unsigned v) { return __hip_atomic_fetch_add(p, v, __ATOMIC_RELAXED, __HIP_MEMORY_SCOPE_AGENT); }
__device__ __forceinline__ unsigned xb_xcc_id() { return (unsigned)__builtin_amdgcn_s_getreg((3 << 11) | 20) & 0xFu; }
#define XB_SPIN(cond, bar) do { unsigned _sp = 0; while (cond) { __builtin_amdgcn_s_sleep(1); \
    if ((++_sp & 255u) == 0u) { if (xb_ld(&(bar)[XB_TMO])) break; if (_sp > XB_SPIN_CAP) { atomicAdd(&(bar)[XB_TMO], 1u); break; } } } } while (0)

struct XcdBarrier {
    unsigned* bar; unsigned x;
    volatile LAS unsigned* st;
};

__device__ __forceinline__ XcdBarrier xcd_barrier_post(unsigned* bar, volatile LAS unsigned* st) {
    XcdBarrier b; b.bar = bar; b.x = xb_xcc_id(); b.st = st;
    if (threadIdx.x == 0) (void)xb_add(&bar[XB_XCNT(b.x)], 1u);
    return b;
}
__device__ __forceinline__ void xcd_barrier_complete(unsigned* bar, unsigned x, unsigned& nloc, unsigned& nx) {
    const unsigned G = gridDim.x * gridDim.y * gridDim.z;
    unsigned sum, cnt, mine, sp = 0u;
    for (;;) {
        sum = 0u; cnt = 0u; mine = 0u;
#pragma unroll
        for (unsigned j = 0; j < 16; ++j) { const unsigned c = xb_ld(&bar[XB_XCNT(j)]); sum += c; cnt += (c > 0u) ? 1u : 0u; mine = (j == x) ? c : mine; }
        if (sum == G) break;
        __builtin_amdgcn_s_sleep(1);
        if ((++sp & 255u) == 0u) { if (xb_ld(&bar[XB_TMO])) break; if (sp > XB_SPIN_CAP) { atomicAdd(&bar[XB_TMO], 1u); break; } }
    }
    nloc = mine > 0u ? mine : 1u; nx = cnt > 0u ? cnt : 1u;
}

__device__ __forceinline__ void xcd_barrier(const XcdBarrier& b) {
    asm volatile("s_waitcnt vmcnt(0)" ::: "memory");
    __syncthreads();
    if (threadIdx.x == 0) {
        unsigned* bar = b.bar;
        __builtin_amdgcn_s_waitcnt(0);
        unsigned nloc = b.st[0], nx = b.st[1];
        if (nloc == 0u) { xcd_barrier_complete(bar, b.x, nloc, nx); b.st[0] = nloc; b.st[1] = nx; }
        const unsigned old = xb_add(&bar[XB_XSUB(b.x)], 1u);
        const unsigned gen = old / nloc;
        if (old + 1u == (gen + 1u) * nloc) {
            __builtin_amdgcn_fence(__ATOMIC_RELEASE, "agent");
            asm volatile("s_waitcnt vmcnt(0)" ::: "memory");
            const unsigned og = xb_add(&bar[XB_TOP], 1u);
            const unsigned tg = og / nx;
            if (og + 1u == (tg + 1u) * nx) xb_add(&bar[XB_TOPGEN], 1u);
            else XB_SPIN(xb_ld(&bar[XB_TOPGEN]) == tg, bar);
            __builtin_amdgcn_fence(__ATOMIC_ACQUIRE, "agent");
            xb_add(&bar[XB_XGEN(b.x)], 1u);
            asm volatile("s_waitcnt vmcnt(0)" ::: "memory");
        } else {
            XB_SPIN(xb_ld(&bar[XB_XGEN(b.x)]) == gen, bar);
            __builtin_amdgcn_fence(__ATOMIC_ACQUIRE, "agent");
            asm volatile("s_waitcnt vmcnt(0)" ::: "memory");
        }
    }
    __syncthreads();
}

constexpr int NWAVES = 8;
constexpr int BATCH = 2, SEQ = 8192, DM = 1024, NTOK = BATCH * SEQ;
constexpr int D_IN = 1792, D_FF = 2816, NEXP = 16, CAP = 1024;
constexpr int NROWS_E = NEXP * BATCH * CAP;
constexpr float EPS = 1e-6f;
constexpr int KS_ADA = 16;
#ifndef PF_DIST
#define PF_DIST 0
#endif
constexpr float Y8_SCALE = 16.f;
constexpr float W8_SCALE = 64.f, W8_INV = 1.f / 64.f;

constexpr size_t MiB = 1u << 20;
constexpr size_t WS_CTL = 0, CTL_ZERO_BYTES = 65536;
constexpr size_t WS_MODP = 1 * MiB;
constexpr size_t WS_AFF = 2 * MiB;
constexpr size_t WS_SLOTS = 3 * MiB;
constexpr size_t WS_IDX = 4 * MiB;
constexpr size_t WS_GATES = 4 * MiB + 128 * 1024;
constexpr size_t WS_WSB = 4 * MiB + 256 * 1024;
constexpr size_t WS_VSTAT = 11 * MiB;
constexpr size_t WS_WINT = 5 * MiB;
constexpr size_t WS_WOUTT = 9 * MiB;
constexpr size_t WS_WGUT = 12 * MiB;
constexpr size_t WS_WDT = 188 * MiB;
constexpr size_t WS_H = 276 * MiB;
constexpr size_t WS_YROWS = 308 * MiB;
constexpr size_t WS_HID = 372 * MiB;
constexpr size_t WS_Q = 372 * MiB;
constexpr size_t WS_K = 388 * MiB;
constexpr size_t WS_VT = 392 * MiB;
constexpr size_t WS_U = 396 * MiB;
constexpr size_t WS_VGT = 412 * MiB;
constexpr size_t WS_MIX = 428 * MiB;
constexpr size_t WS_T = 460 * MiB;
constexpr size_t WS_XS = 548 * MiB;
constexpr size_t WS_X1 = 612 * MiB;
constexpr size_t WS_END = 676 * MiB;
constexpr int CW_BAR = 4096;
constexpr int CW_MIXCNT = 8192;
constexpr int CW_P0CNT = 128;

constexpr int RING_OFF = 0, RING_BYTES = 131072;
constexpr int LDSCTL_OFF = 143360, MISC_OFF = LDSCTL_OFF + 320;
constexpr int LDS_BYTES = 147456;

struct Frame {
    LAS unsigned char* lds;
    volatile LAS unsigned* MISC;
    gu32* ctl;
    int tid, lane, wave;
    int vcu, G;
    const float* in[21];
    float* out;
    unsigned char* ws;
};
#define IN_X 0
#define IN_C 1
#define IN_WADA 2
#define IN_BADA 3
#define IN_NPREMIX 4
#define IN_NPOSTMIX 5
#define IN_WIN 6
#define IN_SINK 7
#define IN_LNG 8
#define IN_LNB 9
#define IN_WS 10
#define IN_BS 11
#define IN_NOATTN 12
#define IN_NOGMLP 13
#define IN_WOUT 14
#define IN_NPREFFN 15
#define IN_NPOSTFFN 16
#define IN_WROUTER 17
#define IN_WGATE 18
#define IN_WUP 19
#define IN_WDOWN 20

#define DPP_ADDF(v, ctrl, rmask) (v) += __builtin_bit_cast(float, __builtin_amdgcn_update_dpp(0, __builtin_bit_cast(int, (v)), (ctrl), (rmask), 0xf, true))
__device__ __forceinline__ float wave_sum(float v) {
    DPP_ADDF(v, 0xB1, 0xf); DPP_ADDF(v, 0x4E, 0xf); DPP_ADDF(v, 0x141, 0xf); DPP_ADDF(v, 0x140, 0xf); DPP_ADDF(v, 0x142, 0xa); DPP_ADDF(v, 0x143, 0xc);
    return __builtin_bit_cast(float, __builtin_amdgcn_readlane(__builtin_bit_cast(int, v), 63));
}
#define DPP_MAXF(v, ctrl, rmask) (v) = fmaxf((v), __builtin_bit_cast(float, __builtin_amdgcn_update_dpp(__builtin_bit_cast(int, (v)), __builtin_bit_cast(int, (v)), (ctrl), (rmask), 0xf, false)))
__device__ __forceinline__ float wave_max(float v) {
    DPP_MAXF(v, 0xB1, 0xf); DPP_MAXF(v, 0x4E, 0xf); DPP_MAXF(v, 0x141, 0xf); DPP_MAXF(v, 0x140, 0xf); DPP_MAXF(v, 0x142, 0xa); DPP_MAXF(v, 0x143, 0xc);
    return __builtin_bit_cast(float, __builtin_amdgcn_readlane(__builtin_bit_cast(int, v), 63));
}
__device__ __forceinline__ float bf2f(unsigned short b) { return __uint_as_float((unsigned)b << 16); }
__device__ __forceinline__ float bflo(unsigned u) { return __uint_as_float(u << 16); }
__device__ __forceinline__ float bfhi(unsigned u) { return __uint_as_float(u & 0xffff0000u); }

__device__ __forceinline__ void transpose_item(const float* W, int N, int k0, int n0, bf16* WT, int ldt, int dest_row0, LAS float* scr, int lane) {
#pragma unroll 8
    for (int i = 0; i < 32; ++i) { const int kk = 2 * i + (lane >> 5); scr[kk * 33 + (lane & 31)] = W[(size_t)(k0 + kk) * N + n0 + (lane & 31)]; }
    LDS_WAIT(); asm volatile("" ::: "memory");
    const int c = lane & 7;
#pragma unroll
    for (int j = 0; j < 4; ++j) { const int n = (lane >> 3) + 8 * j; const LAS float* s = scr + (8 * c) * 33 + n;
        v4u o; o.x = pk2(s[0 * 33], s[1 * 33]); o.y = pk2(s[2 * 33], s[3 * 33]); o.z = pk2(s[4 * 33], s[5 * 33]); o.w = pk2(s[6 * 33], s[7 * 33]);
        *(GAS v4u*)(WT + (size_t)(dest_row0 + n) * ldt + k0 + 8 * c) = o; }
    LDS_WAIT(); asm volatile("" ::: "memory");
}

constexpr int XI_PER_MAT = (DM / 128) * (D_FF / 32);
constexpr int XI_TOTAL = NEXP * 3 * XI_PER_MAT;
struct XItem { const float* src; unsigned char* dst; int N, ldt; };
__device__ __forceinline__ XItem xitem_decode(Frame& F, int it) {
    const int e = it / (3 * XI_PER_MAT), r = it % (3 * XI_PER_MAT), ty = r / XI_PER_MAT, r3 = r % XI_PER_MAT; XItem d;
    if (ty < 2) { const int kb = r3 / (D_FF / 32), n0 = 32 * (r3 % (D_FF / 32)), k0 = 128 * kb;
        d.N = D_FF; d.ldt = DM; d.src = (ty ? F.in[IN_WUP] : F.in[IN_WGATE]) + (size_t)e * DM * D_FF + (size_t)k0 * D_FF + n0;
        const int drow = (n0 >> 7) * 256 + ty * 128 + (n0 & 127);
        d.dst = (unsigned char*)(F.ws + WS_WGUT) + (size_t)e * (2 * D_FF) * DM + (size_t)drow * DM + k0; }
    else { const int kb = r3 / (DM / 32), n0 = 32 * (r3 % (DM / 32)), k0 = 128 * kb;
        d.N = DM; d.ldt = D_FF; d.src = F.in[IN_WDOWN] + (size_t)e * D_FF * DM + (size_t)k0 * DM + n0;
        d.dst = (unsigned char*)(F.ws + WS_WDT) + (size_t)e * DM * D_FF + (size_t)n0 * D_FF + k0; }
    return d;
}
__device__ __forceinline__ void xitem_load(const XItem& d, float (&r)[64], int lane) {
    const float* p = d.src + (size_t)(lane >> 5) * d.N + (lane & 31);
#pragma unroll
    for (int i = 0; i < 64; ++i) r[i] = __builtin_nontemporal_load(p + (size_t)(2 * i) * d.N);
}
__device__ __forceinline__ void xitem_finish(const XItem& d, const float (&r)[64], LAS float* scr, int lane) {
#pragma unroll
    for (int i = 0; i < 64; ++i) scr[(2 * i + (lane >> 5)) * 33 + (lane & 31)] = r[i] * W8_SCALE;
    LDS_WAIT(); asm volatile("" ::: "memory");
    const int c = lane & 7;
#pragma unroll
    for (int j = 0; j < 4; ++j) { const int n = (lane >> 3) + 8 * j; const LAS float* s = scr + (16 * c) * 33 + n;
        v4u o;
        o.x = pg8::pk4_fp8(s[0 * 33], s[1 * 33], s[2 * 33], s[3 * 33]);
        o.y = pg8::pk4_fp8(s[4 * 33], s[5 * 33], s[6 * 33], s[7 * 33]);
        o.z = pg8::pk4_fp8(s[8 * 33], s[9 * 33], s[10 * 33], s[11 * 33]);
        o.w = pg8::pk4_fp8(s[12 * 33], s[13 * 33], s[14 * 33], s[15 * 33]);
        __builtin_nontemporal_store(o, (v4u*)(d.dst + (size_t)n * d.ldt + 16 * c)); }
    LDS_WAIT(); asm volatile("" ::: "memory");
}
constexpr int XI_R0 = 25600, XI_R1 = 28400;
__device__ __forceinline__ void p0_expert_items(Frame& F, int first, int end, int widx, int nworkers) {
    LAS float* scr = (LAS float*)(F.lds + F.wave * 16896);
    const int lane = F.lane;
    float rA[64], rB[64];
    int it = first + widx; XItem dA, dB;
    if (it < end) { dA = xitem_decode(F, it); xitem_load(dA, rA, lane); }
    while (it < end) {
        const int it2 = it + nworkers;
        if (it2 < end) { dB = xitem_decode(F, it2); xitem_load(dB, rB, lane); }
        xitem_finish(dA, rA, scr, lane);
        if (it2 >= end) break;
        const int it3 = it2 + nworkers;
        if (it3 < end) { dA = xitem_decode(F, it3); xitem_load(dA, rA, lane); }
        xitem_finish(dB, rB, scr, lane);
        it = it3;
    }
}

__device__ __forceinline__ void p0_prologue(Frame& F) {
    LAS float* scr = (LAS float*)(F.lds + F.wave * 16896);
    const int gw = F.vcu * NWAVES + F.wave, NGW = F.G * NWAVES, lane = F.lane;
    {
        const float* c = F.in[IN_C]; const float* W = F.in[IN_WADA]; float* modp = (float*)(F.ws + WS_MODP);
        constexpr int KPS = DM / KS_ADA;
        for (int it = gw; it < 96 * KS_ADA; it += NGW) {
            const int cg = it % 96, ks = it / 96, col = cg * 64 + lane;
            float a0 = 0.f, a1 = 0.f;
#pragma unroll 16
            for (int kk = 0; kk < KPS; ++kk) { const int k = ks * KPS + kk; const float w = W[(size_t)k * 6144 + col];
                const float c0 = c[k], c1 = c[DM + k];
                a0 += (c0 / (1.f + __expf(-c0))) * w; a1 += (c1 / (1.f + __expf(-c1))) * w; }
            __hip_atomic_store(modp + (size_t)(ks * 2 + 0) * 6144 + col, a0, __ATOMIC_RELAXED, __HIP_MEMORY_SCOPE_AGENT);
            __hip_atomic_store(modp + (size_t)(ks * 2 + 1) * 6144 + col, a1, __ATOMIC_RELAXED, __HIP_MEMORY_SCOPE_AGENT);
        }
        asm volatile("s_waitcnt vmcnt(0)" ::: "memory");
        if (lane == 0) __hip_atomic_fetch_add((unsigned*)(F.ctl + CW_P0CNT), 1u, __ATOMIC_RELAXED, __HIP_MEMORY_SCOPE_AGENT);
    }
    {
        const float* wsf = F.in[IN_WS]; bf16* wsb = (bf16*)(F.ws + WS_WSB);
        for (int o = gw * 64 + lane; o < 8 * 8 * 4 * 64; o += NGW * 64) { const int ln = o & 63, tb = (o >> 6) & 3, ks = (o >> 8) & 7, g = o >> 11, r32 = ln & 31, hi = ln >> 5;
            const float* src = wsf + (size_t)(g * 128 + 32 * tb + r32) * 128 + 16 * ks + 8 * hi; const f32x4 v0 = *(const f32x4*)src, v1 = *(const f32x4*)(src + 4);
            v4u pk; pk.x = pk2(v0.x, v0.y); pk.y = pk2(v0.z, v0.w); pk.z = pk2(v1.x, v1.y); pk.w = pk2(v1.z, v1.w); *(v4u*)(wsb + (size_t)o * 8) = pk; }
    }
    constexpr int I_IN = (DM / 64) * (D_IN / 32), I_OUT = (DM / 64) * (DM / 32);
    for (int it = gw; it < I_IN + I_OUT; it += NGW) {
        int r = it;
        if (r < I_IN) { const int nb = D_IN / 32, kb = r / nb, n0 = 32 * (r % nb); transpose_item(F.in[IN_WIN], D_IN, 64 * kb, n0, (bf16*)(F.ws + WS_WINT), DM, n0, scr, lane); continue; } r -= I_IN;
        { const int nb = DM / 32, kb = r / nb, n0 = 32 * (r % nb); transpose_item(F.in[IN_WOUT], DM, 64 * kb, n0, (bf16*)(F.ws + WS_WOUTT), DM, n0, scr, lane); }
    }
    p0_expert_items(F, 0, XI_R0, gw, NGW);
}
__device__ __forceinline__ void p0_wait_published(Frame& F) {
    if (F.wave == 0) { const unsigned want = (unsigned)(F.G * NWAVES); unsigned sp = 0;
        while ((unsigned)__builtin_amdgcn_readfirstlane((int)__hip_atomic_load((unsigned*)(F.ctl + CW_P0CNT), __ATOMIC_RELAXED, __HIP_MEMORY_SCOPE_AGENT)) < want) { __builtin_amdgcn_s_sleep(2); if (++sp > (1u << 22)) break; }
        __builtin_amdgcn_fence(__ATOMIC_ACQUIRE, "agent"); asm volatile("s_waitcnt vmcnt(0)" ::: "memory"); }
    __syncthreads();
}

__device__ __forceinline__ void mod_to_lds(Frame& F, LAS float* dst, int col0, int ncols) {
    const float* modp = (const float*)(F.ws + WS_MODP); const float* bada = F.in[IN_BADA];
#pragma unroll 4
    for (int i = F.tid; i < 2 * ncols; i += NWAVES * 64) { const int b = i / ncols, j = i % ncols; float s = bada[col0 + j];
#pragma unroll
        for (int ks = 0; ks < KS_ADA; ++ks) s += modp[(size_t)(ks * 2 + b) * 6144 + col0 + j];
        dst[i] = s; }
    __syncthreads();
}
constexpr size_t WS_MODF = WS_MODP + (size_t)KS_ADA * 2 * 6144 * 4;
__device__ __forceinline__ void modf_write(Frame& F) {
    const float* modp = (const float*)(F.ws + WS_MODP); const float* bada = F.in[IN_BADA]; float* modf = (float*)(F.ws + WS_MODF);
    const int i = (int)blockIdx.x * NWAVES * 64 + F.tid;
    if (i < 2 * 4096) { const int b = i >> 12, col = 2048 + (i & 4095); float s = bada[col];
#pragma unroll
        for (int ks = 0; ks < KS_ADA; ++ks) s += modp[(size_t)(ks * 2 + b) * 6144 + col];
        modf[b * 6144 + col] = s; }
}
__device__ __forceinline__ void modf_to_lds(Frame& F, LAS float* dst, int col0, int ncols) {
    const float* modf = (const float*)(F.ws + WS_MODF);
#pragma unroll 4
    for (int i = F.tid; i < 2 * ncols; i += NWAVES * 64) { const int b = i / ncols, j = i % ncols; dst[i] = modf[b * 6144 + col0 + j]; }
    __syncthreads();
}

__device__ __forceinline__ void p1_prenorm(Frame& F) {
    LAS float* md = (LAS float*)(F.lds + RING_OFF);
    p0_wait_published(F);
    modf_write(F);
    mod_to_lds(F, md, 0, 2048);
    const int gw = F.vcu * NWAVES + F.wave, NGW = F.G * NWAVES, lane = F.lane;
    const float* x = F.in[IN_X]; const float* g = F.in[IN_NPREMIX]; bf16* h = (bf16*)(F.ws + WS_H);
    f32x4 gq[4];
#pragma unroll
    for (int j = 0; j < 4; ++j) gq[j] = *(const f32x4*)(g + 4 * lane + 256 * j);
    f32x4 vn[4];
    if (gw < NTOK) { const f32x4* xr = (const f32x4*)(x + (size_t)gw * DM) + lane;
#pragma unroll
        for (int j = 0; j < 4; ++j) vn[j] = xr[64 * j]; }
    for (int m = gw; m < NTOK; m += NGW) {
        const int b = m >> 13;
        f32x4 v[4]; float ss = 0.f;
#pragma unroll
        for (int j = 0; j < 4; ++j) { v[j] = vn[j]; ss += (v[j].x * v[j].x + v[j].y * v[j].y) + (v[j].z * v[j].z + v[j].w * v[j].w); }
        const float rstd = rsqrtf(wave_sum(ss) * (1.f / DM) + EPS);
        unsigned long long* o8 = (unsigned long long*)(h + (size_t)m * DM) + lane;
#pragma unroll
        for (int j = 0; j < 4; ++j) { const int col = 4 * lane + 256 * j; const f32x4 gg = gq[j];
            const f32x4 sh = *(const LAS f32x4*)(md + b * 2048 + col), sc = *(const LAS f32x4*)(md + b * 2048 + 1024 + col);
            const f32x4 r = (v[j] * rstd * gg) * (sc + 1.f) + sh;
            o8[64 * j] = (unsigned long long)pk2(r.x, r.y) | ((unsigned long long)pk2(r.z, r.w) << 32); }
        if (m + NGW < NTOK) { const f32x4* xr = (const f32x4*)(x + (size_t)(m + NGW) * DM) + lane;
#pragma unroll
            for (int j = 0; j < 4; ++j) vn[j] = xr[64 * j]; }
    }
    __syncthreads();
}

typedef float f32x16 __attribute__((ext_vector_type(16)));
typedef short s16x4 __attribute__((ext_vector_type(4)));
typedef float f32x2_t __attribute__((ext_vector_type(2))); typedef __bf16 bf16x2_t __attribute__((ext_vector_type(2)));
__device__ __forceinline__ unsigned cvtpk(float lo, float hi) { f32x2_t v = {lo, hi}; bf16x2_t bb = __builtin_convertvector(v, bf16x2_t); return __builtin_bit_cast(unsigned, bb); }
__device__ __forceinline__ int crow(int i, int hi) { return (i & 3) + 8 * (i >> 2) + 4 * hi; }
#define MFMA32(a, b, c) __builtin_amdgcn_mfma_f32_32x32x16_bf16((a), (b), (c), 0, 0, 0)
__device__ __forceinline__ void store16_wt(void* p, const v4u v) { asm volatile("global_store_dwordx4 %0, %1, off sc1\n\ts_nop 1" :: "v"(p), "v"(v) : "memory"); }
__device__ __forceinline__ void mix_publish(Frame& F, int row0) {
    asm volatile("s_waitcnt vmcnt(0)" ::: "memory");
    if (F.lane == 0) __hip_atomic_fetch_add((unsigned*)(F.ctl + CW_MIXCNT + 64 * (row0 >> 8)), 1u, __ATOMIC_RELAXED, __HIP_MEMORY_SCOPE_AGENT);
}
constexpr int AT_KB = 24576, AT_VB = 25600, AT_BUF = AT_KB + AT_VB, AT_SQ = 2 * AT_BUF;
struct AtStage { v4u k[3], v[3]; };
__device__ __forceinline__ void at_load(AtStage& st, const bf16* k, const bf16* vT, int b, int q0, int c, int tid) {
#pragma unroll
    for (int i = 0; i < 3; ++i) { const int kb = q0 - 128 + 32 * (3 * c + i), kbc = kb < 0 ? 0 : (kb > SEQ - 32 ? SEQ - 32 : kb);
        st.k[i] = *(const v4u*)(k + (size_t)(b * SEQ + kbc + (tid >> 4)) * 128 + (tid & 15) * 8);
        st.v[i] = *(const v4u*)(vT + (size_t)(b * 128 + (tid >> 2)) * SEQ + kbc + (tid & 3) * 8); }
}
__device__ __forceinline__ void at_store(const AtStage& st, LAS unsigned char* buf, int tid) {
#pragma unroll
    for (int i = 0; i < 3; ++i) { const int key = 32 * i + (tid >> 4), ch16 = tid & 15, kvh = ch16 >> 3, ch = ch16 & 7;
        *(LAS v4u*)(buf + kvh * 12288 + key * 128 + ((ch ^ (key & 7)) << 4)) = st.k[i];
        const int row = tid >> 2, pc = tid & 3; LAS unsigned char* vp = buf + AT_KB + (row >> 6) * 12800 + (row & 63) * 200 + (32 * i + 8 * pc) * 2;
        typedef unsigned u32x2_t __attribute__((ext_vector_type(2)));
        *(LAS u32x2_t*)vp = (u32x2_t){st.v[i].x, st.v[i].y}; *(LAS u32x2_t*)(vp + 8) = (u32x2_t){st.v[i].z, st.v[i].w}; }
}
#define AT_TILE(KT, TL, MODE) do { const int kb_ = q0 - 128 + 32 * (KT); if (kb_ >= 0 && kb_ < SEQ) { \
    const int key_ = 32 * (TL) + r32; bf16x8 kf_[4]; \
    _Pragma("unroll") for (int ks = 0; ks < 4; ++ks) kf_[ks] = *(const LAS bf16x8*)(kimg + key_ * 128 + (((2 * ks + hi) ^ (key_ & 7)) << 4)); \
    bf16x8 va_[2][2]; \
    _Pragma("unroll") for (int db = 0; db < 2; ++db) _Pragma("unroll") for (int sx = 0; sx < 2; ++sx) { const LAS unsigned char* vp_ = vimg + (32 * db + r32) * 200 + (32 * (TL) + 16 * sx + 4 * hi) * 2; \
        const s16x4 lo_ = *(const LAS s16x4*)vp_, hv_ = *(const LAS s16x4*)(vp_ + 16); va_[db][sx] = __builtin_shufflevector(lo_, hv_, 0, 1, 2, 3, 4, 5, 6, 7); } \
    f32x16 st_; _Pragma("unroll") for (int i = 0; i < 16; ++i) st_[i] = 0.f; \
    _Pragma("unroll") for (int ks = 0; ks < 4; ++ks) st_ = MFMA32(kf_[ks], *(const LAS bf16x8*)(ot + ks * 1024 + lane * 16), st_); \
    float bt_ = 0.f; \
    if (MODE == 1) { bt_ = Bp - sl2 * (float)(128 - 32 * (KT)); _Pragma("unroll") for (int i = 0; i < 16; ++i) st_[i] = __builtin_fmaf(st_[i], c0, Kc[i]); } \
    else if (MODE == 2) { bt_ = -Bp - sl2 * (float)(32 * (KT) - 128); _Pragma("unroll") for (int i = 0; i < 16; ++i) st_[i] = __builtin_fmaf(st_[i], c0, -Kc[i]); } \
    else if (MODE == 3) { bt_ = Bp - sl2 * 128.f;              \
        _Pragma("unroll") for (int i = 0; i < 16; ++i) st_[i] = ((i & 3) + 8 * (i >> 2) + 4 * hi >= r32) ? __builtin_fmaf(st_[i], c0, Kc[i]) : -1e30f; } \
    else if (MODE == 4) { bt_ = -Bp - sl2 * 128.f;             \
        _Pragma("unroll") for (int i = 0; i < 16; ++i) st_[i] = ((i & 3) + 8 * (i >> 2) + 4 * hi <= r32) ? __builtin_fmaf(st_[i], c0, -Kc[i]) : -1e30f; } \
    else {                                                     \
        _Pragma("unroll") for (int i = 0; i < 16; ++i) st_[i] = __builtin_fmaf(-sl2, __builtin_fabsf(rh - (float)((i & 3) + 8 * (i >> 2))), st_[i] * c0); } \
    float ta_ = fmaxf(fmaxf(st_[0], st_[1]), st_[2]), tb_ = fmaxf(fmaxf(st_[3], st_[4]), st_[5]); \
    ta_ = fmaxf(fmaxf(ta_, st_[6]), st_[7]); tb_ = fmaxf(fmaxf(tb_, st_[8]), st_[9]); ta_ = fmaxf(fmaxf(ta_, st_[10]), st_[11]); tb_ = fmaxf(fmaxf(tb_, st_[12]), st_[13]); \
    float tmax_ = fmaxf(fmaxf(ta_, tb_), fmaxf(st_[14], st_[15])) + bt_; tmax_ = fmaxf(tmax_, __shfl_xor(tmax_, 32)); \
    if (__any(tmax_ > m_run)) { const float mn_ = fmaxf(m_run, tmax_), al_ = __builtin_amdgcn_exp2f(m_run - mn_); m_run = mn_; l_run *= al_; \
        _Pragma("unroll") for (int i = 0; i < 16; ++i) { o0[i] *= al_; o1[i] *= al_; } } \
    const float dl_ = bt_ - m_run; float ps_ = 0.f; \
    _Pragma("unroll") for (int i = 0; i < 16; ++i) { const float p_ = __builtin_amdgcn_exp2f(st_[i] + dl_); st_[i] = p_; ps_ += p_; } \
    ps_ += __shfl_xor(ps_, 32); l_run += ps_; \
    v4u p0_, p1_; \
    p0_.x = cvtpk(st_[0], st_[1]); p0_.y = cvtpk(st_[2], st_[3]); p0_.z = cvtpk(st_[4], st_[5]); p0_.w = cvtpk(st_[6], st_[7]); \
    p1_.x = cvtpk(st_[8], st_[9]); p1_.y = cvtpk(st_[10], st_[11]); p1_.z = cvtpk(st_[12], st_[13]); p1_.w = cvtpk(st_[14], st_[15]); \
    const bf16x8 pb0_ = __builtin_bit_cast(bf16x8, p0_), pb1_ = __builtin_bit_cast(bf16x8, p1_); \
    o0 = MFMA32(va_[0][0], pb0_, o0); o0 = MFMA32(va_[0][1], pb1_, o0); o1 = MFMA32(va_[1][0], pb0_, o1); o1 = MFMA32(va_[1][1], pb1_, o1); } } while (0)
#define AT_CHUNK(C, NC, NU, M0, M1, M2) do { LAS unsigned char* buf = ring + par * AT_BUF; par ^= 1; at_store(st, buf, tid); __syncthreads(); \
    if ((NU) < nunits) at_load(st, k, vT, ((NU) * 32) >> 13, ((NU) * 32) & 8191, (NC), tid); \
    const LAS unsigned char* kimg = buf + kvh * 12288; const LAS unsigned char* vimg = buf + AT_KB + kvh * 12800; \
    AT_TILE(3 * (C) + 0, 0, M0); __builtin_amdgcn_sched_barrier(0); AT_TILE(3 * (C) + 1, 1, M1); __builtin_amdgcn_sched_barrier(0); AT_TILE(3 * (C) + 2, 2, M2); } while (0)
__device__ __forceinline__ void p3_attn_mfma(Frame& F) {
    const int tid = F.tid, lane = F.lane, r32 = lane & 31, hi = lane >> 5, hh = F.wave, kvh = hh >> 2;
    LAS unsigned char* ring = F.lds + RING_OFF; LAS float* SQ = (LAS float*)(ring + AT_SQ);
    const bf16* q = (const bf16*)(F.ws + WS_Q); const bf16* k = (const bf16*)(F.ws + WS_K); const bf16* vT = (const bf16*)(F.ws + WS_VT);
    bf16* mix = (bf16*)(F.ws + WS_MIX); const float* gn = F.in[IN_NOATTN];
    constexpr float LOG2E = 1.4426950408889634f;
    const float slope = exp2f(-(float)(hh + 1)), sl2 = slope * LOG2E, c0 = 0.125f * LOG2E, sink2 = F.in[IN_SINK][hh] * LOG2E;
    const float rh = (float)(r32 - 4 * hi), Bp = -sl2 * rh;
    float Kc[16];
#pragma unroll
    for (int i = 0; i < 16; ++i) Kc[i] = sl2 * (float)((i & 3) + 8 * (i >> 2));
    LAS unsigned char* ot = ring + AT_SQ + 1024 + hh * 4096;
    const int nunits = NTOK / 32; int unit = F.vcu; if (unit >= nunits) return;
    AtStage st; at_load(st, k, vT, (unit * 32) >> 13, (unit * 32) & 8191, 1, tid);
    int par = 0;
    for (; unit < nunits; unit += F.G) {
        const int tok0 = unit * 32, b = tok0 >> 13, q0 = tok0 & 8191, qpos = q0 + r32;
#pragma unroll
        for (int ks = 0; ks < 4; ++ks) *(LAS bf16x8*)(ot + ks * 1024 + lane * 16) = *(const bf16x8*)(q + (size_t)(tok0 + r32) * 512 + hh * 64 + 16 * ks + 8 * hi);
        f32x16 o0, o1;
#pragma unroll
        for (int i = 0; i < 16; ++i) { o0[i] = 0.f; o1[i] = 0.f; }
        float m_run = sink2, l_run = 1.f;
        AT_CHUNK(1, 0, unit, 1, 0, 2);
        AT_CHUNK(0, 2, unit, 3, 1, 1);
        AT_CHUNK(2, 1, unit + F.G, 2, 2, 4);
        (void)b;
        const float inv = 1.f / l_run; float sq = 0.f;
#pragma unroll
        for (int i = 0; i < 16; ++i) { o0[i] *= inv; o1[i] *= inv; sq += o0[i] * o0[i] + o1[i] * o1[i]; }
        sq += __shfl_xor(sq, 32);
        if (hi == 0) SQ[hh * 32 + r32] = sq;
        __syncthreads();
        float tot = 0.f;
#pragma unroll
        for (int w8 = 0; w8 < 8; ++w8) tot += SQ[w8 * 32 + r32];
        const float rstd = rsqrtf(tot * (1.f / 512.f) + EPS);
#pragma unroll
        for (int g4 = 0; g4 < 4; ++g4) { const int d0 = 8 * g4 + 4 * hi; const f32x4 ga = *(const f32x4*)(gn + hh * 64 + d0), gb = *(const f32x4*)(gn + hh * 64 + 32 + d0);
            *(LAS unsigned long long*)(ot + r32 * 128 + ((g4 ^ (r32 & 7)) << 4) + 8 * hi) = (unsigned long long)cvtpk(o0[4 * g4] * rstd * ga.x, o0[4 * g4 + 1] * rstd * ga.y) | ((unsigned long long)cvtpk(o0[4 * g4 + 2] * rstd * ga.z, o0[4 * g4 + 3] * rstd * ga.w) << 32);
            *(LAS unsigned long long*)(ot + r32 * 128 + (((4 + g4) ^ (r32 & 7)) << 4) + 8 * hi) = (unsigned long long)cvtpk(o1[4 * g4] * rstd * gb.x, o1[4 * g4 + 1] * rstd * gb.y) | ((unsigned long long)cvtpk(o1[4 * g4 + 2] * rstd * gb.z, o1[4 * g4 + 3] * rstd * gb.w) << 32); }
#pragma unroll
        for (int i = 0; i < 4; ++i) { const int qq = 8 * i + (lane >> 3); const v4u v = *(const LAS v4u*)(ot + qq * 128 + (((lane & 7) ^ (qq & 7)) << 4));
            store16_wt(mix + (size_t)(tok0 + qq) * DM + hh * 64 + (lane & 7) * 8, v); }
        mix_publish(F, tok0);
        __syncthreads();
    }
}
#undef AT_TILE
#undef AT_CHUNK

__device__ __forceinline__ void p3_gmlp_mfma(Frame& F) {
    __syncthreads();
    const int lane = F.lane, r32 = lane & 31, hi = lane >> 5, w = F.wave, ch0 = w * 64;
    LAS float* L = (LAS float*)(F.lds + RING_OFF + 131072);
    LAS float* MU = L; LAS float* RS = L + 128; LAS float* SQ = L + 256;
    LAS unsigned char* wt = F.lds + RING_OFF + w * 16384;
    const bf16* vgT = (const bf16*)(F.ws + WS_VGT); const bf16* u = (const bf16*)(F.ws + WS_U); bf16* mix = (bf16*)(F.ws + WS_MIX); const bf16* wsb = (const bf16*)(F.ws + WS_WSB);
    const float* bs = F.in[IN_BS]; const float* lng = F.in[IN_LNG]; const float* lnb = F.in[IN_LNB]; const float* gn = F.in[IN_NOGMLP];
    for (int unit = F.vcu; unit < BATCH * (SEQ / 128); unit += F.G) {
        const int b = unit >> 6, s0 = (unit & 63) * 128;
#pragma unroll
        for (int hb = 0; hb < 2; ++hb) { v4u ur[8];
#pragma unroll
          for (int i = 0; i < 8; ++i) ur[i] = *(const v4u*)(u + ((size_t)b * SEQ + s0 + 8 * (8 * hb + i) + (lane >> 3)) * 512 + ch0 + (lane & 7) * 8);
#pragma unroll
          for (int i = 0; i < 8; ++i) { const int t = 8 * (8 * hb + i) + (lane >> 3); *(LAS v4u*)(wt + t * 128 + (((lane & 7) ^ (t & 7)) << 4)) = ur[i]; }
          asm volatile("s_waitcnt lgkmcnt(0)" ::: "memory"); }
        if (F.tid < 128) { const float* vs = (const float*)(F.ws + WS_VSTAT) + ((size_t)b * SEQ + s0 + F.tid) * 2; float s1 = 0.f, s2 = 0.f;
#pragma unroll
            for (int p = 0; p < 8; ++p) { const f32x2_t t2 = *(const f32x2_t*)(vs + (size_t)p * NTOK * 2); s1 += t2.x; s2 += t2.y; }
            const float mean = s1 * (1.f / 512.f); float var = s2 * (1.f / 512.f) - mean * mean; var = var < 0.f ? 0.f : var;
            MU[F.tid] = mean; RS[F.tid] = rsqrtf(var + EPS); }
        __syncthreads();
        f32x16 z[2][4];
#pragma unroll
        for (int cb = 0; cb < 2; ++cb)
#pragma unroll
            for (int tb = 0; tb < 4; ++tb)
#pragma unroll
                for (int i = 0; i < 16; ++i) z[cb][tb][i] = 0.f;
        const float lg0 = lng[ch0 + r32], lb0 = lnb[ch0 + r32], lg1 = lng[ch0 + 32 + r32], lb1 = lnb[ch0 + 32 + r32];
#pragma unroll 2
        for (int ks = 0; ks < 8; ++ks) {
            const int sb = 16 * ks + 8 * hi;
            const f32x4 mua = *(const LAS f32x4*)(MU + sb), mub = *(const LAS f32x4*)(MU + sb + 4), rsa = *(const LAS f32x4*)(RS + sb), rsb = *(const LAS f32x4*)(RS + sb + 4);
            bf16x8 af[2];
#pragma unroll
            for (int cb = 0; cb < 2; ++cb) { const float lg = cb ? lg1 : lg0, lb = cb ? lb1 : lb0;
                const v4u raw = *(const v4u*)(vgT + ((((size_t)(b * 64 + (unit & 63)) * 8 + w) * 2 + cb) * 8 + ks) * 512 + lane * 8);
                v4u pk;
                pk.x = cvtpk((bflo(raw.x) - mua.x) * rsa.x * lg + lb, (bfhi(raw.x) - mua.y) * rsa.y * lg + lb);
                pk.y = cvtpk((bflo(raw.y) - mua.z) * rsa.z * lg + lb, (bfhi(raw.y) - mua.w) * rsa.w * lg + lb);
                pk.z = cvtpk((bflo(raw.z) - mub.x) * rsb.x * lg + lb, (bfhi(raw.z) - mub.y) * rsb.y * lg + lb);
                pk.w = cvtpk((bflo(raw.w) - mub.z) * rsb.z * lg + lb, (bfhi(raw.w) - mub.w) * rsb.w * lg + lb);
                af[cb] = __builtin_bit_cast(bf16x8, pk); }
#pragma unroll
            for (int tb = 0; tb < 4; ++tb) { const bf16x8 bfr = *(const bf16x8*)(wsb + ((size_t)((w * 8 + ks) * 4 + tb) * 64 + lane) * 8);
                z[0][tb] = MFMA32(af[0], bfr, z[0][tb]); z[1][tb] = MFMA32(af[1], bfr, z[1][tb]); }
        }
        int lq = lane; asm volatile("" : "+v"(lq)); const int r32e = lq & 31, hie = lq >> 5, l8 = lq & 7, l3 = lq >> 3;
        const float* bsl = bs; const float* gnl = gn; asm volatile("" : "+s"(bsl), "+s"(gnl));
#pragma unroll
        for (int tb = 0; tb < 4; ++tb) { const int t = 32 * tb + r32e; const float bsv = bsl[w * 128 + t]; float sq = 0.f;
#pragma unroll
            for (int cb = 0; cb < 2; ++cb)
#pragma unroll
                for (int g4 = 0; g4 < 4; ++g4) { typedef unsigned u32x2_t __attribute__((ext_vector_type(2))); const u32x2_t ur = *(const LAS u32x2_t*)(wt + t * 128 + (((4 * cb + g4) ^ (t & 7)) << 4) + 8 * hie);
                    const float g0 = bflo(ur.x) * (z[cb][tb][4 * g4] + bsv), g1 = bfhi(ur.x) * (z[cb][tb][4 * g4 + 1] + bsv), g2 = bflo(ur.y) * (z[cb][tb][4 * g4 + 2] + bsv), g3 = bfhi(ur.y) * (z[cb][tb][4 * g4 + 3] + bsv);
                    z[cb][tb][4 * g4] = g0; z[cb][tb][4 * g4 + 1] = g1; z[cb][tb][4 * g4 + 2] = g2; z[cb][tb][4 * g4 + 3] = g3; sq += (g0 * g0 + g1 * g1) + (g2 * g2 + g3 * g3); }
            sq += __shfl_xor(sq, 32);
            if (hie == 0) SQ[w * 128 + t] = sq; asm volatile("" ::: "memory"); }
        __syncthreads();
#pragma unroll
        for (int tb = 0; tb < 4; ++tb) { const int t = 32 * tb + r32e; float tot = 0.f;
#pragma unroll
            for (int ww = 0; ww < 8; ++ww) tot += SQ[ww * 128 + t];
            const float rstd = rsqrtf(tot * (1.f / 512.f) + EPS);
#pragma unroll
            for (int cb = 0; cb < 2; ++cb)
#pragma unroll
                for (int g4 = 0; g4 < 4; ++g4) { const int c0 = 32 * cb + 8 * g4 + 4 * hie; const f32x4 gg = *(const f32x4*)(gnl + ch0 + c0);
                    *(LAS unsigned long long*)(wt + t * 128 + (((4 * cb + g4) ^ (t & 7)) << 4) + 8 * hie) = (unsigned long long)cvtpk(z[cb][tb][4 * g4] * rstd * gg.x, z[cb][tb][4 * g4 + 1] * rstd * gg.y) | ((unsigned long long)cvtpk(z[cb][tb][4 * g4 + 2] * rstd * gg.z, z[cb][tb][4 * g4 + 3] * rstd * gg.w) << 32); } asm volatile("" ::: "memory"); }
#pragma unroll
        for (int i = 0; i < 16; ++i) { const int t = 8 * i + l3; const v4u v = *(const LAS v4u*)(wt + t * 128 + ((l8 ^ (t & 7)) << 4));
            store16_wt(mix + ((size_t)b * SEQ + s0 + t) * DM + 512 + ch0 + l8 * 8, v); }
        mix_publish(F, b * SEQ + s0);
        __syncthreads();
    }
}

struct P5Ctx { LAS float* md; LAS float* wrT; const float* x; const bf16* t; unsigned char* h2; float* aff; bf16* x1; int lane, NGW; };
__device__ __forceinline__ void p5_issue(const P5Ctx& C, f32x4 (&xb)[4], uint2 (&tb)[4], int row) {
    const f32x4* xr = (const f32x4*)(C.x + (size_t)row * DM) + C.lane; const uint2* tr = (const uint2*)(C.t + (size_t)row * DM) + C.lane;
#pragma unroll
    for (int j = 0; j < 4; ++j) { xb[j] = __builtin_nontemporal_load(xr + 64 * j); { typedef unsigned u32x2_t __attribute__((ext_vector_type(2))); const u32x2_t tq = __builtin_nontemporal_load((const u32x2_t*)(tr + 64 * j)); tb[j].x = tq.x; tb[j].y = tq.y; } }
}
__device__ __forceinline__ void p5_row(const P5Ctx& C, const f32x4 (&g1q)[4], const f32x4 (&g2q)[4], f32x4 (&xb)[4], uint2 (&tb)[4], int m) {
    if (m >= NTOK) return;
    LAS float* md = C.md; LAS float* wrT = C.wrT; unsigned char* h2 = C.h2; float* aff = C.aff; const int lane = C.lane;
        const int b = m >> 13, s = m & 8191;
        f32x4 tv[4], xv[4]; float ss = 0.f;
#pragma unroll
        for (int j = 0; j < 4; ++j) { const uint2 tq = tb[j]; tv[j] = (f32x4){bflo(tq.x), bfhi(tq.x), bflo(tq.y), bfhi(tq.y)}; xv[j] = xb[j]; ss += (tv[j].x * tv[j].x + tv[j].y * tv[j].y) + (tv[j].z * tv[j].z + tv[j].w * tv[j].w); }
        const float rstd1 = rsqrtf(wave_sum(ss) * (1.f / DM) + EPS);
        float ss2 = 0.f; unsigned long long* orow = (unsigned long long*)(C.x1 + (size_t)m * DM) + lane;
#pragma unroll
        for (int j = 0; j < 4; ++j) { const int col = 4 * lane + 256 * j; const f32x4 gg = g1q[j], ga = *(const LAS f32x4*)(md + b * 3072 + col);
            xv[j] = xv[j] + ga * (tv[j] * rstd1 * gg); orow[64 * j] = (unsigned long long)cvtpk(xv[j].x, xv[j].y) | ((unsigned long long)cvtpk(xv[j].z, xv[j].w) << 32);
            ss2 += (xv[j].x * xv[j].x + xv[j].y * xv[j].y) + (xv[j].z * xv[j].z + xv[j].w * xv[j].w); }
        const float rstd2 = rsqrtf(wave_sum(ss2) * (1.f / DM) + EPS);
        unsigned* o8 = (unsigned*)(h2 + (size_t)m * DM) + lane;
        f32x4 hv[4];
#pragma unroll
        for (int j = 0; j < 4; ++j) { const int col = 4 * lane + 256 * j; const f32x4 gg = g2q[j];
            const f32x4 sh = *(const LAS f32x4*)(md + b * 3072 + 1024 + col), sc = *(const LAS f32x4*)(md + b * 3072 + 2048 + col);
            hv[j] = (xv[j] * rstd2 * gg) * (sc + 1.f) + sh;
            o8[64 * j] = pg8::pk4_fp8(hv[j].x, hv[j].y, hv[j].z, hv[j].w); }
        float lg[16];
#pragma unroll
        for (int eg = 0; eg < 4; ++eg) { f32x4 wv[4][4];
#pragma unroll
            for (int e4 = 0; e4 < 4; ++e4)
#pragma unroll
                for (int j = 0; j < 4; ++j) wv[e4][j] = *(const LAS f32x4*)(wrT + (4 * eg + e4) * DM + 4 * lane + 256 * j);
#pragma unroll
            for (int e4 = 0; e4 < 4; ++e4) { f32x2_t a2 = {0.f, 0.f};
#pragma unroll
                for (int j = 0; j < 4; ++j) { a2 += (f32x2_t){hv[j].x, hv[j].y} * (f32x2_t){wv[e4][j].x, wv[e4][j].y}; a2 += (f32x2_t){hv[j].z, hv[j].w} * (f32x2_t){wv[e4][j].z, wv[e4][j].w}; }
                float a = a2.x + a2.y; asm volatile("" : "+v"(a)); lg[4 * eg + e4] = a; } }
        float v8[8];
#pragma unroll
        for (int e = 0; e < 8; ++e) { const auto r = __builtin_amdgcn_permlane32_swap(__float_as_uint(lg[e]), __float_as_uint(lg[e + 8]), false, false); v8[e] = __uint_as_float(r[0]) + __uint_as_float(r[1]); }
        const bool b4 = (lane & 16) != 0, b3 = (lane & 8) != 0, b2 = (lane & 4) != 0;
        float v4[4];
#pragma unroll
        for (int i = 0; i < 4; ++i) { const float snd = b4 ? v8[i] : v8[i + 4], kp = b4 ? v8[i + 4] : v8[i]; v4[i] = kp + __shfl_xor(snd, 16); }
        float v2[2];
#pragma unroll
        for (int i = 0; i < 2; ++i) { const float snd = b3 ? v4[i] : v4[i + 2], kp = b3 ? v4[i + 2] : v4[i]; v2[i] = kp + __shfl_xor(snd, 8); }
        float tl; { const float snd = b2 ? v2[0] : v2[1], kp = b2 ? v2[1] : v2[0]; tl = kp + __shfl_xor(snd, 4); }
        DPP_ADDF(tl, 0x4E, 0xf); DPP_ADDF(tl, 0xB1, 0xf);
        const float mx = wave_max(tl), ex = __expf(tl - mx), se = wave_sum(ex) * 0.25f;
        if ((lane & 3) == 0) aff[(size_t)(b * NEXP + (lane >> 2)) * SEQ + s] = ex / se;
        if (m + C.NGW < NTOK) p5_issue(C, xb, tb, m + C.NGW);
}
__device__ __forceinline__ void p5_postmix(Frame& F) {
    LAS float* md = (LAS float*)(F.lds + RING_OFF);
    LAS float* wrT = (LAS float*)(F.lds + RING_OFF + 32768);
#pragma unroll 16
    for (int i = F.tid; i < DM * NEXP; i += NWAVES * 64) { const int col = i >> 4, e = i & 15; wrT[e * DM + col] = F.in[IN_WROUTER][i]; }
    modf_to_lds(F, md, 2048, 3072);
    const int gw = F.vcu * NWAVES + F.wave, NGW = F.G * NWAVES, lane = F.lane;
    const float* g1 = F.in[IN_NPOSTMIX]; const float* g2 = F.in[IN_NPREFFN];
    const P5Ctx C{md, wrT, F.in[IN_X], (const bf16*)(F.ws + WS_T), (unsigned char*)(F.ws + WS_H), (float*)(F.ws + WS_AFF), (bf16*)(F.ws + WS_X1), lane, NGW};
    f32x4 g1q[4], g2q[4];
#pragma unroll
    for (int j = 0; j < 4; ++j) { g1q[j] = *(const f32x4*)(g1 + 4 * lane + 256 * j); g2q[j] = *(const f32x4*)(g2 + 4 * lane + 256 * j); }
    f32x4 x0[4]; uint2 t0[4];
    if (gw < NTOK) p5_issue(C, x0, t0, gw);
#pragma unroll 1
    for (int m = gw; m < NTOK; m += NGW) p5_row(C, g1q, g2q, x0, t0, m);
    __syncthreads();
}

__device__ __forceinline__ void p6_topk(Frame& F) {
    LAS unsigned* vals = (LAS unsigned*)(F.lds + RING_OFF);
    LAS unsigned* hist = (LAS unsigned*)(F.lds + RING_OFF + 32768);
    LAS unsigned* misc = (LAS unsigned*)(F.lds + RING_OFF + 32768 + 1024);
    const int tid = F.tid, lane = F.lane, w = F.wave;
    const float* aff = (const float*)(F.ws + WS_AFF); int* slots = (int*)(F.ws + WS_SLOTS); int* idx = (int*)(F.ws + WS_IDX); float* gates = (float*)(F.ws + WS_GATES);
    if (F.vcu >= BATCH * NEXP) { if (F.G > BATCH * NEXP) p0_expert_items(F, XI_R1, XI_TOTAL, (F.vcu - BATCH * NEXP) * NWAVES + F.wave, (F.G - BATCH * NEXP) * NWAVES); return; }
    if (F.G <= BATCH * NEXP && F.vcu == 0) p0_expert_items(F, XI_R1, XI_TOTAL, F.wave, NWAVES);
    for (int unit = F.vcu; unit < BATCH * NEXP; unit += F.G) {
        const int b = unit >> 4, e = unit & 15;
        __syncthreads();
        const unsigned* src = (const unsigned*)(aff + (size_t)unit * SEQ);
        for (int i = tid; i < SEQ; i += NWAVES * 64) vals[i] = src[i];
        unsigned prefix = 0u, mask = 0u, need = CAP;
#pragma unroll 1
        for (int pass = 0; pass < 4; ++pass) {
            const int shift = 24 - 8 * pass;
            if (tid < 256) hist[tid] = 0u;
            __syncthreads();
            for (int i = tid; i < SEQ; i += NWAVES * 64) { const unsigned v = vals[i]; if ((v & mask) == prefix) __hip_atomic_fetch_add(&hist[(v >> shift) & 255u], 1u, __ATOMIC_RELAXED, __HIP_MEMORY_SCOPE_WORKGROUP); }
            __syncthreads();
            if (w == 0) {
                const unsigned b0 = hist[4 * lane], b1 = hist[4 * lane + 1], b2 = hist[4 * lane + 2], b3 = hist[4 * lane + 3];
                const unsigned sl = b0 + b1 + b2 + b3; unsigned suf = sl;
#pragma unroll
                for (int o = 1; o < 64; o <<= 1) { const unsigned tv = __shfl_down(suf, o); if (lane + o < 64) suf += tv; }
                const unsigned above = suf - sl;
                if (above < need && need <= above + sl) {
                    unsigned cnt = above, dig, nn;
                    if (cnt + b3 >= need) { dig = 3; nn = need - cnt; } else { cnt += b3;
                    if (cnt + b2 >= need) { dig = 2; nn = need - cnt; } else { cnt += b2;
                    if (cnt + b1 >= need) { dig = 1; nn = need - cnt; } else { cnt += b1; dig = 0; nn = need - cnt; } } }
                    misc[0] = 4u * lane + dig; misc[1] = nn; }
            }
            __syncthreads();
            prefix |= misc[0] << shift; mask |= 255u << shift; need = misc[1];
            __syncthreads();
        }
        const unsigned T = prefix; unsigned gt = 0u, eq = 0u; unsigned v16[16];
#pragma unroll
        for (int i = 0; i < 16; ++i) { v16[i] = vals[16 * tid + i]; gt += (v16[i] > T) ? 1u : 0u; eq += (v16[i] == T) ? 1u : 0u; }
        unsigned pk = gt | (eq << 16), inc = pk;
#pragma unroll
        for (int o = 1; o < 64; o <<= 1) { const unsigned tv = __shfl_up(inc, o); if (lane >= o) inc += tv; }
        if (lane == 63) misc[16 + w] = inc;
        __syncthreads();
        unsigned base = 0u;
#pragma unroll
        for (int ww = 0; ww < 8; ++ww) base += (ww < w) ? misc[16 + ww] : 0u;
        const unsigned exc = base + inc - pk; unsigned gtb = exc & 0xffffu, eqb = exc >> 16;
#pragma unroll
        for (int i = 0; i < 16; ++i) { const int tok = 16 * tid + i; const unsigned v = v16[i]; int slot = -1;
            if (v > T) { slot = (int)(gtb + (eqb < need ? eqb : need)); ++gtb; }
            else if (v == T) { if (eqb < need) slot = (int)(gtb + eqb); ++eqb; }
            slots[(size_t)(b * SEQ + tok) * NEXP + e] = slot;
            if (slot >= 0) { idx[(e * BATCH + b) * CAP + slot] = b * SEQ + tok; gates[unit * CAP + slot] = __uint_as_float(v); } }
    }
    __syncthreads();
}

__device__ __forceinline__ void p6b_gather(Frame& F) {
    const int gw = F.vcu * NWAVES + F.wave, NGW = F.G * NWAVES, lane = F.lane;
    const int* idx = (const int*)(F.ws + WS_IDX); const unsigned char* h2 = (const unsigned char*)(F.ws + WS_H); unsigned char* xs = (unsigned char*)(F.ws + WS_XS);
    for (int r = gw; r < NROWS_E; r += NGW) { const int e = r >> 11, b = (r >> 10) & 1, c = r & 1023; const int tok = idx[(b * NEXP + e) * CAP + c];
        const v4u* sp = (const v4u*)(h2 + (size_t)(b * SEQ + tok) * DM) + lane; v4u* dp = (v4u*)(xs + (size_t)r * DM) + lane;
        dp[0] = sp[0]; }
}

struct P10Batch { float gt[4]; unsigned ra[4][2], rc[4][2]; };
__device__ __forceinline__ void p10_issue(P10Batch& B, unsigned& mask, int slotv, int b, const float* gates, const unsigned char* yrows, int lane) {
    typedef unsigned u32x2_t __attribute__((ext_vector_type(2)));
#pragma unroll
    for (int q = 0; q < 4; ++q) { const bool ok = mask != 0u; const int e = ok ? __builtin_ctz(mask) : 0; mask = ok ? (mask & (mask - 1u)) : 0u;
        const int sl = ok ? __builtin_amdgcn_readlane(slotv, e) : 0;
        B.gt[q] = ok ? gates[(b * NEXP + e) * CAP + sl] * (1.f / Y8_SCALE) : 0.f; const unsigned char* yr = yrows + (size_t)(e * 2048 + b * 1024 + sl) * DM;
        const u32x2_t a = __builtin_nontemporal_load((const u32x2_t*)(yr + 8 * lane)), c = __builtin_nontemporal_load((const u32x2_t*)(yr + 512 + 8 * lane));
        B.ra[q][0] = a.x; B.ra[q][1] = a.y; B.rc[q][0] = c.x; B.rc[q][1] = c.y; }
}
__device__ __forceinline__ void p10_accum(const P10Batch& B, float (&y)[16]) {
#pragma unroll
    for (int q = 0; q < 4; ++q) { const float g = B.gt[q];
        const f32x2_t a0 = __builtin_amdgcn_cvt_pk_f32_fp8((int)B.ra[q][0], false), a1 = __builtin_amdgcn_cvt_pk_f32_fp8((int)B.ra[q][0], true), a2 = __builtin_amdgcn_cvt_pk_f32_fp8((int)B.ra[q][1], false), a3 = __builtin_amdgcn_cvt_pk_f32_fp8((int)B.ra[q][1], true);
        const f32x2_t c0 = __builtin_amdgcn_cvt_pk_f32_fp8((int)B.rc[q][0], false), c1 = __builtin_amdgcn_cvt_pk_f32_fp8((int)B.rc[q][0], true), c2 = __builtin_amdgcn_cvt_pk_f32_fp8((int)B.rc[q][1], false), c3 = __builtin_amdgcn_cvt_pk_f32_fp8((int)B.rc[q][1], true);
        y[0] += g * a0.x; y[1] += g * a0.y; y[2] += g * a1.x; y[3] += g * a1.y; y[4] += g * a2.x; y[5] += g * a2.y; y[6] += g * a3.x; y[7] += g * a3.y;
        y[8] += g * c0.x; y[9] += g * c0.y; y[10] += g * c1.x; y[11] += g * c1.y; y[12] += g * c2.x; y[13] += g * c2.y; y[14] += g * c3.x; y[15] += g * c3.y; }
}
__device__ __forceinline__ void p9_combine(Frame& F) {
    LAS float* md = (LAS float*)(F.lds + RING_OFF);
    modf_to_lds(F, md, 5120, 1024);
    const int gw = F.vcu * NWAVES + F.wave, NGW = F.G * NWAVES, lane = F.lane;
    const int* slots = (const int*)(F.ws + WS_SLOTS); const float* gates = (const float*)(F.ws + WS_GATES); const unsigned char* yrows = (const unsigned char*)(F.ws + WS_YROWS);
    const float* gn = F.in[IN_NPOSTFFN];
    f32x4 gnq[2][2];
#pragma unroll
    for (int hf = 0; hf < 2; ++hf)
#pragma unroll
        for (int qd = 0; qd < 2; ++qd) gnq[hf][qd] = *(const f32x4*)(gn + hf * 512 + 8 * lane + 4 * qd);
    int slot_c = -1, slot_n = -1; v4u x1c[2], x1n[2]; P10Batch Bc; unsigned mask_c = 0u;
    if (gw < NTOK) { slot_c = (lane < 16) ? slots[(size_t)gw * NEXP + lane] : -1; const bf16* xr = (const bf16*)(F.ws + WS_X1) + (size_t)gw * DM;
        x1c[0] = *(const v4u*)(xr + 8 * lane); x1c[1] = *(const v4u*)(xr + 512 + 8 * lane);
        mask_c = (unsigned)(__ballot(slot_c >= 0) & 0xffffull); p10_issue(Bc, mask_c, slot_c, gw >> 13, gates, yrows, lane); }
    if (gw + NGW < NTOK) { slot_n = (lane < 16) ? slots[(size_t)(gw + NGW) * NEXP + lane] : -1; const bf16* xr = (const bf16*)(F.ws + WS_X1) + (size_t)(gw + NGW) * DM;
        x1n[0] = *(const v4u*)(xr + 8 * lane); x1n[1] = *(const v4u*)(xr + 512 + 8 * lane); }
#pragma unroll 1
    for (int m = gw; m < NTOK; m += NGW) {
        const int b = m >> 13;
        P10Batch Bn; unsigned mask_n = 0u; const int slot_nn = slot_n; const v4u x1nn0 = x1n[0], x1nn1 = x1n[1];
        if (m + NGW < NTOK) { mask_n = (unsigned)(__ballot(slot_nn >= 0) & 0xffffull); p10_issue(Bn, mask_n, slot_nn, (m + NGW) >> 13, gates, yrows, lane); }
        if (m + 2 * NGW < NTOK) { slot_n = (lane < 16) ? slots[(size_t)(m + 2 * NGW) * NEXP + lane] : -1; const bf16* xr = (const bf16*)(F.ws + WS_X1) + (size_t)(m + 2 * NGW) * DM;
            x1n[0] = *(const v4u*)(xr + 8 * lane); x1n[1] = *(const v4u*)(xr + 512 + 8 * lane); }
        float y[16];
#pragma unroll
        for (int i = 0; i < 16; ++i) y[i] = 0.f;
        p10_accum(Bc, y);
        while (mask_c) { P10Batch Br; p10_issue(Br, mask_c, slot_c, b, gates, yrows, lane); p10_accum(Br, y); }
        float ss = 0.f;
#pragma unroll
        for (int i = 0; i < 16; ++i) ss += y[i] * y[i];
        const float rstd = rsqrtf(wave_sum(ss) * (1.f / DM) + EPS);
        float* orow = F.out + (size_t)m * DM;
#pragma unroll
        for (int hf = 0; hf < 2; ++hf) { const v4u xq = x1c[hf]; const float x1f[8] = {bflo(xq.x), bfhi(xq.x), bflo(xq.y), bfhi(xq.y), bflo(xq.z), bfhi(xq.z), bflo(xq.w), bfhi(xq.w)};
#pragma unroll
            for (int qd = 0; qd < 2; ++qd) { const int col = hf * 512 + 8 * lane + 4 * qd; const f32x4 gg = gnq[hf][qd], ga = *(const LAS f32x4*)(md + b * 1024 + col);
                f32x4 yv, x1; yv.x = y[hf * 8 + qd * 4 + 0]; yv.y = y[hf * 8 + qd * 4 + 1]; yv.z = y[hf * 8 + qd * 4 + 2]; yv.w = y[hf * 8 + qd * 4 + 3];
                x1.x = x1f[4 * qd]; x1.y = x1f[4 * qd + 1]; x1.z = x1f[4 * qd + 2]; x1.w = x1f[4 * qd + 3];
                __builtin_nontemporal_store(x1 + ga * (yv * rstd * gg), (f32x4*)(orow + col)); } }
        Bc = Bn; mask_c = mask_n; slot_c = slot_nn; x1c[0] = x1nn0; x1c[1] = x1nn1;
    }
}


__device__ __forceinline__ void ph2_inproj(Frame& F) {
    pg8::Gemm g{(const pg8::bf16_t*)(F.ws + WS_H), (const pg8::bf16_t*)(F.ws + WS_WINT), NTOK, D_IN, DM, nullptr}; pg8::StaticOrder S; S.init(NTOK, D_IN, F.G, (int)blockIdx.x);
    pg8::EpiProj E{(pg8::bf16_t*)(F.ws + WS_Q), (pg8::bf16_t*)(F.ws + WS_K), (pg8::bf16_t*)(F.ws + WS_VT), (pg8::bf16_t*)(F.ws + WS_U), (pg8::bf16_t*)(F.ws + WS_VGT), (float*)(F.ws + WS_VSTAT)};
    pg8::gemm_phase<pg8::EpiProj, pg8::StaticOrder, true, true>(F.lds + RING_OFF, g, S, E);
    { pg8::Unit u2; if (!S.next(1, u2)) {
        const int nlight = 2 * F.G - (NTOK / 256) * (D_IN / 256), first_light = F.G - nlight;
        if (nlight > 0 && (int)blockIdx.x >= first_light) p0_expert_items(F, XI_R0, XI_R1, ((int)blockIdx.x - first_light) * NWAVES + F.wave, nlight * NWAVES);
        else if (nlight <= 0 && blockIdx.x == 0) p0_expert_items(F, XI_R0, XI_R1, F.wave, NWAVES); } }
}
#ifndef PROBE_DUP
#define PROBE_DUP -1
#endif
__device__ __forceinline__ void ph3_mixer(Frame& F) { p3_attn_mfma(F); if (PROBE_DUP == 31) { __syncthreads(); p3_attn_mfma(F); } p3_gmlp_mfma(F); if (PROBE_DUP == 32) p3_gmlp_mfma(F); }
__device__ __forceinline__ void ph4_outproj(Frame& F) {
    pg8::Gemm g{(const pg8::bf16_t*)(F.ws + WS_MIX), (const pg8::bf16_t*)(F.ws + WS_WOUTT), NTOK, DM, DM, nullptr}; pg8::PanelReadyOrder S; S.init(NTOK, DM, F.G, (int)blockIdx.x);
    S.ready = (const unsigned*)(F.ctl + CW_MIXCNT); S.need = 80u;
    pg8::EpiDown E{(pg8::bf16_t*)(F.ws + WS_T), 4};
    pg8::gemm_phase<pg8::EpiDown, pg8::PanelReadyOrder, true, true>(F.lds + RING_OFF, g, S, E);
}
__device__ __forceinline__ void ph8_gateup(Frame& F) {
    pg8::Gemm g{(const pg8::bf16_t*)(F.ws + WS_H), (const pg8::bf16_t*)(F.ws + WS_WGUT), NROWS_E, 2 * D_FF, DM / 2, (const int*)(F.ws + WS_IDX)}; pg8::MoeOrder S; S.init(NEXP, 8, 22, F.G, (int)blockIdx.x);
    pg8::EpiSwiGLU8 E{(unsigned char*)(F.ws + WS_HID), 22, W8_INV};
    pg8::Unit u0;
    for (int base = 0; S.next(base, u0); base += 12) { pg8::SubOrder SS{S, base, 12};
        pg8::gemm_phase<pg8::EpiSwiGLU8, pg8::SubOrder, true, true, true, true, PF_DIST>(F.lds + RING_OFF, g, SS, E); }
}
__device__ __forceinline__ void ph9_down(Frame& F) {
    pg8::Gemm g{(const pg8::bf16_t*)(F.ws + WS_HID), (const pg8::bf16_t*)(F.ws + WS_WDT), NROWS_E, DM, D_FF / 2, nullptr}; pg8::MoeOrder S; S.init(NEXP, 8, 4, F.G, (int)blockIdx.x);
    pg8::EpiDown8 E{(unsigned char*)(F.ws + WS_YROWS), 4, W8_INV * Y8_SCALE};
    pg8::gemm_phase<pg8::EpiDown8, pg8::MoeOrder, true, true, true, false, PF_DIST>(F.lds + RING_OFF, g, S, E);
}
constexpr int NPHASES = 11;
#ifndef MK_N_LAUNCHES
#define MK_N_LAUNCHES 1
#endif
struct Args { const float* in[21]; float* out; unsigned char* ws; int ph_lo, ph_hi, li, pad; };
__global__ void __launch_bounds__(NWAVES * 64, 2) hymba_fwd(Args args) {
    extern __shared__ __attribute__((aligned(16))) unsigned char lds[];
    Frame F;
    F.lds = (LAS unsigned char*)lds;
    F.MISC = (volatile LAS unsigned*)(F.lds + MISC_OFF);
    F.tid = threadIdx.x; F.lane = F.tid & 63; F.wave = __builtin_amdgcn_readfirstlane(F.tid >> 6);
    F.G = gridDim.x; { const int bx = blockIdx.x; F.vcu = (F.G % 8 == 0) ? (bx % 8) * (F.G / 8) + bx / 8 : bx; }
#pragma unroll
    for (int i = 0; i < 21; ++i) F.in[i] = args.in[i];
    F.out = args.out; F.ws = args.ws; F.ctl = (gu32*)(args.ws + WS_CTL);
    for (int u = F.tid; u < (LDS_BYTES - LDSCTL_OFF) / 4; u += NWAVES * 64) ((LAS unsigned*)(F.lds + LDSCTL_OFF))[u] = 0u;
    __syncthreads();
    XcdBarrier bar; bar.bar = (unsigned*)(F.ctl + CW_BAR); bar.x = 0; bar.st = nullptr;
    const bool one_launch = (args.ph_hi - args.ph_lo) > 1;
    if (one_launch) bar = xcd_barrier_post((unsigned*)(F.ctl + CW_BAR), F.MISC + 8);
    const int lo = args.ph_lo, hi = args.ph_hi;
#ifndef PHASE_MASK
#define PHASE_MASK 0x7ff
#endif
#define IN(k) (((PHASE_MASK >> (k)) & 1) && lo <= (k) && (k) < hi)
#define BOTH(k) (IN(k) && IN((k) + 1))
#define GRID_BAR() xcd_barrier(bar)
#ifndef PROBE_DUP
#define PROBE_DUP -1
#endif
#define PHASE(k, call) if (IN(k)) { call; if (PROBE_DUP == (k)) { GRID_BAR(); call; } if (BOTH(k)) GRID_BAR(); }
    if (IN(0)) { p0_prologue(F); if (PROBE_DUP == 0) { GRID_BAR(); p0_prologue(F); } }
    PHASE(1, p1_prenorm(F))
    PHASE(2, ph2_inproj(F))
    if (IN(3)) { ph3_mixer(F); }
    PHASE(4, ph4_outproj(F))
    PHASE(5, p5_postmix(F))
    PHASE(6, p6_topk(F))
    PHASE(8, ph8_gateup(F))
    PHASE(9, ph9_down(F))
    if (IN(10)) { p9_combine(F); if (PROBE_DUP == 10) { GRID_BAR(); p9_combine(F); } }
#undef PHASE
#undef IN
#undef BOTH
#undef GRID_BAR
}

extern "C" void kernel_launch(void* const* d_in, const int* in_sizes, int n_in, void* d_out, int out_size, void* d_ws, size_t ws_size, hipStream_t stream) {
    static int grid = 0;
    if (grid == 0) {
        if (n_in != 21 || out_size != NTOK * DM || ws_size < WS_END) { fprintf(stderr, "kernel_launch: unexpected shapes (n_in %d out %d ws %zu)\n", n_in, out_size, ws_size); grid = -1; return; }
        int dev = 0, cus = 0;
        if (hipGetDevice(&dev) != hipSuccess || hipDeviceGetAttribute(&cus, hipDeviceAttributeMultiprocessorCount, dev) != hipSuccess) { grid = -1; return; }
        if (hipFuncSetAttribute((const void*)hymba_fwd, hipFuncAttributeMaxDynamicSharedMemorySize, LDS_BYTES) != hipSuccess) { fprintf(stderr, "kernel_launch: hipFuncSetAttribute failed\n"); grid = -1; return; }
        int per_cu = 0;
        if (hipOccupancyMaxActiveBlocksPerMultiprocessor(&per_cu, (const void*)hymba_fwd, NWAVES * 64, LDS_BYTES) != hipSuccess || per_cu < 1) fprintf(stderr, "kernel_launch: occupancy query reports %d\n", per_cu);
        (void)hipGetLastError();
        grid = cus;
    }
    if (grid < 0) return;
    (void)hipMemsetAsync((char*)d_ws + WS_CTL, 0, CTL_ZERO_BYTES, stream);
    Args a{};
    for (int i = 0; i < 21; ++i) a.in[i] = (const float*)d_in[i];
    a.out = (float*)d_out; a.ws = (unsigned char*)d_ws;
    if (MK_N_LAUNCHES == 1) { a.ph_lo = 0; a.ph_hi = NPHASES; a.li = 0; hipLaunchKernelGGL(hymba_fwd, dim3(grid), dim3(NWAVES * 64), LDS_BYTES, stream, a); }
    else for (int li = 0; li < NPHASES; ++li) { a.ph_lo = li; a.ph_hi = li + 1; a.li = li; hipLaunchKernelGGL(hymba_fwd, dim3(grid), dim3(NWAVES * 64), LDS_BYTES, stream, a); }
}
```

```cpp
#include <hip/hip_runtime.h>
#include <cstdio>
#include <cstdint>
namespace pg8 {
#define PG8_LAS __attribute__((address_space(3)))
typedef unsigned short bf16_t;
typedef short bf16x8 __attribute__((ext_vector_type(8)));
typedef float f32x4 __attribute__((ext_vector_type(4)));
typedef unsigned u32x4 __attribute__((ext_vector_type(4)));
constexpr int BM = 256, BK = 64, HALF = 128, HTB = HALF * BK * 2  , STAGE_BYTES = 8 * HTB, NXCD = 8, WGM = 8;

__host__ __device__ __forceinline__ int lds_byte(int r, int c) { const int st = (r >> 4) * 2 + (c >> 5), rr = r & 15, cc = c & 31, ob = rr * 64 + cc * 2; return st * 1024 + (ob ^ (((ob >> 9) & 1) << 5)); }
__host__ __device__ __forceinline__ void stage_rc(int b, int& R, int& C) { const int st = b / 1024, sb = b % 1024, swz = sb ^ (((sb >> 9) & 1) << 5); R = (st >> 1) * 16 + swz / 64; C = (st & 1) * 32 + (swz % 64) / 2; }
__host__ __device__ __forceinline__ int perm32(int rho) { const int n = rho >> 4, i = rho & 15; return 8 * (i >> 2) + 4 * n + (i & 3); }

struct Unit { int pm, pn; };
struct Gemm { const bf16_t* A; const bf16_t* Bt; int M, N, K; const int* rowmap; };

struct StaticOrder {
    int nM, nN, nwg, G, c;
    __host__ __device__ void init(int M, int N, int G_, int c_) { nM = M / BM; nN = N / BM; nwg = nM * nN; G = G_; c = c_; }
    __host__ __device__ bool next(int i, Unit& u) const {
        const long L = (long)i * G + c; if (L >= nwg) return false;
        int wgid = (int)L; { const int q = nwg / NXCD, r = nwg % NXCD, xcd = wgid % NXCD, off = wgid / NXCD; wgid = (xcd < r ? xcd * (q + 1) : r * (q + 1) + (xcd - r) * q) + off; }
        const int nig = WGM * nN, gid = wgid / nig, fm = gid * WGM, gsz = (nM - fm) < WGM ? (nM - fm) : WGM;
        u.pm = fm + ((wgid % nig) % gsz); u.pn = (wgid % nig) / gsz; return true;
    }
    __device__ __forceinline__ void a_ready(const Unit&) const {}
    __device__ __forceinline__ void done(const Unit&) const {}
};


typedef float f32x2 __attribute__((ext_vector_type(2))); typedef float f32x2_t __attribute__((ext_vector_type(2))); typedef __bf16 bf16x2_t __attribute__((ext_vector_type(2))); typedef int i32x4_t __attribute__((ext_vector_type(4)));
__device__ __forceinline__ unsigned cvtpk(float lo, float hi) { f32x2_t v = {lo, hi}; bf16x2_t b = __builtin_convertvector(v, bf16x2_t); return __builtin_bit_cast(unsigned, b); }
__device__ __forceinline__ bf16_t f2bf1(float f) { return (bf16_t)(cvtpk(f, 0.f) & 0xffffu); }
__device__ __forceinline__ void store8(bf16_t* p, const f32x4 v0, const f32x4 v1) {
    u32x4 w; w.x = cvtpk(v0[0], v0[1]); w.y = cvtpk(v0[2], v0[3]); w.z = cvtpk(v1[0], v1[1]); w.w = cvtpk(v1[2], v1[3]); *(u32x4*)p = w; }
__device__ __forceinline__ float gelu_tanh(float x) {
    const float t = x * __builtin_fmaf(x * x, -0.10294324f, -2.30220823f);
    return x * __builtin_amdgcn_rcpf(1.f + __builtin_amdgcn_exp2f(t));
}
__device__ __forceinline__ float silu_f(float x) { return x / (1.f + __expf(-x)); }

struct MoeOrder {
    int nE, nM, nN, U, G, c;
    __device__ void init(int nE_, int nM_, int nN_, int G_, int c_) { nE = nE_; nM = nM_; nN = nN_; U = nE * nM * nN; G = G_; c = c_; }
    __device__ bool next(int i, Unit& u) const {
        int gl;
        if ((G & 7) == 0 && (U & 7) == 0) { const int x = c & 7, j = c >> 3, per = G >> 3, li = i * per + j, ux = U >> 3; if (li >= ux) return false; gl = x * ux + li; }
        else { const long L = (long)i * G + c; if (L >= U) return false; gl = (int)L; }
        const int per_e = nM * nN, e = gl / per_e, r = gl % per_e;
        u.pm = e * nM + (r % nM); u.pn = e * nN + (r / nM); return true;
    }
    __device__ __forceinline__ void a_ready(const Unit&) const {}
    __device__ __forceinline__ void done(const Unit&) const {}
};

struct SubOrder {
    MoeOrder S; int base, cnt;
    __device__ bool next(int i, Unit& u) const { return i < cnt && S.next(base + i, u); }
    __device__ __forceinline__ void a_ready(const Unit&) const {}
    __device__ __forceinline__ void done(const Unit&) const {}
};

struct EpiProj {
    static constexpr bool PERM = true, AFTER_DRAIN = false;
    bf16_t *q, *k, *vT, *u, *vgT; float* vstat;
    __device__ __forceinline__ void operator()(const f32x4 (&acc)[2][2][4][2], const Unit& un, int wr, int wc, int fr, int fq) const {
        const int row0 = un.pm * BM + wr * 64 + fr, pn = un.pn, cw = wc * 32 + 8 * fq;
        const int b = (un.pm * BM) >> 13;
        if (pn < 2) {
#pragma unroll
            for (int ai = 0; ai < 2; ++ai)
#pragma unroll
                for (int m = 0; m < 4; ++m) { bf16_t* rowp = q + (size_t)(row0 + ai * HALF + m * 16) * 512 + pn * 256 + cw;
#pragma unroll
                    for (int bj = 0; bj < 2; ++bj) store8(rowp + bj * HALF, acc[ai][bj][m][0], acc[ai][bj][m][1]); }
        } else if (pn == 2) {
#pragma unroll
            for (int ai = 0; ai < 2; ++ai)
#pragma unroll
                for (int m = 0; m < 4; ++m) { const int r = row0 + ai * HALF + m * 16, s = r & 8191;
                    store8(k + (size_t)r * 128 + cw, acc[ai][0][m][0], acc[ai][0][m][1]);
#pragma unroll
                    for (int n = 0; n < 2; ++n)
#pragma unroll
                        for (int j = 0; j < 4; ++j) vT[(size_t)(b * 128 + cw + 4 * n + j) * 8192 + s] = f2bf1(acc[ai][1][m][n][j]); }
        } else if (pn < 5) {
#pragma unroll
            for (int ai = 0; ai < 2; ++ai)
#pragma unroll
                for (int m = 0; m < 4; ++m) { bf16_t* rowp = u + (size_t)(row0 + ai * HALF + m * 16) * 512 + (pn - 3) * 256 + cw;
#pragma unroll
                    for (int bj = 0; bj < 2; ++bj) { f32x4 v0 = acc[ai][bj][m][0], v1 = acc[ai][bj][m][1];
#pragma unroll
                        for (int j = 0; j < 4; ++j) { v0[j] = gelu_tanh(v0[j]); v1[j] = gelu_tanh(v1[j]); }
                        store8(rowp + bj * HALF, v0, v1); } }
        } else {
#pragma unroll
            for (int ai = 0; ai < 2; ++ai)
#pragma unroll
                for (int m = 0; m < 4; ++m) { const int r = row0 + ai * HALF + m * 16, s = r & 8191, nch = s >> 7, sl = s & 127, ks = sl >> 4, hi = (sl >> 3) & 1, jj = sl & 7;
                    float ps = 0.f, pq = 0.f;
#pragma unroll
                    for (int bj = 0; bj < 2; ++bj)
#pragma unroll
                        for (int n = 0; n < 2; ++n)
#pragma unroll
                            for (int j = 0; j < 4; ++j) { const int ch = (pn - 5) * 256 + bj * HALF + cw + 4 * n + j, g = ch >> 6, cb = (ch >> 5) & 1, r32 = ch & 31;
                                const bf16_t hb = f2bf1(gelu_tanh(acc[ai][bj][m][n][j])); const float hv = __uint_as_float((unsigned)hb << 16); ps += hv; pq += hv * hv;
                                vgT[((((size_t)(b * 64 + nch) * 8 + g) * 2 + cb) * 8 + ks) * 512 + (hi * 32 + r32) * 8 + jj] = hb; }
                    ps += __shfl_xor(ps, 16); ps += __shfl_xor(ps, 32); pq += __shfl_xor(pq, 16); pq += __shfl_xor(pq, 32);
                    if (fq == 0) { f32x2 st2 = {ps, pq}; *(f32x2*)(vstat + ((size_t)((pn - 5) * 4 + wc) * 16384 + r) * 2) = st2; } }
        }
    }
};

struct EpiF32 {
    static constexpr bool PERM = false, AFTER_DRAIN = false;
    float* C; int ldc;
    __device__ __forceinline__ void operator()(const f32x4 (&acc)[2][2][4][2], const Unit& u, int wr, int wc, int fr, int fq) const {
        const int row0 = u.pm * BM + wr * 64 + fr, col0 = u.pn * BM + wc * 32 + 4 * fq;
#pragma unroll
        for (int ai = 0; ai < 2; ++ai)
#pragma unroll
            for (int m = 0; m < 4; ++m) { float* rowp = C + (size_t)(row0 + ai * HALF + m * 16) * ldc + col0;
#pragma unroll
                for (int bj = 0; bj < 2; ++bj)
#pragma unroll
                    for (int n = 0; n < 2; ++n) *(f32x4*)(rowp + bj * HALF + n * 16) = acc[ai][bj][m][n]; }
    }
};

struct EpiSwiGLU {
    static constexpr bool PERM = true, AFTER_DRAIN = false;
    bf16_t* hid; int nN;
    __device__ __forceinline__ void operator()(const f32x4 (&acc)[2][2][4][2], const Unit& un, int wr, int wc, int fr, int fq) const {
        const int row0 = un.pm * BM + wr * 64 + fr, pnl = un.pn % nN, col0 = pnl * HALF + wc * 32 + 8 * fq;
#pragma unroll
        for (int ai = 0; ai < 2; ++ai)
#pragma unroll
            for (int m = 0; m < 4; ++m) { bf16_t* rowp = hid + (size_t)(row0 + ai * HALF + m * 16) * 2816 + col0;
                f32x4 v0, v1;
#pragma unroll
                for (int j = 0; j < 4; ++j) { v0[j] = silu_f(acc[ai][0][m][0][j]) * acc[ai][1][m][0][j]; v1[j] = silu_f(acc[ai][0][m][1][j]) * acc[ai][1][m][1][j]; }
                store8(rowp, v0, v1); }
    }
};

struct EpiDown {
    static constexpr bool PERM = true, AFTER_DRAIN = false;
    bf16_t* y; int nN;
    __device__ __forceinline__ void operator()(const f32x4 (&acc)[2][2][4][2], const Unit& un, int wr, int wc, int fr, int fq) const {
        const int row0 = un.pm * BM + wr * 64 + fr, pnl = un.pn % nN, col0 = pnl * BM + wc * 32 + 8 * fq;
#pragma unroll
        for (int ai = 0; ai < 2; ++ai)
#pragma unroll
            for (int m = 0; m < 4; ++m) { bf16_t* rowp = y + (size_t)(row0 + ai * HALF + m * 16) * 1024 + col0;
#pragma unroll
                for (int bj = 0; bj < 2; ++bj) store8(rowp + bj * HALF, acc[ai][bj][m][0], acc[ai][bj][m][1]); }
    }
};

__device__ __forceinline__ unsigned pk4_fp8(float a, float b, float c, float d) { int w = __builtin_amdgcn_cvt_pk_fp8_f32(a, b, 0, false); w = __builtin_amdgcn_cvt_pk_fp8_f32(c, d, w, true); return (unsigned)w; }
__device__ __forceinline__ float clamp448(float x) { return __builtin_fminf(__builtin_fmaxf(x, -448.f), 448.f); }
struct EpiSwiGLU8 {
    static constexpr bool PERM = true, AFTER_DRAIN = false;
    unsigned char* hid; int nN; float inv_scale;
    __device__ __forceinline__ void operator()(const f32x4 (&acc)[2][2][4][2], const Unit& un, int wr, int wc, int fr, int fq) const {
        const int row0 = un.pm * BM + wr * 64 + fr, pnl = un.pn % nN, col0 = pnl * HALF + wc * 32 + 8 * fq;
        const float c1 = -inv_scale * 1.4426950408889634f, s2 = inv_scale * inv_scale;
#pragma unroll
        for (int ai = 0; ai < 2; ++ai)
#pragma unroll
            for (int m = 0; m < 4; ++m) { unsigned char* rowp = hid + (size_t)(row0 + ai * HALF + m * 16) * 2816 + col0;
                float v[8];
#pragma unroll
                for (int n = 0; n < 2; ++n)
#pragma unroll
                    for (int j = 0; j < 4; j += 2) { const f32x2 g = {acc[ai][0][m][n][j], acc[ai][0][m][n][j + 1]}, u = {acc[ai][1][m][n][j], acc[ai][1][m][n][j + 1]};
                        const f32x2 p = (g * u) * s2, x = g * c1; f32x2 d; d.x = __builtin_amdgcn_exp2f(x.x); d.y = __builtin_amdgcn_exp2f(x.y); d = d + 1.0f;
                        f32x2 r; r.x = __builtin_amdgcn_rcpf(d.x); r.y = __builtin_amdgcn_rcpf(d.y); const f32x2 o = p * r;
                        v[4 * n + j] = __builtin_amdgcn_fmed3f(o.x, -448.f, 448.f); v[4 * n + j + 1] = __builtin_amdgcn_fmed3f(o.y, -448.f, 448.f); }
                uint2 w; w.x = pk4_fp8(v[0], v[1], v[2], v[3]); w.y = pk4_fp8(v[4], v[5], v[6], v[7]); *(uint2*)rowp = w; }
    }
};
struct EpiDown8 {
    static constexpr bool PERM = true, AFTER_DRAIN = false;
    unsigned char* y; int nN; float inv_scale;
    __device__ __forceinline__ void operator()(const f32x4 (&acc)[2][2][4][2], const Unit& un, int wr, int wc, int fr, int fq) const {
        const int row0 = un.pm * BM + wr * 64 + fr, pnl = un.pn % nN, col0 = pnl * BM + wc * 32 + 8 * fq;
#pragma unroll
        for (int ai = 0; ai < 2; ++ai)
#pragma unroll
            for (int m = 0; m < 4; ++m) { unsigned char* rowp = y + (size_t)(row0 + ai * HALF + m * 16) * 1024 + col0;
#pragma unroll
                for (int bj = 0; bj < 2; ++bj) { const f32x4 v0 = acc[ai][bj][m][0] * inv_scale, v1 = acc[ai][bj][m][1] * inv_scale;
                    uint2 w; w.x = pk4_fp8(__builtin_amdgcn_fmed3f(v0[0], -448.f, 448.f), __builtin_amdgcn_fmed3f(v0[1], -448.f, 448.f), __builtin_amdgcn_fmed3f(v0[2], -448.f, 448.f), __builtin_amdgcn_fmed3f(v0[3], -448.f, 448.f));
                    w.y = pk4_fp8(__builtin_amdgcn_fmed3f(v1[0], -448.f, 448.f), __builtin_amdgcn_fmed3f(v1[1], -448.f, 448.f), __builtin_amdgcn_fmed3f(v1[2], -448.f, 448.f), __builtin_amdgcn_fmed3f(v1[3], -448.f, 448.f));
                    *(uint2*)(rowp + bj * HALF) = w; } }
    }
};
typedef int i32x8_t __attribute__((ext_vector_type(8)));
template <bool FP8> struct OperandT { typedef bf16x8 type; };
template <> struct OperandT<true> { typedef i32x8_t type; };
__device__ __forceinline__ void ld_bf16(bf16x8& d, const PG8_LAS unsigned char* p) { d = *(const PG8_LAS bf16x8*)p; }
__device__ __forceinline__ void ld_bf16(i32x8_t&, const PG8_LAS unsigned char*) {}
__device__ __forceinline__ void ld_fp8(i32x8_t& d, const PG8_LAS unsigned char* p) { const i32x4_t lo = *(const PG8_LAS i32x4_t*)p, hi = *(const PG8_LAS i32x4_t*)(p + 1024); d = __builtin_shufflevector(lo, hi, 0, 1, 2, 3, 4, 5, 6, 7); }
__device__ __forceinline__ void ld_fp8(bf16x8&, const PG8_LAS unsigned char*) {}
__device__ __forceinline__ f32x4 mma_bf16(const bf16x8& a, const bf16x8& b, const f32x4& c) { return __builtin_amdgcn_mfma_f32_16x16x32_bf16(a, b, c, 0, 0, 0); }
__device__ __forceinline__ f32x4 mma_bf16(const i32x8_t&, const i32x8_t&, const f32x4& c) { return c; }
__device__ __forceinline__ f32x4 mma_fp8(const i32x8_t& a, const i32x8_t& b, const f32x4& c) { f32x4 d = c; const int sc = 0x7f7f7f7f;
    asm volatile("v_mfma_scale_f32_16x16x128_f8f6f4 %0, %1, %2, %0, %3, %3 op_sel_hi:[0,0,0]" : "+v"(d) : "v"(a), "v"(b), "v"(sc)); return d; }
__device__ __forceinline__ f32x4 mma_fp8(const bf16x8&, const bf16x8&, const f32x4& c) { return c; }
template <class Epi, class Sched, bool ALIGN_EPI = false, bool SP2 = false, bool FP8 = false, bool GATHER = false, int PF = 0, bool BTM = false>
__device__ __forceinline__ void gemm_phase(PG8_LAS unsigned char* lds, const Gemm g, const Sched& S, const Epi& E) {
    const int tid = threadIdx.x, wid = __builtin_amdgcn_readfirstlane(tid >> 6), lane = tid & 63, wr = wid >> 2, wc = wid & 3, fr = lane & 15, fq = lane >> 4;
    const int K = g.K, nt = K / BK;
    unsigned voffA[2], voffB[2];
#pragma unroll
    for (int i = 0; i < 2; ++i) { int R, C; stage_rc(tid * 16 + i * 8192, R, C); const int Rb = Epi::PERM ? ((R & ~31) + perm32(R & 31)) : R;
        voffA[i] = (unsigned)(R * K + C) * 2u; voffB[i] = BTM ? (unsigned)(Rb * BK + C) * 2u : (unsigned)(Rb * K + C) * 2u; }
    const size_t kstep = (size_t)(BK * 2);
    const size_t hstep = (size_t)HALF * K * 2;
    const size_t kstepB = BTM ? (size_t)BM * BK * 2 : kstep, hstepB = BTM ? (size_t)HALF * BK * 2 : hstep;
    const size_t tstep = 2 * hstep;
    const unsigned ldsw = (unsigned)wid * 1024u;
    const int aoff = lds_byte(wr * 64 + fr, fq * 8), boff = lds_byte(wc * 32 + fr, fq * 8);
#define PG8_SA(b, h) (((b) * 2 + (h)) * HTB)
#define PG8_SB(b, h) ((4 + (b) * 2 + (h)) * HTB)
#define PG8_STAGE(bufoff, gbase, voff) do { _Pragma("unroll") for (int _i = 0; _i < 2; ++_i) \
        __builtin_amdgcn_global_load_lds((const unsigned*)((const char*)(gbase) + (voff)[_i]), (PG8_LAS unsigned*)(lds + (bufoff) + ldsw + _i * 8192), 16, 0, 0); } while (0)
#define PG8_STAGE_A(bufoff, gbase, h, usenext) do { if constexpr (GATHER) { _Pragma("unroll") for (int _i = 0; _i < 2; ++_i) \
        __builtin_amdgcn_global_load_lds((const unsigned*)((const char*)(gbase) + ((usenext) ? vgn[h][_i] : vgc[h][_i])), (PG8_LAS unsigned*)(lds + (bufoff) + ldsw + _i * 8192), 16, 0, 0); } \
    else { PG8_STAGE(bufoff, (gbase) + ((h) ? hstep : 0), voffA); } } while (0)
#define PG8_LD2(base) PG8_CAT(*(const PG8_LAS i32x4_t*)(base), *(const PG8_LAS i32x4_t*)((base) + 1024))
#define PG8_LDA(dst, b, h) do { _Pragma("unroll") for (int m = 0; m < 4; ++m) { if constexpr (FP8) { ld_fp8(dst[m][0], lds + PG8_SA(b, h) + aoff + m * 2048); } else { _Pragma("unroll") for (int k = 0; k < (FP8 ? 1 : 2); ++k) ld_bf16(dst[m][k], lds + PG8_SA(b, h) + aoff + m * 2048 + k * 1024); } } } while (0)
#define PG8_LDB(dst, b, h) do { _Pragma("unroll") for (int n = 0; n < 2; ++n) { if constexpr (FP8) { ld_fp8(dst[n][0], lds + PG8_SB(b, h) + boff + n * 2048); } else { _Pragma("unroll") for (int k = 0; k < (FP8 ? 1 : 2); ++k) ld_bf16(dst[n][k], lds + PG8_SB(b, h) + boff + n * 2048 + k * 1024); } } } while (0)
#define PG8_MMA(ai, bj, At, Bt) do { __builtin_amdgcn_s_setprio(1); _Pragma("unroll") for (int m = 0; m < 4; ++m) _Pragma("unroll") for (int n = 0; n < 2; ++n) { \
        if constexpr (FP8) { acc[ai][bj][m][n] = mma_fp8(Bt[n][0], At[m][0], acc[ai][bj][m][n]); } \
        else { _Pragma("unroll") for (int k = 0; k < (FP8 ? 1 : 2); ++k) acc[ai][bj][m][n] = mma_bf16(Bt[n][k], At[m][k], acc[ai][bj][m][n]); } } __builtin_amdgcn_s_setprio(0); } while (0)
#define PG8_WAIT_V(n) asm volatile("s_waitcnt vmcnt(" #n ")" ::: "memory")
#define PG8_WAIT_L(n) asm volatile("s_waitcnt lgkmcnt(" #n ")" ::: "memory")
#define PG8_BAR __builtin_amdgcn_s_barrier()
#define PG8_SCHED __builtin_amdgcn_sched_barrier(0)
    Unit cur, nxt; int ui = 0;
    if (!S.next(0, cur)) return;
    f32x4 acc[2][2][4][2];
#pragma unroll
    for (int a = 0; a < 2; ++a)
#pragma unroll
        for (int b = 0; b < 2; ++b)
#pragma unroll
            for (int m = 0; m < 4; ++m)
#pragma unroll
                for (int n = 0; n < 2; ++n) acc[a][b][m][n] = (f32x4){0.f, 0.f, 0.f, 0.f};
    typename OperandT<FP8>::type At[4][FP8 ? 1 : 2], B0[2][FP8 ? 1 : 2], B1[2][FP8 ? 1 : 2];
    const char* cA = GATHER ? (const char*)g.A : (const char*)g.A + (size_t)cur.pm * tstep; const char* cB = (const char*)g.Bt + (size_t)cur.pn * tstep;
    unsigned vgc[2][2], vgn[2][2]; int stR[2], stC[2];
#pragma unroll
    for (int i = 0; i < 2; ++i) { stage_rc(tid * 16 + i * 8192, stR[i], stC[i]); }
    constexpr int RM_MAXU = 12; PG8_LAS int* rml = (PG8_LAS int*)(lds + STAGE_BYTES);
    if constexpr (GATHER) { Unit uu;
        for (int i = 0; i < RM_MAXU && S.next(i, uu); ++i) { if (tid < BM) rml[i * BM + tid] = g.rowmap[uu.pm * BM + tid]; }
        asm volatile("s_waitcnt vmcnt(0) lgkmcnt(0)" ::: "memory"); __builtin_amdgcn_s_barrier(); asm volatile("" ::: "memory"); }
#define PG8_GOFF(dst, uidx, pmv) do { _Pragma("unroll") for (int _h = 0; _h < 2; ++_h) _Pragma("unroll") for (int _i = 0; _i < 2; ++_i) { \
        const int _r = _h * HALF + stR[_i]; const int _row = !GATHER ? 0 : rml[(uidx) * BM + _r]; \
        dst[_h][_i] = ((unsigned)_row * (unsigned)K + (unsigned)stC[_i]) * 2u; } } while (0)
    PG8_GOFF(vgc, 0, cur.pm);
    static_assert(PF == 0 || SP2, "the L2 prefetch is wired into the super-phase loop only");
    const size_t rowb = (size_t)K * 2;
#define PG8_PFBASE(un, uidx) ((tid < BM) ? (GATHER ? (unsigned)rml[(GATHER ? (uidx) : 0) * BM + (tid & (BM - 1))] * (unsigned)rowb : ((unsigned)(un).pm * BM + tid) * (unsigned)rowb) \
                                         : ((unsigned)(un).pn * BM + (tid - BM)) * (unsigned)rowb)
    unsigned pfc = PF ? PG8_PFBASE(cur, 0) : 0u; unsigned pfn = pfc;
#define PG8_PREFETCH(tt) do { if constexpr (PF > 0) { const int _tt = (tt); const bool _in = _tt < nt; const char* _b = (tid < BM) ? (const char*)g.A : (const char*)g.Bt; \
        const char* _p = (_in || !has_next) ? _b + pfc + (size_t)(_in ? _tt : 0) * kstep : _b + pfn + (size_t)(_tt - nt) * kstep; \
        __builtin_amdgcn_global_load_lds((const unsigned*)_p, (PG8_LAS unsigned*)(lds + STAGE_BYTES + 12032), 4, 0, 0); } } while (0)
#define PG8_WAIT_VL() do { if constexpr (PF > 0) PG8_WAIT_V(9); else PG8_WAIT_V(8); } while (0)
#pragma unroll
    for (int h_ = 0; h_ < 2; ++h_) { vgn[h_][0] = vgc[h_][0]; vgn[h_][1] = vgc[h_][1]; }
    S.a_ready(cur);
    if constexpr (SP2) {
        PG8_STAGE(PG8_SB(0, 0), cB, voffB); PG8_STAGE(PG8_SB(0, 1), cB + hstepB, voffB); PG8_STAGE_A(PG8_SA(0, 0), cA, 0, false); PG8_STAGE_A(PG8_SA(0, 1), cA, 1, false);
        if (wr == 1) PG8_BAR;
        PG8_WAIT_V(2); PG8_BAR;
        PG8_STAGE(PG8_SB(1, 0), cB + kstepB, voffB); PG8_STAGE_A(PG8_SA(1, 0), cA + kstep, 0, false); PG8_STAGE(PG8_SB(1, 1), cB + hstepB + kstepB, voffB);
        PG8_WAIT_V(6); PG8_BAR;
    } else {
        PG8_STAGE(PG8_SB(0, 0), cB, voffB); PG8_STAGE_A(PG8_SA(0, 0), cA, 0, false); PG8_STAGE(PG8_SB(0, 1), cB + hstepB, voffB); PG8_STAGE_A(PG8_SA(0, 1), cA, 1, false);
        if (wr == 1) PG8_BAR;
        PG8_WAIT_V(4); PG8_BAR;
        PG8_STAGE(PG8_SB(1, 0), cB + kstepB, voffB); PG8_STAGE_A(PG8_SA(1, 0), cA + kstep, 0, false); PG8_STAGE(PG8_SB(1, 1), cB + hstepB + kstepB, voffB);
        PG8_WAIT_V(6); PG8_BAR;
    }
    for (;;) {
        const bool has_next = S.next(ui + 1, nxt);
        if constexpr (GATHER) { if (has_next) PG8_GOFF(vgn, ui + 1, nxt.pm); }
        if constexpr (PF > 0) { if (has_next) pfn = PG8_PFBASE(nxt, ui + 1); }
        const char* nA = (has_next && !GATHER) ? (const char*)g.A + (size_t)nxt.pm * tstep : cA; const char* nB = has_next ? (const char*)g.Bt + (size_t)nxt.pn * tstep : cB;
#pragma unroll 1
        for (int t = 0; t < nt; t += 2) {
            const bool last = (t == nt - 2);
            const char* a1 = cA + (size_t)(t + 1) * kstep;
            const char* a2 = last ? nA : cA + (size_t)(t + 2) * kstep; const char* b2 = last ? nB : cB + (size_t)(t + 2) * kstepB;
            const char* a3 = a2 + kstep; const char* b3 = b2 + kstepB;
            if (last && has_next) S.a_ready(nxt);
            if constexpr (SP2) {
            PG8_LDB(B0, 0, 0); PG8_LDB(B1, 0, 1); PG8_SCHED; PG8_LDA(At, 0, 0); PG8_STAGE_A(PG8_SA(1, 1), a1, 1, false); PG8_PREFETCH(t + PF);
            PG8_WAIT_VL(); PG8_WAIT_L(0); PG8_BAR; PG8_MMA(0, 0, At, B0); PG8_MMA(0, 1, At, B1); PG8_BAR; PG8_SCHED;
            PG8_LDA(At, 0, 1); PG8_STAGE(PG8_SB(0, 0), b2, voffB); PG8_STAGE(PG8_SB(0, 1), b2 + hstepB, voffB); PG8_STAGE_A(PG8_SA(0, 0), a2, 0, last);
            PG8_WAIT_VL(); PG8_WAIT_L(0); PG8_BAR; PG8_MMA(1, 0, At, B0); PG8_MMA(1, 1, At, B1); PG8_BAR; PG8_SCHED;
            PG8_LDB(B0, 1, 0); PG8_LDB(B1, 1, 1); PG8_SCHED; PG8_LDA(At, 1, 0); PG8_STAGE_A(PG8_SA(0, 1), a2, 1, last); PG8_PREFETCH(t + 1 + PF);
            PG8_WAIT_VL(); PG8_WAIT_L(0); PG8_BAR; PG8_MMA(0, 0, At, B0); PG8_MMA(0, 1, At, B1); PG8_BAR; PG8_SCHED;
            PG8_LDA(At, 1, 1); PG8_STAGE(PG8_SB(1, 0), b3, voffB); PG8_STAGE(PG8_SB(1, 1), b3 + hstepB, voffB); PG8_STAGE_A(PG8_SA(1, 0), a3, 0, last);
            PG8_WAIT_VL(); PG8_WAIT_L(0); PG8_BAR; PG8_MMA(1, 0, At, B0); PG8_MMA(1, 1, At, B1); PG8_BAR; PG8_SCHED;
            } else {
            PG8_LDB(B0, 0, 0); PG8_SCHED; PG8_LDA(At, 0, 0); PG8_STAGE_A(PG8_SA(1, 1), a1, 1, false);
            PG8_WAIT_L(8); PG8_BAR; PG8_WAIT_L(0); PG8_MMA(0, 0, At, B0); PG8_BAR; PG8_SCHED;
            PG8_LDB(B1, 0, 1); PG8_STAGE(PG8_SB(0, 0), b2, voffB);
            PG8_BAR; PG8_WAIT_L(0); PG8_MMA(0, 1, At, B1); PG8_BAR;
            PG8_LDA(At, 0, 1); PG8_STAGE_A(PG8_SA(0, 0), a2, 0, last);
            PG8_BAR; PG8_WAIT_L(0); PG8_MMA(1, 0, At, B0); PG8_BAR; PG8_SCHED;
            PG8_STAGE(PG8_SB(0, 1), b2 + hstepB, voffB);
            PG8_WAIT_V(6); PG8_BAR; PG8_MMA(1, 1, At, B1); PG8_BAR;
            PG8_LDB(B0, 1, 0); PG8_SCHED; PG8_LDA(At, 1, 0); PG8_STAGE_A(PG8_SA(0, 1), a2, 1, last);
            PG8_WAIT_L(8); PG8_BAR; PG8_WAIT_L(0); PG8_MMA(0, 0, At, B0); PG8_BAR; PG8_SCHED;
            PG8_LDB(B1, 1, 1); PG8_STAGE(PG8_SB(1, 0), b3, voffB);
            PG8_BAR; PG8_WAIT_L(0); PG8_MMA(0, 1, At, B1); PG8_BAR;
            PG8_LDA(At, 1, 1); PG8_STAGE_A(PG8_SA(1, 0), a3, 0, last);
            PG8_BAR; PG8_WAIT_L(0); PG8_MMA(1, 0, At, B0); PG8_BAR; PG8_SCHED;
            PG8_STAGE(PG8_SB(1, 1), b3 + hstepB, voffB);
            PG8_WAIT_V(6); PG8_BAR; PG8_MMA(1, 1, At, B1); PG8_BAR;
            }
        }
        if constexpr (FP8) { asm volatile("s_nop 15\n\ts_nop 15" ::: "memory"); }
        if constexpr (ALIGN_EPI) { if (wr == 0) PG8_BAR; }
        if constexpr (!Epi::AFTER_DRAIN) { E(acc, cur, wr, wc, fr, fq); S.done(cur); }
        if (!has_next) break;
#pragma unroll
        for (int a = 0; a < 2; ++a)
#pragma unroll
            for (int b = 0; b < 2; ++b)
#pragma unroll
                for (int m = 0; m < 4; ++m)
#pragma unroll
                    for (int n = 0; n < 2; ++n) acc[a][b][m][n] = (f32x4){0.f, 0.f, 0.f, 0.f};
        cur = nxt; cA = nA; cB = nB; ++ui; pfc = pfn;
        if constexpr (GATHER) {
#pragma unroll
            for (int h_ = 0; h_ < 2; ++h_) { vgc[h_][0] = vgn[h_][0]; vgc[h_][1] = vgn[h_][1]; } }
        if constexpr (ALIGN_EPI) { if (wr == 1) PG8_BAR; }
    }
    PG8_WAIT_V(0);
    if constexpr (!ALIGN_EPI) { if (wr == 0) PG8_BAR; }
    PG8_BAR;
    if constexpr (Epi::AFTER_DRAIN) { E.fused(acc, cur, wr, wc, fr, fq, lds, wid, lane); S.done(cur); }
#undef PG8_SA
#undef PG8_SB
#undef PG8_STAGE
#undef PG8_STAGE_A
#undef PG8_GOFF
#undef PG8_PFBASE
#undef PG8_PREFETCH
#undef PG8_WAIT_VL
#undef PG8_LDA
#undef PG8_LDB
#undef PG8_MMA
#undef PG8_LD2
#undef PG8_WAIT_V
#undef PG8_WAIT_L
#undef PG8_BAR
#undef PG8_SCHED
}
}
#define GAS __attribute__((address_space(1)))
#define LAS __attribute__((address_space(3)))
typedef unsigned short bf16;
typedef unsigned v4u __attribute__((ext_vector_type(4)));
typedef float f32x4 __attribute__((ext_vector_type(4)));
typedef short bf16x8 __attribute__((ext_vector_type(8)));
typedef GAS unsigned gu32;
typedef GAS unsigned long long gu64;
#define RLX_AGENT __ATOMIC_RELAXED, __HIP_MEMORY_SCOPE_AGENT
#define LDS_WAIT() asm volatile("s_waitcnt lgkmcnt(0)" ::: "memory")
#define VM_WAIT() asm volatile("s_waitcnt vmcnt(0)" ::: "memory")
__device__ __forceinline__ unsigned long long rt() { return __builtin_amdgcn_s_memrealtime(); }
__device__ __forceinline__ unsigned f2bf(float f) { unsigned u = __builtin_bit_cast(unsigned, f); return (u + 0x7fffu + ((u >> 16) & 1u)) >> 16; }
__device__ __forceinline__ unsigned pk2(float lo, float hi) { return f2bf(lo) | (f2bf(hi) << 16); }

#define XB_TMO      128
#define XB_XCNT(j)  (256  + 64 * (j))
#define XB_XSUB(j)  (1280 + 64 * (j))
#define XB_XGEN(j)  (2304 + 64 * (j))
#define XB_TOP      3328
#define XB_TOPGEN   3392
#define XCD_BAR_WORDS 3456
#define XB_SPIN_CAP (1u << 18)

__device__ __forceinline__ unsigned xb_ld(unsigned* p)              { return __hip_atomic_load(p, __ATOMIC_RELAXED, __HIP_MEMORY_SCOPE_AGENT); }
__device__ __forceinline__ unsigned xb_add(unsigned* p, unsigned v) { return __hip_atomic_fetch_add(p, v, __ATOMIC_RELAXED, __HIP_MEMORY_SCOPE_AGENT); }
__device__ __forceinline__ unsigned xb_xcc_id() { return (unsigned)__builtin_amdgcn_s_getreg((3 << 11) | 20) & 0xFu; }
#define XB_SPIN(cond, bar) do { unsigned _sp = 0; while (cond) { __builtin_amdgcn_s_sleep(1); \
    if ((++_sp & 255u) == 0u) { if (xb_ld(&(bar)[XB_TMO])) break; if (_sp > XB_SPIN_CAP) { atomicAdd(&(bar)[XB_TMO], 1u); break; } } } } while (0)

struct XcdBarrier {
    unsigned* bar; unsigned x;
    volatile LAS unsigned* st;
};

__device__ __forceinline__ XcdBarrier xcd_barrier_post(unsigned* bar, volatile LAS unsigned* st) {
    XcdBarrier b; b.bar = bar; b.x = xb_xcc_id(); b.st = st;
    if (threadIdx.x == 0) (void)xb_add(&bar[XB_XCNT(b.x)], 1u);
    return b;
}
__device__ __forceinline__ void xcd_barrier_complete(unsigned* bar, unsigned x, unsigned& nloc, unsigned& nx) {
    const unsigned G = gridDim.x * gridDim.y * gridDim.z;
    unsigned sum, cnt, mine, sp = 0u;
    for (;;) {
        sum = 0u; cnt = 0u; mine = 0u;
#pragma unroll
        for (unsigned j = 0; j < 16; ++j) { const unsigned c = xb_ld(&bar[XB_XCNT(j)]); sum += c; cnt += (c > 0u) ? 1u : 0u; mine = (j == x) ? c : mine; }
        if (sum == G) break;
        __builtin_amdgcn_s_sleep(1);
        if ((++sp & 255u) == 0u) { if (xb_ld(&bar[XB_TMO])) break; if (sp > XB_SPIN_CAP) { atomicAdd(&bar[XB_TMO], 1u); break; } }
    }
    nloc = mine > 0u ? mine : 1u; nx = cnt > 0u ? cnt : 1u;
}

__device__ __forceinline__ void xcd_barrier(const XcdBarrier& b) {
    asm volatile("s_waitcnt vmcnt(0)" ::: "memory");
    __syncthreads();
    if (threadIdx.x == 0) {
        unsigned* bar = b.bar;
        __builtin_amdgcn_s_waitcnt(0);
        unsigned nloc = b.st[0], nx = b.st[1];
        if (nloc == 0u) { xcd_barrier_complete(bar, b.x, nloc, nx); b.st[0] = nloc; b.st[1] = nx; }
        const unsigned old = xb_add(&bar[XB_XSUB(b.x)], 1u);
        const unsigned gen = old / nloc;
        if (old + 1u == (gen + 1u) * nloc) {
            __builtin_amdgcn_fence(__ATOMIC_RELEASE, "agent");
            asm volatile("s_waitcnt vmcnt(0)" ::: "memory");
            const unsigned og = xb_add(&bar[XB_TOP], 1u);
            const unsigned tg = og / nx;
            if (og + 1u == (tg + 1u) * nx) xb_add(&bar[XB_TOPGEN], 1u);
            else XB_SPIN(xb_ld(&bar[XB_TOPGEN]) == tg, bar);
            __builtin_amdgcn_fence(__ATOMIC_ACQUIRE, "agent");
            xb_add(&bar[XB_XGEN(b.x)], 1u);
            asm volatile("s_waitcnt vmcnt(0)" ::: "memory");
        } else {
            XB_SPIN(xb_ld(&bar[XB_XGEN(b.x)]) == gen, bar);
            __builtin_amdgcn_fence(__ATOMIC_ACQUIRE, "agent");
            asm volatile("s_waitcnt vmcnt(0)" ::: "memory");
        }
    }
    __syncthreads();
}

constexpr int NWAVES = 8;
constexpr int BATCH = 2, SEQ = 8192, DM = 1024, NTOK = BATCH * SEQ;
constexpr int D_IN = 1792, D_FF = 2816, NEXP = 16, CAP = 1024;
constexpr int NROWS_E = NEXP * BATCH * CAP;
constexpr float EPS = 1e-6f;
constexpr int KS_ADA = 16;
#ifndef PF_DIST
#define PF_DIST 0
#ifndef P10_MODE
#define P10_MODE 0
#endif
#endif
constexpr float Y8_SCALE = 16.f;
constexpr float W8_SCALE = 64.f, W8_INV = 1.f / 64.f;

constexpr size_t MiB = 1u << 20;
constexpr size_t WS_CTL = 0, CTL_ZERO_BYTES = 32768;
constexpr size_t WS_MODP = 1 * MiB;
constexpr size_t WS_AFF = 2 * MiB;
constexpr size_t WS_SLOTS = 3 * MiB;
constexpr size_t WS_IDX = 4 * MiB;
constexpr size_t WS_GATES = 4 * MiB + 128 * 1024;
constexpr size_t WS_WSB = 4 * MiB + 256 * 1024;
constexpr size_t WS_VSTAT = 11 * MiB;
constexpr size_t WS_WINT = 5 * MiB;
constexpr size_t WS_WOUTT = 9 * MiB;
constexpr size_t WS_WGUT = 12 * MiB;
constexpr size_t WS_WDT = 188 * MiB;
constexpr size_t WS_H = 276 * MiB;
constexpr size_t WS_YROWS = 308 * MiB;
constexpr size_t WS_HID = 372 * MiB;
constexpr size_t WS_Q = 372 * MiB;
constexpr size_t WS_K = 388 * MiB;
constexpr size_t WS_VT = 392 * MiB;
constexpr size_t WS_U = 396 * MiB;
constexpr size_t WS_VGT = 412 * MiB;
constexpr size_t WS_MIX = 428 * MiB;
constexpr size_t WS_T = 460 * MiB;
constexpr size_t WS_XS = 548 * MiB;
constexpr size_t WS_X1 = 612 * MiB;
constexpr size_t WS_END = 676 * MiB;
constexpr int CW_BAR = 4096;
constexpr int CW_P0CNT = 128;

constexpr int RING_OFF = 0, RING_BYTES = 131072;
constexpr int LDSCTL_OFF = 143360, MISC_OFF = LDSCTL_OFF + 320;
constexpr int LDS_BYTES = 147456;

struct Frame {
    LAS unsigned char* lds;
    volatile LAS unsigned* MISC;
    gu32* ctl;
    int tid, lane, wave;
    int vcu, G;
    const float* in[21];
    float* out;
    unsigned char* ws;
};
#define IN_X 0
#define IN_C 1
#define IN_WADA 2
#define IN_BADA 3
#define IN_NPREMIX 4
#define IN_NPOSTMIX 5
#define IN_WIN 6
#define IN_SINK 7
#define IN_LNG 8
#define IN_LNB 9
#define IN_WS 10
#define IN_BS 11
#define IN_NOATTN 12
#define IN_NOGMLP 13
#define IN_WOUT 14
#define IN_NPREFFN 15
#define IN_NPOSTFFN 16
#define IN_WROUTER 17
#define IN_WGATE 18
#define IN_WUP 19
#define IN_WDOWN 20

#define DPP_ADDF(v, ctrl, rmask) (v) += __builtin_bit_cast(float, __builtin_amdgcn_update_dpp(0, __builtin_bit_cast(int, (v)), (ctrl), (rmask), 0xf, true))
__device__ __forceinline__ float wave_sum(float v) {
    DPP_ADDF(v, 0xB1, 0xf); DPP_ADDF(v, 0x4E, 0xf); DPP_ADDF(v, 0x141, 0xf); DPP_ADDF(v, 0x140, 0xf); DPP_ADDF(v, 0x142, 0xa); DPP_ADDF(v, 0x143, 0xc);
    return __builtin_bit_cast(float, __builtin_amdgcn_readlane(__builtin_bit_cast(int, v), 63));
}
#define DPP_MAXF(v, ctrl, rmask) (v) = fmaxf((v), __builtin_bit_cast(float, __builtin_amdgcn_update_dpp(__builtin_bit_cast(int, (v)), __builtin_bit_cast(int, (v)), (ctrl), (rmask), 0xf, false)))
__device__ __forceinline__ float wave_max(float v) {
    DPP_MAXF(v, 0xB1, 0xf); DPP_MAXF(v, 0x4E, 0xf); DPP_MAXF(v, 0x141, 0xf); DPP_MAXF(v, 0x140, 0xf); DPP_MAXF(v, 0x142, 0xa); DPP_MAXF(v, 0x143, 0xc);
    return __builtin_bit_cast(float, __builtin_amdgcn_readlane(__builtin_bit_cast(int, v), 63));
}
__device__ __forceinline__ float bf2f(unsigned short b) { return __uint_as_float((unsigned)b << 16); }
__device__ __forceinline__ float bflo(unsigned u) { return __uint_as_float(u << 16); }
__device__ __forceinline__ float bfhi(unsigned u) { return __uint_as_float(u & 0xffff0000u); }

__device__ __forceinline__ void transpose_item(const float* W, int N, int k0, int n0, bf16* WT, int ldt, int dest_row0, LAS float* scr, int lane) {
#pragma unroll 8
    for (int i = 0; i < 32; ++i) { const int kk = 2 * i + (lane >> 5); scr[kk * 33 + (lane & 31)] = W[(size_t)(k0 + kk) * N + n0 + (lane & 31)]; }
    LDS_WAIT(); asm volatile("" ::: "memory");
    const int c = lane & 7;
#pragma unroll
    for (int j = 0; j < 4; ++j) { const int n = (lane >> 3) + 8 * j; const LAS float* s = scr + (8 * c) * 33 + n;
        v4u o; o.x = pk2(s[0 * 33], s[1 * 33]); o.y = pk2(s[2 * 33], s[3 * 33]); o.z = pk2(s[4 * 33], s[5 * 33]); o.w = pk2(s[6 * 33], s[7 * 33]);
        *(GAS v4u*)(WT + (size_t)(dest_row0 + n) * ldt + k0 + 8 * c) = o; }
    LDS_WAIT(); asm volatile("" ::: "memory");
}

constexpr int XI_PER_MAT = (DM / 128) * (D_FF / 32);
constexpr int XI_TOTAL = NEXP * 3 * XI_PER_MAT;
struct XItem { const float* src; unsigned char* dst; int N, ldt; };
__device__ __forceinline__ XItem xitem_decode(Frame& F, int it) {
    const int e = it / (3 * XI_PER_MAT), r = it % (3 * XI_PER_MAT), ty = r / XI_PER_MAT, r3 = r % XI_PER_MAT; XItem d;
    if (ty < 2) { const int kb = r3 / (D_FF / 32), n0 = 32 * (r3 % (D_FF / 32)), k0 = 128 * kb;
        d.N = D_FF; d.ldt = DM; d.src = (ty ? F.in[IN_WUP] : F.in[IN_WGATE]) + (size_t)e * DM * D_FF + (size_t)k0 * D_FF + n0;
        d.ldt = 128; d.dst = (unsigned char*)(F.ws + WS_WGUT) + (size_t)e * (2 * D_FF) * DM + ((size_t)((n0 >> 7) * (DM / 128) + kb) * 256 + ty * 128 + (n0 & 127)) * 128; }
    else { const int kb = r3 / (DM / 32), n0 = 32 * (r3 % (DM / 32)), k0 = 128 * kb;
        d.N = DM; d.ldt = D_FF; d.src = F.in[IN_WDOWN] + (size_t)e * D_FF * DM + (size_t)k0 * DM + n0;
        d.ldt = 128; d.dst = (unsigned char*)(F.ws + WS_WDT) + (size_t)e * DM * D_FF + ((size_t)((n0 >> 8) * (D_FF / 128) + kb) * 256 + (n0 & 255)) * 128; }
    return d;
}
__device__ __forceinline__ void xitem_load(const XItem& d, f32x4 (&r)[16], int lane) {
    const float* p = d.src + (size_t)(lane >> 3) * d.N + 4 * (lane & 7);
#pragma unroll
    for (int i = 0; i < 16; ++i) r[i] = __builtin_nontemporal_load((const f32x4*)(p + (size_t)(8 * i) * d.N));
}
__device__ __forceinline__ void xitem_finish(const XItem& d, const f32x4 (&r)[16], LAS float* scr, int lane) {
    LAS float* w = scr + (lane >> 3) * 33 + 4 * (lane & 7);
#pragma unroll
    for (int i = 0; i < 16; ++i) { const f32x4 v = r[i] * W8_SCALE; w[i * 264] = v.x; w[i * 264 + 1] = v.y; w[i * 264 + 2] = v.z; w[i * 264 + 3] = v.w; }
    LDS_WAIT(); asm volatile("" ::: "memory");
    const int c = lane & 7;
#pragma unroll
    for (int j = 0; j < 4; ++j) { const int n = (lane >> 3) + 8 * j; const LAS float* s = scr + (16 * c) * 33 + n;
        v4u o;
        o.x = pg8::pk4_fp8(s[0 * 33], s[1 * 33], s[2 * 33], s[3 * 33]);
        o.y = pg8::pk4_fp8(s[4 * 33], s[5 * 33], s[6 * 33], s[7 * 33]);
        o.z = pg8::pk4_fp8(s[8 * 33], s[9 * 33], s[10 * 33], s[11 * 33]);
        o.w = pg8::pk4_fp8(s[12 * 33], s[13 * 33], s[14 * 33], s[15 * 33]);
        __builtin_nontemporal_store(o, (v4u*)(d.dst + (size_t)n * d.ldt + 16 * c)); }
    LDS_WAIT(); asm volatile("" ::: "memory");
}
constexpr int XI_R0 = 25600, XI_R1 = 28400;
__device__ __forceinline__ void p0_expert_items(Frame& F, int first, int end, int widx, int nworkers) {
    LAS float* scr = (LAS float*)(F.lds + F.wave * 16896);
    const int lane = F.lane;
    const int it0 = first + widx; if (it0 >= end) return;
    const int n = (end - it0 + nworkers - 1) / nworkers;
    f32x4 rA[16], rB[16]; XItem dA = xitem_decode(F, it0), dB; xitem_load(dA, rA, lane);
    int j = 1;
#pragma unroll 1
    for (; j + 1 < n; j += 2) {
        dB = xitem_decode(F, it0 + j * nworkers); xitem_load(dB, rB, lane); __builtin_amdgcn_sched_barrier(0);
        xitem_finish(dA, rA, scr, lane); __builtin_amdgcn_sched_barrier(0);
        dA = xitem_decode(F, it0 + (j + 1) * nworkers); xitem_load(dA, rA, lane); __builtin_amdgcn_sched_barrier(0);
        xitem_finish(dB, rB, scr, lane); __builtin_amdgcn_sched_barrier(0);
    }
    if (j < n) { dB = xitem_decode(F, it0 + j * nworkers); xitem_load(dB, rB, lane); xitem_finish(dA, rA, scr, lane); xitem_finish(dB, rB, scr, lane); }
    else xitem_finish(dA, rA, scr, lane);
}

__device__ __forceinline__ void p0_prologue(Frame& F) {
    LAS float* scr = (LAS float*)(F.lds + F.wave * 16896);
    const int gw = F.vcu * NWAVES + F.wave, NGW = F.G * NWAVES, lane = F.lane;
    {
        const float* c = F.in[IN_C]; const float* W = F.in[IN_WADA]; float* modp = (float*)(F.ws + WS_MODP);
        constexpr int KPS = DM / KS_ADA;
        for (int it = gw; it < 96 * KS_ADA; it += NGW) {
            const int cg = it % 96, ks = it / 96, col = cg * 64 + lane;
            float a0 = 0.f, a1 = 0.f;
#pragma unroll 16
            for (int kk = 0; kk < KPS; ++kk) { const int k = ks * KPS + kk; const float w = W[(size_t)k * 6144 + col];
                const float c0 = c[k], c1 = c[DM + k];
                a0 += (c0 / (1.f + __expf(-c0))) * w; a1 += (c1 / (1.f + __expf(-c1))) * w; }
            __hip_atomic_store(modp + (size_t)(ks * 2 + 0) * 6144 + col, a0, __ATOMIC_RELAXED, __HIP_MEMORY_SCOPE_AGENT);
            __hip_atomic_store(modp + (size_t)(ks * 2 + 1) * 6144 + col, a1, __ATOMIC_RELAXED, __HIP_MEMORY_SCOPE_AGENT);
        }
        asm volatile("s_waitcnt vmcnt(0)" ::: "memory");
        if (lane == 0) __hip_atomic_fetch_add((unsigned*)(F.ctl + CW_P0CNT), 1u, __ATOMIC_RELAXED, __HIP_MEMORY_SCOPE_AGENT);
    }
    {
        const float* wsf = F.in[IN_WS]; bf16* wsb = (bf16*)(F.ws + WS_WSB);
        for (int o = gw * 64 + lane; o < 8 * 8 * 4 * 64; o += NGW * 64) { const int ln = o & 63, tb = (o >> 6) & 3, ks = (o >> 8) & 7, g = o >> 11, r32 = ln & 31, hi = ln >> 5;
            const float* src = wsf + (size_t)(g * 128 + 32 * tb + r32) * 128 + 16 * ks + 8 * hi; const f32x4 v0 = *(const f32x4*)src, v1 = *(const f32x4*)(src + 4);
            v4u pk; pk.x = pk2(v0.x, v0.y); pk.y = pk2(v0.z, v0.w); pk.z = pk2(v1.x, v1.y); pk.w = pk2(v1.z, v1.w); *(v4u*)(wsb + (size_t)o * 8) = pk; }
    }
    constexpr int I_IN = (DM / 64) * (D_IN / 32), I_OUT = (DM / 64) * (DM / 32);
    for (int it = gw; it < I_IN + I_OUT; it += NGW) {
        int r = it;
        if (r < I_IN) { const int nb = D_IN / 32, kb = r / nb, n0 = 32 * (r % nb); transpose_item(F.in[IN_WIN], D_IN, 64 * kb, n0, (bf16*)(F.ws + WS_WINT), DM, n0, scr, lane); continue; } r -= I_IN;
        { const int nb = DM / 32, kb = r / nb, n0 = 32 * (r % nb); transpose_item(F.in[IN_WOUT], DM, 64 * kb, n0, (bf16*)(F.ws + WS_WOUTT), DM, n0, scr, lane); }
    }
    p0_expert_items(F, 0, XI_R0, gw, NGW);
}
__device__ __forceinline__ void p0_wait_published(Frame& F) {
    if (F.wave == 0) { const unsigned want = (unsigned)(F.G * NWAVES); unsigned sp = 0;
        while ((unsigned)__builtin_amdgcn_readfirstlane((int)__hip_atomic_load((unsigned*)(F.ctl + CW_P0CNT), __ATOMIC_RELAXED, __HIP_MEMORY_SCOPE_AGENT)) < want) { __builtin_amdgcn_s_sleep(2); if (++sp > (1u << 22)) break; }
        __builtin_amdgcn_fence(__ATOMIC_ACQUIRE, "agent"); asm volatile("s_waitcnt vmcnt(0)" ::: "memory"); }
    __syncthreads();
}

__device__ __forceinline__ void mod_to_lds(Frame& F, LAS float* dst, int col0, int ncols) {
    const float* modp = (const float*)(F.ws + WS_MODP); const float* bada = F.in[IN_BADA];
#pragma unroll 4
    for (int i = F.tid; i < 2 * ncols; i += NWAVES * 64) { const int b = i / ncols, j = i % ncols; float s = bada[col0 + j];
#pragma unroll
        for (int ks = 0; ks < KS_ADA; ++ks) s += modp[(size_t)(ks * 2 + b) * 6144 + col0 + j];
        dst[i] = s; }
    __syncthreads();
}
constexpr size_t WS_MODF = WS_MODP + (size_t)KS_ADA * 2 * 6144 * 4;
__device__ __forceinline__ void modf_write(Frame& F) {
    const float* modp = (const float*)(F.ws + WS_MODP); const float* bada = F.in[IN_BADA]; float* modf = (float*)(F.ws + WS_MODF);
    const int i = (int)blockIdx.x * NWAVES * 64 + F.tid;
    if (i < 2 * 4096) { const int b = i >> 12, col = 2048 + (i & 4095); float s = bada[col];
#pragma unroll
        for (int ks = 0; ks < KS_ADA; ++ks) s += modp[(size_t)(ks * 2 + b) * 6144 + col];
        modf[b * 6144 + col] = s; }
}
__device__ __forceinline__ void modf_to_lds(Frame& F, LAS float* dst, int col0, int ncols) {
    const float* modf = (const float*)(F.ws + WS_MODF);
#pragma unroll 4
    for (int i = F.tid; i < 2 * ncols; i += NWAVES * 64) { const int b = i / ncols, j = i % ncols; dst[i] = modf[b * 6144 + col0 + j]; }
    __syncthreads();
}

__device__ __forceinline__ void p1_prenorm(Frame& F) {
    LAS float* md = (LAS float*)(F.lds + RING_OFF);
    p0_wait_published(F);
    modf_write(F);
    mod_to_lds(F, md, 0, 2048);
    const int gw = F.vcu * NWAVES + F.wave, NGW = F.G * NWAVES, lane = F.lane;
    const float* x = F.in[IN_X]; const float* g = F.in[IN_NPREMIX]; bf16* h = (bf16*)(F.ws + WS_H);
    f32x4 gq[4];
#pragma unroll
    for (int j = 0; j < 4; ++j) gq[j] = *(const f32x4*)(g + 4 * lane + 256 * j);
    f32x4 vn[4];
    if (gw < NTOK) { const f32x4* xr = (const f32x4*)(x + (size_t)gw * DM) + lane;
#pragma unroll
        for (int j = 0; j < 4; ++j) vn[j] = xr[64 * j]; }
    for (int m = gw; m < NTOK; m += NGW) {
        const int b = m >> 13;
        f32x4 v[4]; float ss = 0.f;
#pragma unroll
        for (int j = 0; j < 4; ++j) { v[j] = vn[j]; ss += (v[j].x * v[j].x + v[j].y * v[j].y) + (v[j].z * v[j].z + v[j].w * v[j].w); }
        const float rstd = rsqrtf(wave_sum(ss) * (1.f / DM) + EPS);
        unsigned long long* o8 = (unsigned long long*)(h + (size_t)m * DM) + lane;
#pragma unroll
        for (int j = 0; j < 4; ++j) { const int col = 4 * lane + 256 * j; const f32x4 gg = gq[j];
            const f32x4 sh = *(const LAS f32x4*)(md + b * 2048 + col), sc = *(const LAS f32x4*)(md + b * 2048 + 1024 + col);
            const f32x4 r = (v[j] * rstd * gg) * (sc + 1.f) + sh;
            o8[64 * j] = (unsigned long long)pk2(r.x, r.y) | ((unsigned long long)pk2(r.z, r.w) << 32); }
        if (m + NGW < NTOK) { const f32x4* xr = (const f32x4*)(x + (size_t)(m + NGW) * DM) + lane;
#pragma unroll
            for (int j = 0; j < 4; ++j) vn[j] = xr[64 * j]; }
    }
    __syncthreads();
}

typedef float f32x16 __attribute__((ext_vector_type(16)));
typedef short s16x4 __attribute__((ext_vector_type(4)));
typedef float f32x2_t __attribute__((ext_vector_type(2))); typedef __bf16 bf16x2_t __attribute__((ext_vector_type(2)));
__device__ __forceinline__ unsigned cvtpk(float lo, float hi) { f32x2_t v = {lo, hi}; bf16x2_t bb = __builtin_convertvector(v, bf16x2_t); return __builtin_bit_cast(unsigned, bb); }
__device__ __forceinline__ int crow(int i, int hi) { return (i & 3) + 8 * (i >> 2) + 4 * hi; }
#define MFMA32(a, b, c) __builtin_amdgcn_mfma_f32_32x32x16_bf16((a), (b), (c), 0, 0, 0)
constexpr int AT_KB = 24576, AT_VB = 25600, AT_BUF = AT_KB + AT_VB, AT_SQ = 2 * AT_BUF;
struct AtStage { v4u k[3], v[3]; };
__device__ __forceinline__ void at_load(AtStage& st, const bf16* k, const bf16* vT, int b, int q0, int c, int tid) {
#pragma unroll
    for (int i = 0; i < 3; ++i) { const int kb = q0 - 128 + 32 * (3 * c + i), kbc = kb < 0 ? 0 : (kb > SEQ - 32 ? SEQ - 32 : kb);
        st.k[i] = *(const v4u*)(k + (size_t)(b * SEQ + kbc + (tid >> 4)) * 128 + (tid & 15) * 8);
        st.v[i] = *(const v4u*)(vT + (size_t)(b * 128 + (tid >> 2)) * SEQ + kbc + (tid & 3) * 8); }
}
__device__ __forceinline__ void at_store(const AtStage& st, LAS unsigned char* buf, int tid) {
#pragma unroll
    for (int i = 0; i < 3; ++i) { const int key = 32 * i + (tid >> 4), ch16 = tid & 15, kvh = ch16 >> 3, ch = ch16 & 7;
        *(LAS v4u*)(buf + kvh * 12288 + key * 128 + ((ch ^ (key & 7)) << 4)) = st.k[i];
        const int row = tid >> 2, pc = tid & 3; LAS unsigned char* vp = buf + AT_KB + (row >> 6) * 12800 + (row & 63) * 200 + (32 * i + 8 * pc) * 2;
        typedef unsigned u32x2_t __attribute__((ext_vector_type(2)));
        *(LAS u32x2_t*)vp = (u32x2_t){st.v[i].x, st.v[i].y}; *(LAS u32x2_t*)(vp + 8) = (u32x2_t){st.v[i].z, st.v[i].w}; }
}
#define AT_TILE(KT, TL, MODE) do { const int kb_ = q0 - 128 + 32 * (KT); if (kb_ >= 0 && kb_ < SEQ) { \
    const int key_ = 32 * (TL) + r32; bf16x8 kf_[4]; \
    _Pragma("unroll") for (int ks = 0; ks < 4; ++ks) kf_[ks] = *(const LAS bf16x8*)(kimg + key_ * 128 + (((2 * ks + hi) ^ (key_ & 7)) << 4)); \
    bf16x8 va_[2][2]; \
    _Pragma("unroll") for (int db = 0; db < 2; ++db) _Pragma("unroll") for (int sx = 0; sx < 2; ++sx) { const LAS unsigned char* vp_ = vimg + (32 * db + r32) * 200 + (32 * (TL) + 16 * sx + 4 * hi) * 2; \
        const s16x4 lo_ = *(const LAS s16x4*)vp_, hv_ = *(const LAS s16x4*)(vp_ + 16); va_[db][sx] = __builtin_shufflevector(lo_, hv_, 0, 1, 2, 3, 4, 5, 6, 7); } \
    f32x16 st_; _Pragma("unroll") for (int i = 0; i < 16; ++i) st_[i] = 0.f; \
    _Pragma("unroll") for (int ks = 0; ks < 4; ++ks) st_ = MFMA32(kf_[ks], *(const LAS bf16x8*)(ot + ks * 1024 + lane * 16), st_); \
    float bt_ = 0.f; \
    if (MODE == 1) { bt_ = Bp - sl2 * (float)(128 - 32 * (KT)); _Pragma("unroll") for (int i = 0; i < 16; ++i) st_[i] = __builtin_fmaf(st_[i], c0, Kc[i]); } \
    else if (MODE == 2) { bt_ = -Bp - sl2 * (float)(32 * (KT) - 128); _Pragma("unroll") for (int i = 0; i < 16; ++i) st_[i] = __builtin_fmaf(st_[i], c0, -Kc[i]); } \
    else if (MODE == 3) { bt_ = Bp - sl2 * 128.f;              \
        _Pragma("unroll") for (int i = 0; i < 16; ++i) st_[i] = ((i & 3) + 8 * (i >> 2) + 4 * hi >= r32) ? __builtin_fmaf(st_[i], c0, Kc[i]) : -1e30f; } \
    else if (MODE == 4) { bt_ = -Bp - sl2 * 128.f;             \
        _Pragma("unroll") for (int i = 0; i < 16; ++i) st_[i] = ((i & 3) + 8 * (i >> 2) + 4 * hi <= r32) ? __builtin_fmaf(st_[i], c0, -Kc[i]) : -1e30f; } \
    else {                                                     \
        _Pragma("unroll") for (int i = 0; i < 16; ++i) st_[i] = __builtin_fmaf(-sl2, __builtin_fabsf(rh - (float)((i & 3) + 8 * (i >> 2))), st_[i] * c0); } \
    float ta_ = fmaxf(fmaxf(st_[0], st_[1]), st_[2]), tb_ = fmaxf(fmaxf(st_[3], st_[4]), st_[5]); \
    ta_ = fmaxf(fmaxf(ta_, st_[6]), st_[7]); tb_ = fmaxf(fmaxf(tb_, st_[8]), st_[9]); ta_ = fmaxf(fmaxf(ta_, st_[10]), st_[11]); tb_ = fmaxf(fmaxf(tb_, st_[12]), st_[13]); \
    float tmax_ = fmaxf(fmaxf(ta_, tb_), fmaxf(st_[14], st_[15])) + bt_; tmax_ = fmaxf(tmax_, __shfl_xor(tmax_, 32)); \
    if (__any(tmax_ > m_run)) { const float mn_ = fmaxf(m_run, tmax_), al_ = __builtin_amdgcn_exp2f(m_run - mn_); m_run = mn_; l_run *= al_; \
        _Pragma("unroll") for (int i = 0; i < 16; ++i) { o0[i] *= al_; o1[i] *= al_; } } \
    const float dl_ = bt_ - m_run; float ps_ = 0.f; \
    _Pragma("unroll") for (int i = 0; i < 16; ++i) { const float p_ = __builtin_amdgcn_exp2f(st_[i] + dl_); st_[i] = p_; ps_ += p_; } \
    ps_ += __shfl_xor(ps_, 32); l_run += ps_; \
    v4u p0_, p1_; \
    p0_.x = cvtpk(st_[0], st_[1]); p0_.y = cvtpk(st_[2], st_[3]); p0_.z = cvtpk(st_[4], st_[5]); p0_.w = cvtpk(st_[6], st_[7]); \
    p1_.x = cvtpk(st_[8], st_[9]); p1_.y = cvtpk(st_[10], st_[11]); p1_.z = cvtpk(st_[12], st_[13]); p1_.w = cvtpk(st_[14], st_[15]); \
    const bf16x8 pb0_ = __builtin_bit_cast(bf16x8, p0_), pb1_ = __builtin_bit_cast(bf16x8, p1_); \
    o0 = MFMA32(va_[0][0], pb0_, o0); o0 = MFMA32(va_[0][1], pb1_, o0); o1 = MFMA32(va_[1][0], pb0_, o1); o1 = MFMA32(va_[1][1], pb1_, o1); } } while (0)
#define AT_CHUNK(C, NC, NU, M0, M1, M2) do { LAS unsigned char* buf = ring + par * AT_BUF; par ^= 1; at_store(st, buf, tid); __syncthreads(); \
    if ((NU) < nunits) at_load(st, k, vT, ((NU) * 32) >> 13, ((NU) * 32) & 8191, (NC), tid); \
    const LAS unsigned char* kimg = buf + kvh * 12288; const LAS unsigned char* vimg = buf + AT_KB + kvh * 12800; \
    AT_TILE(3 * (C) + 0, 0, M0); __builtin_amdgcn_sched_barrier(0); AT_TILE(3 * (C) + 1, 1, M1); __builtin_amdgcn_sched_barrier(0); AT_TILE(3 * (C) + 2, 2, M2); } while (0)
__device__ __forceinline__ void p3_attn_mfma(Frame& F) {
    const int tid = F.tid, lane = F.lane, r32 = lane & 31, hi = lane >> 5, hh = F.wave, kvh = hh >> 2;
    LAS unsigned char* ring = F.lds + RING_OFF; LAS float* SQ = (LAS float*)(ring + AT_SQ);
    const bf16* q = (const bf16*)(F.ws + WS_Q); const bf16* k = (const bf16*)(F.ws + WS_K); const bf16* vT = (const bf16*)(F.ws + WS_VT);
    bf16* mix = (bf16*)(F.ws + WS_MIX); const float* gn = F.in[IN_NOATTN];
    constexpr float LOG2E = 1.4426950408889634f;
    const float slope = exp2f(-(float)(hh + 1)), sl2 = slope * LOG2E, c0 = 0.125f * LOG2E, sink2 = F.in[IN_SINK][hh] * LOG2E;
    const float rh = (float)(r32 - 4 * hi), Bp = -sl2 * rh;
    float Kc[16];
#pragma unroll
    for (int i = 0; i < 16; ++i) Kc[i] = sl2 * (float)((i & 3) + 8 * (i >> 2));
    LAS unsigned char* ot = ring + AT_SQ + 1024 + hh * 4096;
    const int nunits = NTOK / 32; int unit = F.vcu; if (unit >= nunits) return;
    AtStage st; at_load(st, k, vT, (unit * 32) >> 13, (unit * 32) & 8191, 1, tid);
    int par = 0;
    for (; unit < nunits; unit += F.G) {
        const int tok0 = unit * 32, b = tok0 >> 13, q0 = tok0 & 8191, qpos = q0 + r32;
#pragma unroll
        for (int ks = 0; ks < 4; ++ks) *(LAS bf16x8*)(ot + ks * 1024 + lane * 16) = *(const bf16x8*)(q + (size_t)(tok0 + r32) * 512 + hh * 64 + 16 * ks + 8 * hi);
        f32x16 o0, o1;
#pragma unroll
        for (int i = 0; i < 16; ++i) { o0[i] = 0.f; o1[i] = 0.f; }
        float m_run = sink2, l_run = 1.f;
        AT_CHUNK(1, 0, unit, 1, 0, 2);
        AT_CHUNK(0, 2, unit, 3, 1, 1);
        AT_CHUNK(2, 1, unit + F.G, 2, 2, 4);
        (void)b;
        const float inv = 1.f / l_run; float sq = 0.f;
#pragma unroll
        for (int i = 0; i < 16; ++i) { o0[i] *= inv; o1[i] *= inv; sq += o0[i] * o0[i] + o1[i] * o1[i]; }
        sq += __shfl_xor(sq, 32);
        if (hi == 0) SQ[hh * 32 + r32] = sq;
        __syncthreads();
        float tot = 0.f;
#pragma unroll
        for (int w8 = 0; w8 < 8; ++w8) tot += SQ[w8 * 32 + r32];
        const float rstd = rsqrtf(tot * (1.f / 512.f) + EPS);
#pragma unroll
        for (int g4 = 0; g4 < 4; ++g4) { const int d0 = 8 * g4 + 4 * hi; const f32x4 ga = *(const f32x4*)(gn + hh * 64 + d0), gb = *(const f32x4*)(gn + hh * 64 + 32 + d0);
            *(LAS unsigned long long*)(ot + r32 * 128 + ((g4 ^ (r32 & 7)) << 4) + 8 * hi) = (unsigned long long)cvtpk(o0[4 * g4] * rstd * ga.x, o0[4 * g4 + 1] * rstd * ga.y) | ((unsigned long long)cvtpk(o0[4 * g4 + 2] * rstd * ga.z, o0[4 * g4 + 3] * rstd * ga.w) << 32);
            *(LAS unsigned long long*)(ot + r32 * 128 + (((4 + g4) ^ (r32 & 7)) << 4) + 8 * hi) = (unsigned long long)cvtpk(o1[4 * g4] * rstd * gb.x, o1[4 * g4 + 1] * rstd * gb.y) | ((unsigned long long)cvtpk(o1[4 * g4 + 2] * rstd * gb.z, o1[4 * g4 + 3] * rstd * gb.w) << 32); }
#pragma unroll
        for (int i = 0; i < 4; ++i) { const int qq = 8 * i + (lane >> 3); const v4u v = *(const LAS v4u*)(ot + qq * 128 + (((lane & 7) ^ (qq & 7)) << 4));
            *(v4u*)(mix + (size_t)(tok0 + qq) * DM + hh * 64 + (lane & 7) * 8) = v; }
        __syncthreads();
    }
}
#undef AT_TILE
#undef AT_CHUNK

__device__ __forceinline__ void p3_gmlp_mfma(Frame& F) {
    __syncthreads();
    const int lane = F.lane, r32 = lane & 31, hi = lane >> 5, w = F.wave, ch0 = w * 64;
    LAS float* L = (LAS float*)(F.lds + RING_OFF + 131072);
    LAS float* MU = L; LAS float* RS = L + 128; LAS float* SQ = L + 256;
    LAS unsigned char* wt = F.lds + RING_OFF + w * 16384;
    const bf16* vgT = (const bf16*)(F.ws + WS_VGT); const bf16* u = (const bf16*)(F.ws + WS_U); bf16* mix = (bf16*)(F.ws + WS_MIX); const bf16* wsb = (const bf16*)(F.ws + WS_WSB);
    const float* bs = F.in[IN_BS]; const float* lng = F.in[IN_LNG]; const float* lnb = F.in[IN_LNB]; const float* gn = F.in[IN_NOGMLP];
    for (int unit = F.vcu; unit < BATCH * (SEQ / 128); unit += F.G) {
        const int b = unit >> 6, s0 = (unit & 63) * 128;
#pragma unroll
        for (int hb = 0; hb < 2; ++hb) { v4u ur[8];
#pragma unroll
          for (int i = 0; i < 8; ++i) ur[i] = *(const v4u*)(u + ((size_t)b * SEQ + s0 + 8 * (8 * hb + i) + (lane >> 3)) * 512 + ch0 + (lane & 7) * 8);
#pragma unroll
          for (int i = 0; i < 8; ++i) { const int t = 8 * (8 * hb + i) + (lane >> 3); *(LAS v4u*)(wt + t * 128 + (((lane & 7) ^ (t & 7)) << 4)) = ur[i]; }
          asm volatile("s_waitcnt lgkmcnt(0)" ::: "memory"); }
        if (F.tid < 128) { const float* vs = (const float*)(F.ws + WS_VSTAT) + ((size_t)b * SEQ + s0 + F.tid) * 2; float s1 = 0.f, s2 = 0.f;
#pragma unroll
            for (int p = 0; p < 8; ++p) { const f32x2_t t2 = *(const f32x2_t*)(vs + (size_t)p * NTOK * 2); s1 += t2.x; s2 += t2.y; }
            const float mean = s1 * (1.f / 512.f); float var = s2 * (1.f / 512.f) - mean * mean; var = var < 0.f ? 0.f : var;
            MU[F.tid] = mean; RS[F.tid] = rsqrtf(var + EPS); }
        __syncthreads();
        f32x16 z[2][4];
#pragma unroll
        for (int cb = 0; cb < 2; ++cb)
#pragma unroll
            for (int tb = 0; tb < 4; ++tb)
#pragma unroll
                for (int i = 0; i < 16; ++i) z[cb][tb][i] = 0.f;
        const float lg0 = lng[ch0 + r32], lb0 = lnb[ch0 + r32], lg1 = lng[ch0 + 32 + r32], lb1 = lnb[ch0 + 32 + r32];
#pragma unroll 2
        for (int ks = 0; ks < 8; ++ks) {
            const int sb = 16 * ks + 8 * hi;
            const f32x4 mua = *(const LAS f32x4*)(MU + sb), mub = *(const LAS f32x4*)(MU + sb + 4), rsa = *(const LAS f32x4*)(RS + sb), rsb = *(const LAS f32x4*)(RS + sb + 4);
            bf16x8 af[2];
#pragma unroll
            for (int cb = 0; cb < 2; ++cb) { const float lg = cb ? lg1 : lg0, lb = cb ? lb1 : lb0;
                const v4u raw = *(const v4u*)(vgT + ((((size_t)(b * 64 + (unit & 63)) * 8 + w) * 2 + cb) * 8 + ks) * 512 + lane * 8);
                v4u pk;
                pk.x = cvtpk((bflo(raw.x) - mua.x) * rsa.x * lg + lb, (bfhi(raw.x) - mua.y) * rsa.y * lg + lb);
                pk.y = cvtpk((bflo(raw.y) - mua.z) * rsa.z * lg + lb, (bfhi(raw.y) - mua.w) * rsa.w * lg + lb);
                pk.z = cvtpk((bflo(raw.z) - mub.x) * rsb.x * lg + lb, (bfhi(raw.z) - mub.y) * rsb.y * lg + lb);
                pk.w = cvtpk((bflo(raw.w) - mub.z) * rsb.z * lg + lb, (bfhi(raw.w) - mub.w) * rsb.w * lg + lb);
                af[cb] = __builtin_bit_cast(bf16x8, pk); }
#pragma unroll
            for (int tb = 0; tb < 4; ++tb) { const bf16x8 bfr = *(const bf16x8*)(wsb + ((size_t)((w * 8 + ks) * 4 + tb) * 64 + lane) * 8);
                z[0][tb] = MFMA32(af[0], bfr, z[0][tb]); z[1][tb] = MFMA32(af[1], bfr, z[1][tb]); }
        }
        int lq = lane; asm volatile("" : "+v"(lq)); const int r32e = lq & 31, hie = lq >> 5, l8 = lq & 7, l3 = lq >> 3;
        const float* bsl = bs; const float* gnl = gn; asm volatile("" : "+s"(bsl), "+s"(gnl));
#pragma unroll
        for (int tb = 0; tb < 4; ++tb) { const int t = 32 * tb + r32e; const float bsv = bsl[w * 128 + t]; float sq = 0.f;
#pragma unroll
            for (int cb = 0; cb < 2; ++cb)
#pragma unroll
                for (int g4 = 0; g4 < 4; ++g4) { typedef unsigned u32x2_t __attribute__((ext_vector_type(2))); const u32x2_t ur = *(const LAS u32x2_t*)(wt + t * 128 + (((4 * cb + g4) ^ (t & 7)) << 4) + 8 * hie);
                    const float g0 = bflo(ur.x) * (z[cb][tb][4 * g4] + bsv), g1 = bfhi(ur.x) * (z[cb][tb][4 * g4 + 1] + bsv), g2 = bflo(ur.y) * (z[cb][tb][4 * g4 + 2] + bsv), g3 = bfhi(ur.y) * (z[cb][tb][4 * g4 + 3] + bsv);
                    z[cb][tb][4 * g4] = g0; z[cb][tb][4 * g4 + 1] = g1; z[cb][tb][4 * g4 + 2] = g2; z[cb][tb][4 * g4 + 3] = g3; sq += (g0 * g0 + g1 * g1) + (g2 * g2 + g3 * g3); }
            sq += __shfl_xor(sq, 32);
            if (hie == 0) SQ[w * 128 + t] = sq; asm volatile("" ::: "memory"); }
        __syncthreads();
#pragma unroll
        for (int tb = 0; tb < 4; ++tb) { const int t = 32 * tb + r32e; float tot = 0.f;
#pragma unroll
            for (int ww = 0; ww < 8; ++ww) tot += SQ[ww * 128 + t];
            const float rstd = rsqrtf(tot * (1.f / 512.f) + EPS);
#pragma unroll
            for (int cb = 0; cb < 2; ++cb)
#pragma unroll
                for (int g4 = 0; g4 < 4; ++g4) { const int c0 = 32 * cb + 8 * g4 + 4 * hie; const f32x4 gg = *(const f32x4*)(gnl + ch0 + c0);
                    *(LAS unsigned long long*)(wt + t * 128 + (((4 * cb + g4) ^ (t & 7)) << 4) + 8 * hie) = (unsigned long long)cvtpk(z[cb][tb][4 * g4] * rstd * gg.x, z[cb][tb][4 * g4 + 1] * rstd * gg.y) | ((unsigned long long)cvtpk(z[cb][tb][4 * g4 + 2] * rstd * gg.z, z[cb][tb][4 * g4 + 3] * rstd * gg.w) << 32); } asm volatile("" ::: "memory"); }
#pragma unroll
        for (int i = 0; i < 16; ++i) { const int t = 8 * i + l3; const v4u v = *(const LAS v4u*)(wt + t * 128 + ((l8 ^ (t & 7)) << 4));
            *(v4u*)(mix + ((size_t)b * SEQ + s0 + t) * DM + 512 + ch0 + l8 * 8) = v; }
        __syncthreads();
    }
}

struct P5Ctx { LAS float* md; LAS float* wrT; const float* x; const bf16* t; unsigned char* h2; float* aff; bf16* x1; int lane, NGW; };
__device__ __forceinline__ void p5_issue(const P5Ctx& C, f32x4 (&xb)[4], uint2 (&tb)[4], int row) {
    const f32x4* xr = (const f32x4*)(C.x + (size_t)row * DM) + C.lane; const uint2* tr = (const uint2*)(C.t + (size_t)row * DM) + C.lane;
#pragma unroll
    for (int j = 0; j < 4; ++j) { xb[j] = __builtin_nontemporal_load(xr + 64 * j); { typedef unsigned u32x2_t __attribute__((ext_vector_type(2))); const u32x2_t tq = __builtin_nontemporal_load((const u32x2_t*)(tr + 64 * j)); tb[j].x = tq.x; tb[j].y = tq.y; } }
}
__device__ __forceinline__ void p5_row(const P5Ctx& C, const f32x4 (&g1q)[4], const f32x4 (&g2q)[4], f32x4 (&xb)[4], uint2 (&tb)[4], int m) {
    if (m >= NTOK) return;
    LAS float* md = C.md; LAS float* wrT = C.wrT; unsigned char* h2 = C.h2; float* aff = C.aff; const int lane = C.lane;
        const int b = m >> 13, s = m & 8191;
        f32x4 tv[4], xv[4]; float ss = 0.f;
#pragma unroll
        for (int j = 0; j < 4; ++j) { const uint2 tq = tb[j]; tv[j] = (f32x4){bflo(tq.x), bfhi(tq.x), bflo(tq.y), bfhi(tq.y)}; xv[j] = xb[j]; ss += (tv[j].x * tv[j].x + tv[j].y * tv[j].y) + (tv[j].z * tv[j].z + tv[j].w * tv[j].w); }
        const float rstd1 = rsqrtf(wave_sum(ss) * (1.f / DM) + EPS);
        float ss2 = 0.f; unsigned long long* orow = (unsigned long long*)(C.x1 + (size_t)m * DM) + lane;
#pragma unroll
        for (int j = 0; j < 4; ++j) { const int col = 4 * lane + 256 * j; const f32x4 gg = g1q[j], ga = *(const LAS f32x4*)(md + b * 3072 + col);
            xv[j] = xv[j] + ga * (tv[j] * rstd1 * gg); orow[64 * j] = (unsigned long long)cvtpk(xv[j].x, xv[j].y) | ((unsigned long long)cvtpk(xv[j].z, xv[j].w) << 32);
            ss2 += (xv[j].x * xv[j].x + xv[j].y * xv[j].y) + (xv[j].z * xv[j].z + xv[j].w * xv[j].w); }
        const float rstd2 = rsqrtf(wave_sum(ss2) * (1.f / DM) + EPS);
        unsigned* o8 = (unsigned*)(h2 + (size_t)m * DM) + lane;
        f32x4 hv[4];
#pragma unroll
        for (int j = 0; j < 4; ++j) { const int col = 4 * lane + 256 * j; const f32x4 gg = g2q[j];
            const f32x4 sh = *(const LAS f32x4*)(md + b * 3072 + 1024 + col), sc = *(const LAS f32x4*)(md + b * 3072 + 2048 + col);
            hv[j] = (xv[j] * rstd2 * gg) * (sc + 1.f) + sh;
            o8[64 * j] = pg8::pk4_fp8(hv[j].x, hv[j].y, hv[j].z, hv[j].w); }
        float lg[16];
#pragma unroll
        for (int eg = 0; eg < 4; ++eg) { f32x4 wv[4][4];
#pragma unroll
            for (int e4 = 0; e4 < 4; ++e4)
#pragma unroll
                for (int j = 0; j < 4; ++j) wv[e4][j] = *(const LAS f32x4*)(wrT + (4 * eg + e4) * DM + 4 * lane + 256 * j);
#pragma unroll
            for (int e4 = 0; e4 < 4; ++e4) { f32x2_t a2 = {0.f, 0.f};
#pragma unroll
                for (int j = 0; j < 4; ++j) { a2 += (f32x2_t){hv[j].x, hv[j].y} * (f32x2_t){wv[e4][j].x, wv[e4][j].y}; a2 += (f32x2_t){hv[j].z, hv[j].w} * (f32x2_t){wv[e4][j].z, wv[e4][j].w}; }
                float a = a2.x + a2.y; asm volatile("" : "+v"(a)); lg[4 * eg + e4] = a; } }
        float v8[8];
#pragma unroll
        for (int e = 0; e < 8; ++e) { const auto r = __builtin_amdgcn_permlane32_swap(__float_as_uint(lg[e]), __float_as_uint(lg[e + 8]), false, false); v8[e] = __uint_as_float(r[0]) + __uint_as_float(r[1]); }
        const bool b4 = (lane & 16) != 0, b3 = (lane & 8) != 0, b2 = (lane & 4) != 0;
        float v4[4];
#pragma unroll
        for (int i = 0; i < 4; ++i) { const float snd = b4 ? v8[i] : v8[i + 4], kp = b4 ? v8[i + 4] : v8[i]; v4[i] = kp + __shfl_xor(snd, 16); }
        float v2[2];
#pragma unroll
        for (int i = 0; i < 2; ++i) { const float snd = b3 ? v4[i] : v4[i + 2], kp = b3 ? v4[i + 2] : v4[i]; v2[i] = kp + __shfl_xor(snd, 8); }
        float tl; { const float snd = b2 ? v2[0] : v2[1], kp = b2 ? v2[1] : v2[0]; tl = kp + __shfl_xor(snd, 4); }
        DPP_ADDF(tl, 0x4E, 0xf); DPP_ADDF(tl, 0xB1, 0xf);
        const float mx = wave_max(tl), ex = __expf(tl - mx), se = wave_sum(ex) * 0.25f;
        if ((lane & 3) == 0) aff[(size_t)(b * NEXP + (lane >> 2)) * SEQ + s] = ex / se;
        if (m + C.NGW < NTOK) p5_issue(C, xb, tb, m + C.NGW);
}
__device__ __forceinline__ void p5_postmix(Frame& F) {
    LAS float* md = (LAS float*)(F.lds + RING_OFF);
    LAS float* wrT = (LAS float*)(F.lds + RING_OFF + 32768);
#pragma unroll 16
    for (int i = F.tid; i < DM * NEXP; i += NWAVES * 64) { const int col = i >> 4, e = i & 15; wrT[e * DM + col] = F.in[IN_WROUTER][i]; }
    modf_to_lds(F, md, 2048, 3072);
    const int gw = F.vcu * NWAVES + F.wave, NGW = F.G * NWAVES, lane = F.lane;
    const float* g1 = F.in[IN_NPOSTMIX]; const float* g2 = F.in[IN_NPREFFN];
    const P5Ctx C{md, wrT, F.in[IN_X], (const bf16*)(F.ws + WS_T), (unsigned char*)(F.ws + WS_H), (float*)(F.ws + WS_AFF), (bf16*)(F.ws + WS_X1), lane, NGW};
    f32x4 g1q[4], g2q[4];
#pragma unroll
    for (int j = 0; j < 4; ++j) { g1q[j] = *(const f32x4*)(g1 + 4 * lane + 256 * j); g2q[j] = *(const f32x4*)(g2 + 4 * lane + 256 * j); }
    f32x4 x0[4]; uint2 t0[4];
    if (gw < NTOK) p5_issue(C, x0, t0, gw);
#pragma unroll 1
    for (int m = gw; m < NTOK; m += NGW) p5_row(C, g1q, g2q, x0, t0, m);
    __syncthreads();
}

__device__ __forceinline__ void p6_topk(Frame& F) {
    LAS unsigned* vals = (LAS unsigned*)(F.lds + RING_OFF);
    LAS unsigned* hist = (LAS unsigned*)(F.lds + RING_OFF + 32768);
    LAS unsigned* misc = (LAS unsigned*)(F.lds + RING_OFF + 32768 + 1024);
    const int tid = F.tid, lane = F.lane, w = F.wave;
    const float* aff = (const float*)(F.ws + WS_AFF); int* slots = (int*)(F.ws + WS_SLOTS); int* idx = (int*)(F.ws + WS_IDX); float* gates = (float*)(F.ws + WS_GATES);
    if (F.vcu >= BATCH * NEXP) { if (F.G > BATCH * NEXP) p0_expert_items(F, XI_R1, XI_TOTAL, (F.vcu - BATCH * NEXP) * NWAVES + F.wave, (F.G - BATCH * NEXP) * NWAVES); return; }
    if (F.G <= BATCH * NEXP && F.vcu == 0) p0_expert_items(F, XI_R1, XI_TOTAL, F.wave, NWAVES);
    for (int unit = F.vcu; unit < BATCH * NEXP; unit += F.G) {
        const int b = unit >> 4, e = unit & 15;
        __syncthreads();
        const unsigned* src = (const unsigned*)(aff + (size_t)unit * SEQ);
        for (int i = tid; i < SEQ; i += NWAVES * 64) vals[i] = src[i];
        unsigned prefix = 0u, mask = 0u, need = CAP;
#pragma unroll 1
        for (int pass = 0; pass < 4; ++pass) {
            const int shift = 24 - 8 * pass;
            if (tid < 256) hist[tid] = 0u;
            __syncthreads();
            for (int i = tid; i < SEQ; i += NWAVES * 64) { const unsigned v = vals[i]; if ((v & mask) == prefix) __hip_atomic_fetch_add(&hist[(v >> shift) & 255u], 1u, __ATOMIC_RELAXED, __HIP_MEMORY_SCOPE_WORKGROUP); }
            __syncthreads();
            if (w == 0) {
                const unsigned b0 = hist[4 * lane], b1 = hist[4 * lane + 1], b2 = hist[4 * lane + 2], b3 = hist[4 * lane + 3];
                const unsigned sl = b0 + b1 + b2 + b3; unsigned suf = sl;
#pragma unroll
                for (int o = 1; o < 64; o <<= 1) { const unsigned tv = __shfl_down(suf, o); if (lane + o < 64) suf += tv; }
                const unsigned above = suf - sl;
                if (above < need && need <= above + sl) {
                    unsigned cnt = above, dig, nn;
                    if (cnt + b3 >= need) { dig = 3; nn = need - cnt; } else { cnt += b3;
                    if (cnt + b2 >= need) { dig = 2; nn = need - cnt; } else { cnt += b2;
                    if (cnt + b1 >= need) { dig = 1; nn = need - cnt; } else { cnt += b1; dig = 0; nn = need - cnt; } } }
                    misc[0] = 4u * lane + dig; misc[1] = nn; }
            }
            __syncthreads();
            prefix |= misc[0] << shift; mask |= 255u << shift; need = misc[1];
            __syncthreads();
        }
        const unsigned T = prefix; unsigned gt = 0u, eq = 0u; unsigned v16[16];
#pragma unroll
        for (int i = 0; i < 16; ++i) { v16[i] = vals[16 * tid + i]; gt += (v16[i] > T) ? 1u : 0u; eq += (v16[i] == T) ? 1u : 0u; }
        unsigned pk = gt | (eq << 16), inc = pk;
#pragma unroll
        for (int o = 1; o < 64; o <<= 1) { const unsigned tv = __shfl_up(inc, o); if (lane >= o) inc += tv; }
        if (lane == 63) misc[16 + w] = inc;
        __syncthreads();
        unsigned base = 0u;
#pragma unroll
        for (int ww = 0; ww < 8; ++ww) base += (ww < w) ? misc[16 + ww] : 0u;
        const unsigned exc = base + inc - pk; unsigned gtb = exc & 0xffffu, eqb = exc >> 16;
#pragma unroll
        for (int i = 0; i < 16; ++i) { const int tok = 16 * tid + i; const unsigned v = v16[i]; int slot = -1;
            if (v > T) { slot = (int)(gtb + (eqb < need ? eqb : need)); ++gtb; }
            else if (v == T) { if (eqb < need) slot = (int)(gtb + eqb); ++eqb; }
            slots[(size_t)(b * SEQ + tok) * NEXP + e] = slot;
            if (slot >= 0) { idx[(e * BATCH + b) * CAP + slot] = b * SEQ + tok; gates[unit * CAP + slot] = __uint_as_float(v); } }
    }
    __syncthreads();
}

__device__ __forceinline__ void p6b_gather(Frame& F) {
    const int gw = F.vcu * NWAVES + F.wave, NGW = F.G * NWAVES, lane = F.lane;
    const int* idx = (const int*)(F.ws + WS_IDX); const unsigned char* h2 = (const unsigned char*)(F.ws + WS_H); unsigned char* xs = (unsigned char*)(F.ws + WS_XS);
    for (int r = gw; r < NROWS_E; r += NGW) { const int e = r >> 11, b = (r >> 10) & 1, c = r & 1023; const int tok = idx[(b * NEXP + e) * CAP + c];
        const v4u* sp = (const v4u*)(h2 + (size_t)(b * SEQ + tok) * DM) + lane; v4u* dp = (v4u*)(xs + (size_t)r * DM) + lane;
        dp[0] = sp[0]; }
}

typedef unsigned u32x2_t __attribute__((ext_vector_type(2)));
struct P10Set { float gt[4]; unsigned r[4][4]; u32x2_t x1[4]; unsigned okb, mask; int slotv; };
__device__ __forceinline__ void p10_gather4(float (&gt)[4], unsigned (&r)[4][4], unsigned& okb, unsigned& mask, int slotv, int b, const float* gates, const unsigned char* yrows, int lane, int dflt) {
    int rowi = dflt, gi = dflt; okb = 0u;
#pragma unroll
    for (int q = 0; q < 4; ++q) { const bool ok = mask != 0u; const int e = ok ? __builtin_ctz(mask) : 0; mask = ok ? (mask & (mask - 1u)) : 0u;
        const int sl = __builtin_amdgcn_readlane(slotv, e);
        rowi = ok ? e * 2048 + b * 1024 + sl : rowi; gi = ok ? (b * NEXP + e) * CAP + sl : gi; okb |= ok ? (1u << q) : 0u;
        gt[q] = gates[gi]; const unsigned* yr = (const unsigned*)(yrows + (size_t)rowi * DM) + lane;
#pragma unroll
        for (int j = 0; j < 4; ++j) r[q][j] = __builtin_nontemporal_load(yr + 64 * j); }
}
__device__ __forceinline__ void p10_accum(const float (&gt)[4], const unsigned (&r)[4][4], unsigned okb, float (&y)[16]) {
#pragma unroll
    for (int q = 0; q < 4; ++q) { const float g = ((okb >> q) & 1u) ? gt[q] * (1.f / Y8_SCALE) : 0.f;
#pragma unroll
        for (int j = 0; j < 4; ++j) { const f32x2_t lo = __builtin_amdgcn_cvt_pk_f32_fp8((int)r[q][j], false), hi = __builtin_amdgcn_cvt_pk_f32_fp8((int)r[q][j], true);
            y[4 * j] += g * lo.x; y[4 * j + 1] += g * lo.y; y[4 * j + 2] += g * hi.x; y[4 * j + 3] += g * hi.y; } }
}
struct P10Ctx { const float* gates; const unsigned char* yrows; const bf16* x1; float* out; LAS float* md; LAS int* sl; int gw, NGW, nrows, lane; };
__device__ __forceinline__ void p10_issue_row(const P10Ctx& C, P10Set& S, int k) {
    const int kk = k < C.nrows ? k : C.nrows - 1, m = C.gw + kk * C.NGW, lane = C.lane;
    S.slotv = C.sl[kk * 16 + (lane & 15)]; S.slotv = (lane < 16) ? S.slotv : -1;
    S.mask = (unsigned)(__ballot(S.slotv >= 0) & 0xffffull);
    p10_gather4(S.gt, S.r, S.okb, S.mask, S.slotv, m >> 13, C.gates, C.yrows, lane, m & 32767);
    const u32x2_t* xr = (const u32x2_t*)(C.x1 + (size_t)m * DM) + lane;
#pragma unroll
    for (int j = 0; j < 4; ++j) S.x1[j] = xr[64 * j];
}
__device__ __forceinline__ void p10_finish_row(const P10Ctx& C, P10Set& S, const f32x4 (&gnq)[4], int k) {
    if (k >= C.nrows) return;
    const int m = C.gw + k * C.NGW, b = m >> 13, lane = C.lane;
    float y[16];
#pragma unroll
    for (int i = 0; i < 16; ++i) y[i] = 0.f;
    p10_accum(S.gt, S.r, S.okb, y);
    while (S.mask) { float gt[4]; unsigned r[4][4]; unsigned okb; p10_gather4(gt, r, okb, S.mask, S.slotv, b, C.gates, C.yrows, lane, m & 32767); p10_accum(gt, r, okb, y); }
    float ss = 0.f;
#pragma unroll
    for (int i = 0; i < 16; ++i) ss += y[i] * y[i];
    const float rstd = rsqrtf(wave_sum(ss) * (1.f / DM) + EPS);
    float* orow = C.out + (size_t)m * DM + 4 * lane;
#pragma unroll
    for (int j = 0; j < 4; ++j) { const u32x2_t xq = S.x1[j]; const f32x4 gg = gnq[j], ga = *(const LAS f32x4*)(C.md + b * 1024 + 4 * lane + 256 * j);
        const f32x4 yv = {y[4 * j], y[4 * j + 1], y[4 * j + 2], y[4 * j + 3]}, x1 = {bflo(xq.x), bfhi(xq.x), bflo(xq.y), bfhi(xq.y)};
        __builtin_nontemporal_store(x1 + ga * (yv * rstd * gg), (f32x4*)(orow + 256 * j)); }
}
template <int PM = 0> __device__ __forceinline__ void p9_combine(Frame& F) {
    LAS float* md = (LAS float*)(F.lds + RING_OFF);
    modf_to_lds(F, md, 5120, 1024);
    const int gw = F.vcu * NWAVES + F.wave, NGW = F.G * NWAVES, lane = F.lane;
    if (gw >= NTOK) return;
    const int nrows = (NTOK - gw + NGW - 1) / NGW;
    LAS int* sl = (LAS int*)(F.lds + RING_OFF + 16384) + F.wave * 2048;
    const int* slots = (const int*)(F.ws + WS_SLOTS);
    for (int k0 = 0; k0 < nrows && k0 < 128; k0 += 4) { const int k = k0 + (lane >> 4); if (k < nrows) sl[k * 16 + (lane & 15)] = slots[(size_t)(gw + k * NGW) * NEXP + (lane & 15)]; }
    const float* gn = F.in[IN_NPOSTFFN];
    f32x4 gnq[4];
#pragma unroll
    for (int j = 0; j < 4; ++j) gnq[j] = *(const f32x4*)(gn + 4 * lane + 256 * j);
    asm volatile("s_waitcnt vmcnt(0) lgkmcnt(0)" ::: "memory");
    const P10Ctx C{(const float*)(F.ws + WS_GATES), (const unsigned char*)(F.ws + WS_YROWS), (const bf16*)(F.ws + WS_X1), F.out, md, sl, gw, NGW, nrows < 128 ? nrows : 128, lane};
    P10Set A, B;
    p10_issue_row(C, A, 0); __builtin_amdgcn_sched_barrier(0);
#pragma unroll 1
    for (int k = 0; k < C.nrows; k += 2) {
        p10_issue_row(C, B, k + 1); __builtin_amdgcn_sched_barrier(0);
        p10_finish_row(C, A, gnq, k); __builtin_amdgcn_sched_barrier(0);
        p10_issue_row(C, A, k + 2); __builtin_amdgcn_sched_barrier(0);
        p10_finish_row(C, B, gnq, k + 1); __builtin_amdgcn_sched_barrier(0);
    }
}


__device__ __forceinline__ void ph2_inproj(Frame& F) {
    pg8::Gemm g{(const pg8::bf16_t*)(F.ws + WS_H), (const pg8::bf16_t*)(F.ws + WS_WINT), NTOK, D_IN, DM, nullptr}; pg8::StaticOrder S; S.init(NTOK, D_IN, F.G, (int)blockIdx.x);
    pg8::EpiProj E{(pg8::bf16_t*)(F.ws + WS_Q), (pg8::bf16_t*)(F.ws + WS_K), (pg8::bf16_t*)(F.ws + WS_VT), (pg8::bf16_t*)(F.ws + WS_U), (pg8::bf16_t*)(F.ws + WS_VGT), (float*)(F.ws + WS_VSTAT)};
    pg8::gemm_phase<pg8::EpiProj, pg8::StaticOrder, true, true>(F.lds + RING_OFF, g, S, E);
    { pg8::Unit u2; if (!S.next(1, u2)) {
        const int nlight = 2 * F.G - (NTOK / 256) * (D_IN / 256), first_light = F.G - nlight;
        if (nlight > 0 && (int)blockIdx.x >= first_light) p0_expert_items(F, XI_R0, XI_R1, ((int)blockIdx.x - first_light) * NWAVES + F.wave, nlight * NWAVES);
        else if (nlight <= 0 && blockIdx.x == 0) p0_expert_items(F, XI_R0, XI_R1, F.wave, NWAVES); } }
}
#ifndef PROBE_DUP
#define PROBE_DUP -1
#endif
__device__ __forceinline__ void ph3_mixer(Frame& F) { p3_attn_mfma(F); if (PROBE_DUP == 31) { __syncthreads(); p3_attn_mfma(F); } p3_gmlp_mfma(F); if (PROBE_DUP == 32) p3_gmlp_mfma(F); }
__device__ __forceinline__ void ph4_outproj(Frame& F) {
    pg8::Gemm g{(const pg8::bf16_t*)(F.ws + WS_MIX), (const pg8::bf16_t*)(F.ws + WS_WOUTT), NTOK, DM, DM, nullptr}; pg8::StaticOrder S; S.init(NTOK, DM, F.G, (int)blockIdx.x);
    pg8::EpiDown E{(pg8::bf16_t*)(F.ws + WS_T), 4};
    pg8::gemm_phase<pg8::EpiDown, pg8::StaticOrder, true, true>(F.lds + RING_OFF, g, S, E);
}
__device__ __forceinline__ void ph8_gateup(Frame& F) {
    pg8::Gemm g{(const pg8::bf16_t*)(F.ws + WS_H), (const pg8::bf16_t*)(F.ws + WS_WGUT), NROWS_E, 2 * D_FF, DM / 2, (const int*)(F.ws + WS_IDX)}; pg8::MoeOrder S; S.init(NEXP, 8, 22, F.G, (int)blockIdx.x);
    pg8::EpiSwiGLU8 E{(unsigned char*)(F.ws + WS_HID), 22, W8_INV};
    pg8::Unit u0;
    for (int base = 0; S.next(base, u0); base += 12) { pg8::SubOrder SS{S, base, 12};
        pg8::gemm_phase<pg8::EpiSwiGLU8, pg8::SubOrder, true, true, true, true, PF_DIST, true>(F.lds + RING_OFF, g, SS, E); }
}
__device__ __forceinline__ void ph9_down(Frame& F) {
    pg8::Gemm g{(const pg8::bf16_t*)(F.ws + WS_HID), (const pg8::bf16_t*)(F.ws + WS_WDT), NROWS_E, DM, D_FF / 2, nullptr}; pg8::MoeOrder S; S.init(NEXP, 8, 4, F.G, (int)blockIdx.x);
    pg8::EpiDown8 E{(unsigned char*)(F.ws + WS_YROWS), 4, W8_INV * Y8_SCALE};
    pg8::gemm_phase<pg8::EpiDown8, pg8::MoeOrder, true, true, true, false, PF_DIST, true>(F.lds + RING_OFF, g, S, E);
}
constexpr int NPHASES = 11;
#ifndef MK_N_LAUNCHES
#define MK_N_LAUNCHES 1
#endif
struct Args { const float* in[21]; float* out; unsigned char* ws; int ph_lo, ph_hi, li, pad; };
__global__ void __launch_bounds__(NWAVES * 64, 2) hymba_fwd(Args args) {
    extern __shared__ __attribute__((aligned(16))) unsigned char lds[];
    Frame F;
    F.lds = (LAS unsigned char*)lds;
    F.MISC = (volatile LAS unsigned*)(F.lds + MISC_OFF);
    F.tid = threadIdx.x; F.lane = F.tid & 63; F.wave = __builtin_amdgcn_readfirstlane(F.tid >> 6);
    F.G = gridDim.x; { const int bx = blockIdx.x; F.vcu = (F.G % 8 == 0) ? (bx % 8) * (F.G / 8) + bx / 8 : bx; }
#pragma unroll
    for (int i = 0; i < 21; ++i) F.in[i] = args.in[i];
    F.out = args.out; F.ws = args.ws; F.ctl = (gu32*)(args.ws + WS_CTL);
    for (int u = F.tid; u < (LDS_BYTES - LDSCTL_OFF) / 4; u += NWAVES * 64) ((LAS unsigned*)(F.lds + LDSCTL_OFF))[u] = 0u;
    __syncthreads();
    XcdBarrier bar; bar.bar = (unsigned*)(F.ctl + CW_BAR); bar.x = 0; bar.st = nullptr;
    const bool one_launch = (args.ph_hi - args.ph_lo) > 1;
    if (one_launch) bar = xcd_barrier_post((unsigned*)(F.ctl + CW_BAR), F.MISC + 8);
    const int lo = args.ph_lo, hi = args.ph_hi;
#ifndef PHASE_MASK
#define PHASE_MASK 0x7ff
#endif
#define IN(k) (((PHASE_MASK >> (k)) & 1) && lo <= (k) && (k) < hi)
#define BOTH(k) (IN(k) && IN((k) + 1))
#define GRID_BAR() xcd_barrier(bar)
#ifndef PROBE_DUP
#define PROBE_DUP -1
#endif
#define PHASE(k, call) if (IN(k)) { call; if (PROBE_DUP == (k)) { GRID_BAR(); call; } if (BOTH(k)) GRID_BAR(); }
    if (IN(0)) { p0_prologue(F); if (PROBE_DUP == 0) { GRID_BAR(); p0_prologue(F); } }
    PHASE(1, p1_prenorm(F))
    PHASE(2, ph2_inproj(F))
    PHASE(3, ph3_mixer(F))
    PHASE(4, ph4_outproj(F))
    PHASE(5, p5_postmix(F))
    PHASE(6, p6_topk(F))
    PHASE(8, ph8_gateup(F))
    PHASE(9, ph9_down(F))
    if (IN(10)) { if (PROBE_DUP == 10) { p9_combine<P10_MODE>(F); GRID_BAR(); } p9_combine<0>(F); }
#undef PHASE
#undef IN
#undef BOTH
#undef GRID_BAR
}

extern "C" void kernel_launch(void* const* d_in, const int* in_sizes, int n_in, void* d_out, int out_size, void* d_ws, size_t ws_size, hipStream_t stream) {
    static int grid = 0;
    if (grid == 0) {
        if (n_in != 21 || out_size != NTOK * DM || ws_size < WS_END) { fprintf(stderr, "kernel_launch: unexpected shapes (n_in %d out %d ws %zu)\n", n_in, out_size, ws_size); grid = -1; return; }
        int dev = 0, cus = 0;
        if (hipGetDevice(&dev) != hipSuccess || hipDeviceGetAttribute(&cus, hipDeviceAttributeMultiprocessorCount, dev) != hipSuccess) { grid = -1; return; }
        if (hipFuncSetAttribute((const void*)hymba_fwd, hipFuncAttributeMaxDynamicSharedMemorySize, LDS_BYTES) != hipSuccess) { fprintf(stderr, "kernel_launch: hipFuncSetAttribute failed\n"); grid = -1; return; }
        int per_cu = 0;
        if (hipOccupancyMaxActiveBlocksPerMultiprocessor(&per_cu, (const void*)hymba_fwd, NWAVES * 64, LDS_BYTES) != hipSuccess || per_cu < 1) fprintf(stderr, "kernel_launch: occupancy query reports %d\n", per_cu);
        (void)hipGetLastError();
        grid = cus;
    }
    if (grid < 0) return;
    (void)hipMemsetAsync((char*)d_ws + WS_CTL, 0, CTL_ZERO_BYTES, stream);
    Args a{};
    for (int i = 0; i < 21; ++i) a.in[i] = (const float*)d_in[i];
    a.out = (float*)d_out; a.ws = (unsigned char*)d_ws;
    if (MK_N_LAUNCHES == 1) { a.ph_lo = 0; a.ph_hi = NPHASES; a.li = 0; hipLaunchKernelGGL(hymba_fwd, dim3(grid), dim3(NWAVES * 64), LDS_BYTES, stream, a); }
    else for (int li = 0; li < NPHASES; ++li) { a.ph_lo = li; a.ph_hi = li + 1; a.li = li; hipLaunchKernelGGL(hymba_fwd, dim3(grid), dim3(NWAVES * 64), LDS_BYTES, stream, a); }
}
```

```cpp
#include <hip/hip_runtime.h>
#include <cstdio>
#include <cstdint>
namespace pg8 {
#define PG8_LAS __attribute__((address_space(3)))
typedef unsigned short bf16_t;
typedef short bf16x8 __attribute__((ext_vector_type(8)));
typedef float f32x4 __attribute__((ext_vector_type(4)));
typedef unsigned u32x4 __attribute__((ext_vector_type(4)));
constexpr int BM = 256, BK = 64, HALF = 128, HTB = HALF * BK * 2  , STAGE_BYTES = 8 * HTB, NXCD = 8, WGM = 8;

__host__ __device__ __forceinline__ int lds_byte(int r, int c) { const int st = (r >> 4) * 2 + (c >> 5), rr = r & 15, cc = c & 31, ob = rr * 64 + cc * 2; return st * 1024 + (ob ^ (((ob >> 9) & 1) << 5)); }
__host__ __device__ __forceinline__ void stage_rc(int b, int& R, int& C) { const int st = b / 1024, sb = b % 1024, swz = sb ^ (((sb >> 9) & 1) << 5); R = (st >> 1) * 16 + swz / 64; C = (st & 1) * 32 + (swz % 64) / 2; }
__host__ __device__ __forceinline__ int perm32(int rho) { const int n = rho >> 4, i = rho & 15; return 8 * (i >> 2) + 4 * n + (i & 3); }

struct Unit { int pm, pn; };
struct Gemm { const bf16_t* A; const bf16_t* Bt; int M, N, K; const int* rowmap; };

struct StaticOrder {
    int nM, nN, nwg, G, c;
    __host__ __device__ void init(int M, int N, int G_, int c_) { nM = M / BM; nN = N / BM; nwg = nM * nN; G = G_; c = c_; }
    __host__ __device__ bool next(int i, Unit& u) const {
        const long L = (long)i * G + c; if (L >= nwg) return false;
        int wgid = (int)L; { const int q = nwg / NXCD, r = nwg % NXCD, xcd = wgid % NXCD, off = wgid / NXCD; wgid = (xcd < r ? xcd * (q + 1) : r * (q + 1) + (xcd - r) * q) + off; }
        const int nig = WGM * nN, gid = wgid / nig, fm = gid * WGM, gsz = (nM - fm) < WGM ? (nM - fm) : WGM;
        u.pm = fm + ((wgid % nig) % gsz); u.pn = (wgid % nig) / gsz; return true;
    }
    __device__ __forceinline__ void a_ready(const Unit&) const {}
    __device__ __forceinline__ void done(const Unit&) const {}
};


typedef float f32x2 __attribute__((ext_vector_type(2))); typedef float f32x2_t __attribute__((ext_vector_type(2))); typedef __bf16 bf16x2_t __attribute__((ext_vector_type(2))); typedef int i32x4_t __attribute__((ext_vector_type(4)));
__device__ __forceinline__ unsigned cvtpk(float lo, float hi) { f32x2_t v = {lo, hi}; bf16x2_t b = __builtin_convertvector(v, bf16x2_t); return __builtin_bit_cast(unsigned, b); }
__device__ __forceinline__ bf16_t f2bf1(float f) { return (bf16_t)(cvtpk(f, 0.f) & 0xffffu); }
__device__ __forceinline__ void store8(bf16_t* p, const f32x4 v0, const f32x4 v1) {
    u32x4 w; w.x = cvtpk(v0[0], v0[1]); w.y = cvtpk(v0[2], v0[3]); w.z = cvtpk(v1[0], v1[1]); w.w = cvtpk(v1[2], v1[3]); *(u32x4*)p = w; }
__device__ __forceinline__ float gelu_tanh(float x) {
    const float t = x * __builtin_fmaf(x * x, -0.10294324f, -2.30220823f);
    return x * __builtin_amdgcn_rcpf(1.f + __builtin_amdgcn_exp2f(t));
}
__device__ __forceinline__ float silu_f(float x) { return x / (1.f + __expf(-x)); }

struct MoeOrder {
    int nE, nM, nN, U, G, c;
    __device__ void init(int nE_, int nM_, int nN_, int G_, int c_) { nE = nE_; nM = nM_; nN = nN_; U = nE * nM * nN; G = G_; c = c_; }
    __device__ bool next(int i, Unit& u) const {
        int gl;
        if ((G & 7) == 0 && (U & 7) == 0) { const int x = c & 7, j = c >> 3, per = G >> 3, li = i * per + j, ux = U >> 3; if (li >= ux) return false; gl = x * ux + li; }
        else { const long L = (long)i * G + c; if (L >= U) return false; gl = (int)L; }
        const int per_e = nM * nN, e = gl / per_e, r = gl % per_e;
        u.pm = e * nM + (r % nM); u.pn = e * nN + (r / nM); return true;
    }
    __device__ __forceinline__ void a_ready(const Unit&) const {}
    __device__ __forceinline__ void done(const Unit&) const {}
};

struct SubOrder {
    MoeOrder S; int base, cnt;
    __device__ bool next(int i, Unit& u) const { return i < cnt && S.next(base + i, u); }
    __device__ __forceinline__ void a_ready(const Unit&) const {}
    __device__ __forceinline__ void done(const Unit&) const {}
};

struct EpiProj {
    static constexpr bool PERM = true, AFTER_DRAIN = false;
    bf16_t *q, *k, *vT, *u, *vgT; float* vstat;
    __device__ __forceinline__ void operator()(const f32x4 (&acc)[2][2][4][2], const Unit& un, int wr, int wc, int fr, int fq) const {
        const int row0 = un.pm * BM + wr * 64 + fr, pn = un.pn, cw = wc * 32 + 8 * fq;
        const int b = (un.pm * BM) >> 13;
        if (pn < 2) {
#pragma unroll
            for (int ai = 0; ai < 2; ++ai)
#pragma unroll
                for (int m = 0; m < 4; ++m) { bf16_t* rowp = q + (size_t)(row0 + ai * HALF + m * 16) * 512 + pn * 256 + cw;
#pragma unroll
                    for (int bj = 0; bj < 2; ++bj) store8(rowp + bj * HALF, acc[ai][bj][m][0], acc[ai][bj][m][1]); }
        } else if (pn == 2) {
#pragma unroll
            for (int ai = 0; ai < 2; ++ai)
#pragma unroll
                for (int m = 0; m < 4; ++m) { const int r = row0 + ai * HALF + m * 16, s = r & 8191;
                    store8(k + (size_t)r * 128 + cw, acc[ai][0][m][0], acc[ai][0][m][1]);
#pragma unroll
                    for (int n = 0; n < 2; ++n)
#pragma unroll
                        for (int j = 0; j < 4; ++j) vT[(size_t)(b * 128 + cw + 4 * n + j) * 8192 + s] = f2bf1(acc[ai][1][m][n][j]); }
        } else if (pn < 5) {
#pragma unroll
            for (int ai = 0; ai < 2; ++ai)
#pragma unroll
                for (int m = 0; m < 4; ++m) { bf16_t* rowp = u + (size_t)(row0 + ai * HALF + m * 16) * 512 + (pn - 3) * 256 + cw;
#pragma unroll
                    for (int bj = 0; bj < 2; ++bj) { f32x4 v0 = acc[ai][bj][m][0], v1 = acc[ai][bj][m][1];
#pragma unroll
                        for (int j = 0; j < 4; ++j) { v0[j] = gelu_tanh(v0[j]); v1[j] = gelu_tanh(v1[j]); }
                        store8(rowp + bj * HALF, v0, v1); } }
        } else {
#pragma unroll
            for (int ai = 0; ai < 2; ++ai)
#pragma unroll
                for (int m = 0; m < 4; ++m) { const int r = row0 + ai * HALF + m * 16, s = r & 8191, nch = s >> 7, sl = s & 127, ks = sl >> 4, hi = (sl >> 3) & 1, jj = sl & 7;
                    float ps = 0.f, pq = 0.f;
#pragma unroll
                    for (int bj = 0; bj < 2; ++bj)
#pragma unroll
                        for (int n = 0; n < 2; ++n)
#pragma unroll
                            for (int j = 0; j < 4; ++j) { const int ch = (pn - 5) * 256 + bj * HALF + cw + 4 * n + j, g = ch >> 6, cb = (ch >> 5) & 1, r32 = ch & 31;
                                const bf16_t hb = f2bf1(gelu_tanh(acc[ai][bj][m][n][j])); const float hv = __uint_as_float((unsigned)hb << 16); ps += hv; pq += hv * hv;
                                vgT[((((size_t)(b * 64 + nch) * 8 + g) * 2 + cb) * 8 + ks) * 512 + (hi * 32 + r32) * 8 + jj] = hb; }
                    ps += __shfl_xor(ps, 16); ps += __shfl_xor(ps, 32); pq += __shfl_xor(pq, 16); pq += __shfl_xor(pq, 32);
                    if (fq == 0) { f32x2 st2 = {ps, pq}; *(f32x2*)(vstat + ((size_t)((pn - 5) * 4 + wc) * 16384 + r) * 2) = st2; } }
        }
    }
};

struct EpiF32 {
    static constexpr bool PERM = false, AFTER_DRAIN = false;
    float* C; int ldc;
    __device__ __forceinline__ void operator()(const f32x4 (&acc)[2][2][4][2], const Unit& u, int wr, int wc, int fr, int fq) const {
        const int row0 = u.pm * BM + wr * 64 + fr, col0 = u.pn * BM + wc * 32 + 4 * fq;
#pragma unroll
        for (int ai = 0; ai < 2; ++ai)
#pragma unroll
            for (int m = 0; m < 4; ++m) { float* rowp = C + (size_t)(row0 + ai * HALF + m * 16) * ldc + col0;
#pragma unroll
                for (int bj = 0; bj < 2; ++bj)
#pragma unroll
                    for (int n = 0; n < 2; ++n) *(f32x4*)(rowp + bj * HALF + n * 16) = acc[ai][bj][m][n]; }
    }
};

struct EpiSwiGLU {
    static constexpr bool PERM = true, AFTER_DRAIN = false;
    bf16_t* hid; int nN;
    __device__ __forceinline__ void operator()(const f32x4 (&acc)[2][2][4][2], const Unit& un, int wr, int wc, int fr, int fq) const {
        const int row0 = un.pm * BM + wr * 64 + fr, pnl = un.pn % nN, col0 = pnl * HALF + wc * 32 + 8 * fq;
#pragma unroll
        for (int ai = 0; ai < 2; ++ai)
#pragma unroll
            for (int m = 0; m < 4; ++m) { bf16_t* rowp = hid + (size_t)(row0 + ai * HALF + m * 16) * 2816 + col0;
                f32x4 v0, v1;
#pragma unroll
                for (int j = 0; j < 4; ++j) { v0[j] = silu_f(acc[ai][0][m][0][j]) * acc[ai][1][m][0][j]; v1[j] = silu_f(acc[ai][0][m][1][j]) * acc[ai][1][m][1][j]; }
                store8(rowp, v0, v1); }
    }
};

struct EpiDown {
    static constexpr bool PERM = true, AFTER_DRAIN = false;
    bf16_t* y; int nN;
    __device__ __forceinline__ void operator()(const f32x4 (&acc)[2][2][4][2], const Unit& un, int wr, int wc, int fr, int fq) const {
        const int row0 = un.pm * BM + wr * 64 + fr, pnl = un.pn % nN, col0 = pnl * BM + wc * 32 + 8 * fq;
#pragma unroll
        for (int ai = 0; ai < 2; ++ai)
#pragma unroll
            for (int m = 0; m < 4; ++m) { bf16_t* rowp = y + (size_t)(row0 + ai * HALF + m * 16) * 1024 + col0;
#pragma unroll
                for (int bj = 0; bj < 2; ++bj) store8(rowp + bj * HALF, acc[ai][bj][m][0], acc[ai][bj][m][1]); }
    }
};

__device__ __forceinline__ unsigned pk4_fp8(float a, float b, float c, float d) { int w = __builtin_amdgcn_cvt_pk_fp8_f32(a, b, 0, false); w = __builtin_amdgcn_cvt_pk_fp8_f32(c, d, w, true); return (unsigned)w; }
__device__ __forceinline__ float clamp448(float x) { return __builtin_fminf(__builtin_fmaxf(x, -448.f), 448.f); }
struct EpiSwiGLU8 {
    static constexpr bool PERM = true, AFTER_DRAIN = false;
    unsigned char* hid; int nN; float inv_scale;
    __device__ __forceinline__ void operator()(const f32x4 (&acc)[2][2][4][2], const Unit& un, int wr, int wc, int fr, int fq) const {
        const int row0 = un.pm * BM + wr * 64 + fr, pnl = un.pn % nN, col0 = pnl * HALF + wc * 32 + 8 * fq;
        const float c1 = -inv_scale * 1.4426950408889634f, s2 = inv_scale * inv_scale;
#pragma unroll
        for (int ai = 0; ai < 2; ++ai)
#pragma unroll
            for (int m = 0; m < 4; ++m) { unsigned char* rowp = hid + (size_t)(row0 + ai * HALF + m * 16) * 2816 + col0;
                float v[8];
#pragma unroll
                for (int n = 0; n < 2; ++n)
#pragma unroll
                    for (int j = 0; j < 4; j += 2) { const f32x2 g = {acc[ai][0][m][n][j], acc[ai][0][m][n][j + 1]}, u = {acc[ai][1][m][n][j], acc[ai][1][m][n][j + 1]};
                        const f32x2 p = (g * u) * s2, x = g * c1; f32x2 d; d.x = __builtin_amdgcn_exp2f(x.x); d.y = __builtin_amdgcn_exp2f(x.y); d = d + 1.0f;
                        f32x2 r; r.x = __builtin_amdgcn_rcpf(d.x); r.y = __builtin_amdgcn_rcpf(d.y); const f32x2 o = p * r;
                        v[4 * n + j] = __builtin_amdgcn_fmed3f(o.x, -448.f, 448.f); v[4 * n + j + 1] = __builtin_amdgcn_fmed3f(o.y, -448.f, 448.f); }
                uint2 w; w.x = pk4_fp8(v[0], v[1], v[2], v[3]); w.y = pk4_fp8(v[4], v[5], v[6], v[7]); *(uint2*)rowp = w; }
    }
};
struct EpiDown8 {
    static constexpr bool PERM = true, AFTER_DRAIN = false;
    unsigned char* y; int nN; float inv_scale;
    __device__ __forceinline__ void operator()(const f32x4 (&acc)[2][2][4][2], const Unit& un, int wr, int wc, int fr, int fq) const {
        const int row0 = un.pm * BM + wr * 64 + fr, pnl = un.pn % nN, col0 = pnl * BM + wc * 32 + 8 * fq;
#pragma unroll
        for (int ai = 0; ai < 2; ++ai)
#pragma unroll
            for (int m = 0; m < 4; ++m) { unsigned char* rowp = y + (size_t)(row0 + ai * HALF + m * 16) * 1024 + col0;
#pragma unroll
                for (int bj = 0; bj < 2; ++bj) { const f32x4 v0 = acc[ai][bj][m][0] * inv_scale, v1 = acc[ai][bj][m][1] * inv_scale;
                    uint2 w; w.x = pk4_fp8(__builtin_amdgcn_fmed3f(v0[0], -448.f, 448.f), __builtin_amdgcn_fmed3f(v0[1], -448.f, 448.f), __builtin_amdgcn_fmed3f(v0[2], -448.f, 448.f), __builtin_amdgcn_fmed3f(v0[3], -448.f, 448.f));
                    w.y = pk4_fp8(__builtin_amdgcn_fmed3f(v1[0], -448.f, 448.f), __builtin_amdgcn_fmed3f(v1[1], -448.f, 448.f), __builtin_amdgcn_fmed3f(v1[2], -448.f, 448.f), __builtin_amdgcn_fmed3f(v1[3], -448.f, 448.f));
                    *(uint2*)(rowp + bj * HALF) = w; } }
    }
};
typedef int i32x8_t __attribute__((ext_vector_type(8)));
template <bool FP8> struct OperandT { typedef bf16x8 type; };
template <> struct OperandT<true> { typedef i32x8_t type; };
__device__ __forceinline__ void ld_bf16(bf16x8& d, const PG8_LAS unsigned char* p) { d = *(const PG8_LAS bf16x8*)p; }
__device__ __forceinline__ void ld_bf16(i32x8_t&, const PG8_LAS unsigned char*) {}
__device__ __forceinline__ void ld_fp8(i32x8_t& d, const PG8_LAS unsigned char* p) { const i32x4_t lo = *(const PG8_LAS i32x4_t*)p, hi = *(const PG8_LAS i32x4_t*)(p + 1024); d = __builtin_shufflevector(lo, hi, 0, 1, 2, 3, 4, 5, 6, 7); }
__device__ __forceinline__ void ld_fp8(bf16x8&, const PG8_LAS unsigned char*) {}
__device__ __forceinline__ f32x4 mma_bf16(const bf16x8& a, const bf16x8& b, const f32x4& c) { return __builtin_amdgcn_mfma_f32_16x16x32_bf16(a, b, c, 0, 0, 0); }
__device__ __forceinline__ f32x4 mma_bf16(const i32x8_t&, const i32x8_t&, const f32x4& c) { return c; }
__device__ __forceinline__ f32x4 mma_fp8(const i32x8_t& a, const i32x8_t& b, const f32x4& c) { f32x4 d = c; const int sc = 0x7f7f7f7f;
    asm volatile("v_mfma_scale_f32_16x16x128_f8f6f4 %0, %1, %2, %0, %3, %3 op_sel_hi:[0,0,0]" : "+v"(d) : "v"(a), "v"(b), "v"(sc)); return d; }
__device__ __forceinline__ f32x4 mma_fp8(const bf16x8&, const bf16x8&, const f32x4& c) { return c; }
template <class Epi, class Sched, bool ALIGN_EPI = false, bool SP2 = false, bool FP8 = false, bool GATHER = false, int PF = 0, bool BTM = false>
__device__ __forceinline__ void gemm_phase(PG8_LAS unsigned char* lds, const Gemm g, const Sched& S, const Epi& E) {
    const int tid = threadIdx.x, wid = __builtin_amdgcn_readfirstlane(tid >> 6), lane = tid & 63, wr = wid >> 2, wc = wid & 3, fr = lane & 15, fq = lane >> 4;
    const int K = g.K, nt = K / BK;
    unsigned voffA[2], voffB[2];
#pragma unroll
    for (int i = 0; i < 2; ++i) { int R, C; stage_rc(tid * 16 + i * 8192, R, C); const int Rb = Epi::PERM ? ((R & ~31) + perm32(R & 31)) : R;
        voffA[i] = (unsigned)(R * K + C) * 2u; voffB[i] = BTM ? (unsigned)(Rb * BK + C) * 2u : (unsigned)(Rb * K + C) * 2u; }
    const size_t kstep = (size_t)(BK * 2);
    const size_t hstep = (size_t)HALF * K * 2;
    const size_t kstepB = BTM ? (size_t)BM * BK * 2 : kstep, hstepB = BTM ? (size_t)HALF * BK * 2 : hstep;
    const size_t tstep = 2 * hstep;
    const unsigned ldsw = (unsigned)wid * 1024u;
    const int aoff = lds_byte(wr * 64 + fr, fq * 8), boff = lds_byte(wc * 32 + fr, fq * 8);
#define PG8_SA(b, h) (((b) * 2 + (h)) * HTB)
#define PG8_SB(b, h) ((4 + (b) * 2 + (h)) * HTB)
#define PG8_STAGE(bufoff, gbase, voff) do { _Pragma("unroll") for (int _i = 0; _i < 2; ++_i) \
        __builtin_amdgcn_global_load_lds((const unsigned*)((const char*)(gbase) + (voff)[_i]), (PG8_LAS unsigned*)(lds + (bufoff) + ldsw + _i * 8192), 16, 0, 0); } while (0)
#define PG8_STAGE_A(bufoff, gbase, h, usenext) do { if constexpr (GATHER) { _Pragma("unroll") for (int _i = 0; _i < 2; ++_i) \
        __builtin_amdgcn_global_load_lds((const unsigned*)((const char*)(gbase) + ((usenext) ? vgn[h][_i] : vgc[h][_i])), (PG8_LAS unsigned*)(lds + (bufoff) + ldsw + _i * 8192), 16, 0, 0); } \
    else { PG8_STAGE(bufoff, (gbase) + ((h) ? hstep : 0), voffA); } } while (0)
#define PG8_LD2(base) PG8_CAT(*(const PG8_LAS i32x4_t*)(base), *(const PG8_LAS i32x4_t*)((base) + 1024))
#define PG8_LDA(dst, b, h) do { _Pragma("unroll") for (int m = 0; m < 4; ++m) { if constexpr (FP8) { ld_fp8(dst[m][0], lds + PG8_SA(b, h) + aoff + m * 2048); } else { _Pragma("unroll") for (int k = 0; k < (FP8 ? 1 : 2); ++k) ld_bf16(dst[m][k], lds + PG8_SA(b, h) + aoff + m * 2048 + k * 1024); } } } while (0)
#define PG8_LDB(dst, b, h) do { _Pragma("unroll") for (int n = 0; n < 2; ++n) { if constexpr (FP8) { ld_fp8(dst[n][0], lds + PG8_SB(b, h) + boff + n * 2048); } else { _Pragma("unroll") for (int k = 0; k < (FP8 ? 1 : 2); ++k) ld_bf16(dst[n][k], lds + PG8_SB(b, h) + boff + n * 2048 + k * 1024); } } } while (0)
#define PG8_MMA(ai, bj, At, Bt) do { __builtin_amdgcn_s_setprio(1); _Pragma("unroll") for (int m = 0; m < 4; ++m) _Pragma("unroll") for (int n = 0; n < 2; ++n) { \
        if constexpr (FP8) { acc[ai][bj][m][n] = mma_fp8(Bt[n][0], At[m][0], acc[ai][bj][m][n]); } \
        else { _Pragma("unroll") for (int k = 0; k < (FP8 ? 1 : 2); ++k) acc[ai][bj][m][n] = mma_bf16(Bt[n][k], At[m][k], acc[ai][bj][m][n]); } } __builtin_amdgcn_s_setprio(0); } while (0)
#define PG8_WAIT_V(n) asm volatile("s_waitcnt vmcnt(" #n ")" ::: "memory")
#define PG8_WAIT_L(n) asm volatile("s_waitcnt lgkmcnt(" #n ")" ::: "memory")
#define PG8_BAR __builtin_amdgcn_s_barrier()
#define PG8_SCHED __builtin_amdgcn_sched_barrier(0)
    Unit cur, nxt; int ui = 0;
    if (!S.next(0, cur)) return;
    f32x4 acc[2][2][4][2];
#pragma unroll
    for (int a = 0; a < 2; ++a)
#pragma unroll
        for (int b = 0; b < 2; ++b)
#pragma unroll
            for (int m = 0; m < 4; ++m)
#pragma unroll
                for (int n = 0; n < 2; ++n) acc[a][b][m][n] = (f32x4){0.f, 0.f, 0.f, 0.f};
    typename OperandT<FP8>::type At[4][FP8 ? 1 : 2], B0[2][FP8 ? 1 : 2], B1[2][FP8 ? 1 : 2];
    const char* cA = GATHER ? (const char*)g.A : (const char*)g.A + (size_t)cur.pm * tstep; const char* cB = (const char*)g.Bt + (size_t)cur.pn * tstep;
    unsigned vgc[2][2], vgn[2][2]; int stR[2], stC[2];
#pragma unroll
    for (int i = 0; i < 2; ++i) { stage_rc(tid * 16 + i * 8192, stR[i], stC[i]); }
    constexpr int RM_MAXU = 12; PG8_LAS int* rml = (PG8_LAS int*)(lds + STAGE_BYTES);
    if constexpr (GATHER) { Unit uu;
        for (int i = 0; i < RM_MAXU && S.next(i, uu); ++i) { if (tid < BM) rml[i * BM + tid] = g.rowmap[uu.pm * BM + tid]; }
        asm volatile("s_waitcnt vmcnt(0) lgkmcnt(0)" ::: "memory"); __builtin_amdgcn_s_barrier(); asm volatile("" ::: "memory"); }
#define PG8_GOFF(dst, uidx, pmv) do { _Pragma("unroll") for (int _h = 0; _h < 2; ++_h) _Pragma("unroll") for (int _i = 0; _i < 2; ++_i) { \
        const int _r = _h * HALF + stR[_i]; const int _row = !GATHER ? 0 : rml[(uidx) * BM + _r]; \
        dst[_h][_i] = ((unsigned)_row * (unsigned)K + (unsigned)stC[_i]) * 2u; } } while (0)
    PG8_GOFF(vgc, 0, cur.pm);
    static_assert(PF == 0 || SP2, "the L2 prefetch is wired into the super-phase loop only");
    const size_t rowb = (size_t)K * 2;
#define PG8_PFBASE(un, uidx) ((tid < BM) ? (GATHER ? (unsigned)rml[(GATHER ? (uidx) : 0) * BM + (tid & (BM - 1))] * (unsigned)rowb : ((unsigned)(un).pm * BM + tid) * (unsigned)rowb) \
                                         : ((unsigned)(un).pn * BM + (tid - BM)) * (unsigned)rowb)
    unsigned pfc = PF ? PG8_PFBASE(cur, 0) : 0u; unsigned pfn = pfc;
#define PG8_PREFETCH(tt) do { if constexpr (PF > 0) { const int _tt = (tt); const bool _in = _tt < nt; const char* _b = (tid < BM) ? (const char*)g.A : (const char*)g.Bt; \
        const char* _p = (_in || !has_next) ? _b + pfc + (size_t)(_in ? _tt : 0) * kstep : _b + pfn + (size_t)(_tt - nt) * kstep; \
        __builtin_amdgcn_global_load_lds((const unsigned*)_p, (PG8_LAS unsigned*)(lds + STAGE_BYTES + 12032), 4, 0, 0); } } while (0)
#define PG8_WAIT_VL() do { if constexpr (PF > 0) PG8_WAIT_V(9); else PG8_WAIT_V(8); } while (0)
#pragma unroll
    for (int h_ = 0; h_ < 2; ++h_) { vgn[h_][0] = vgc[h_][0]; vgn[h_][1] = vgc[h_][1]; }
    S.a_ready(cur);
    if constexpr (SP2) {
        PG8_STAGE(PG8_SB(0, 0), cB, voffB); PG8_STAGE(PG8_SB(0, 1), cB + hstepB, voffB); PG8_STAGE_A(PG8_SA(0, 0), cA, 0, false); PG8_STAGE_A(PG8_SA(0, 1), cA, 1, false);
        if (wr == 1) PG8_BAR;
        PG8_WAIT_V(2); PG8_BAR;
        PG8_STAGE(PG8_SB(1, 0), cB + kstepB, voffB); PG8_STAGE_A(PG8_SA(1, 0), cA + kstep, 0, false); PG8_STAGE(PG8_SB(1, 1), cB + hstepB + kstepB, voffB);
        PG8_WAIT_V(6); PG8_BAR;
    } else {
        PG8_STAGE(PG8_SB(0, 0), cB, voffB); PG8_STAGE_A(PG8_SA(0, 0), cA, 0, false); PG8_STAGE(PG8_SB(0, 1), cB + hstepB, voffB); PG8_STAGE_A(PG8_SA(0, 1), cA, 1, false);
        if (wr == 1) PG8_BAR;
        PG8_WAIT_V(4); PG8_BAR;
        PG8_STAGE(PG8_SB(1, 0), cB + kstepB, voffB); PG8_STAGE_A(PG8_SA(1, 0), cA + kstep, 0, false); PG8_STAGE(PG8_SB(1, 1), cB + hstepB + kstepB, voffB);
        PG8_WAIT_V(6); PG8_BAR;
    }
    for (;;) {
        const bool has_next = S.next(ui + 1, nxt);
        if constexpr (GATHER) { if (has_next) PG8_GOFF(vgn, ui + 1, nxt.pm); }
        if constexpr (PF > 0) { if (has_next) pfn = PG8_PFBASE(nxt, ui + 1); }
        const char* nA = (has_next && !GATHER) ? (const char*)g.A + (size_t)nxt.pm * tstep : cA; const char* nB = has_next ? (const char*)g.Bt + (size_t)nxt.pn * tstep : cB;
#pragma unroll 1
        for (int t = 0; t < nt; t += 2) {
            const bool last = (t == nt - 2);
            const char* a1 = cA + (size_t)(t + 1) * kstep;
            const char* a2 = last ? nA : cA + (size_t)(t + 2) * kstep; const char* b2 = last ? nB : cB + (size_t)(t + 2) * kstepB;
            const char* a3 = a2 + kstep; const char* b3 = b2 + kstepB;
            if (last && has_next) S.a_ready(nxt);
            if constexpr (SP2) {
            PG8_LDB(B0, 0, 0); PG8_LDB(B1, 0, 1); PG8_SCHED; PG8_LDA(At, 0, 0); PG8_STAGE_A(PG8_SA(1, 1), a1, 1, false); PG8_PREFETCH(t + PF);
            PG8_WAIT_VL(); PG8_WAIT_L(0); PG8_BAR; PG8_MMA(0, 0, At, B0); PG8_MMA(0, 1, At, B1); PG8_BAR; PG8_SCHED;
            PG8_LDA(At, 0, 1); PG8_STAGE(PG8_SB(0, 0), b2, voffB); PG8_STAGE(PG8_SB(0, 1), b2 + hstepB, voffB); PG8_STAGE_A(PG8_SA(0, 0), a2, 0, last);
            PG8_WAIT_VL(); PG8_WAIT_L(0); PG8_BAR; PG8_MMA(1, 0, At, B0); PG8_MMA(1, 1, At, B1); PG8_BAR; PG8_SCHED;
            PG8_LDB(B0, 1, 0); PG8_LDB(B1, 1, 1); PG8_SCHED; PG8_LDA(At, 1, 0); PG8_STAGE_A(PG8_SA(0, 1), a2, 1, last); PG8_PREFETCH(t + 1 + PF);
            PG8_WAIT_VL(); PG8_WAIT_L(0); PG8_BAR; PG8_MMA(0, 0, At, B0); PG8_MMA(0, 1, At, B1); PG8_BAR; PG8_SCHED;
            PG8_LDA(At, 1, 1); PG8_STAGE(PG8_SB(1, 0), b3, voffB); PG8_STAGE(PG8_SB(1, 1), b3 + hstepB, voffB); PG8_STAGE_A(PG8_SA(1, 0), a3, 0, last);
            PG8_WAIT_VL(); PG8_WAIT_L(0); PG8_BAR; PG8_MMA(1, 0, At, B0); PG8_MMA(1, 1, At, B1); PG8_BAR; PG8_SCHED;
            } else {
            PG8_LDB(B0, 0, 0); PG8_SCHED; PG8_LDA(At, 0, 0); PG8_STAGE_A(PG8_SA(1, 1), a1, 1, false);
            PG8_WAIT_L(8); PG8_BAR; PG8_WAIT_L(0); PG8_MMA(0, 0, At, B0); PG8_BAR; PG8_SCHED;
            PG8_LDB(B1, 0, 1); PG8_STAGE(PG8_SB(0, 0), b2, voffB);
            PG8_BAR; PG8_WAIT_L(0); PG8_MMA(0, 1, At, B1); PG8_BAR;
            PG8_LDA(At, 0, 1); PG8_STAGE_A(PG8_SA(0, 0), a2, 0, last);
            PG8_BAR; PG8_WAIT_L(0); PG8_MMA(1, 0, At, B0); PG8_BAR; PG8_SCHED;
            PG8_STAGE(PG8_SB(0, 1), b2 + hstepB, voffB);
            PG8_WAIT_V(6); PG8_BAR; PG8_MMA(1, 1, At, B1); PG8_BAR;
            PG8_LDB(B0, 1, 0); PG8_SCHED; PG8_LDA(At, 1, 0); PG8_STAGE_A(PG8_SA(0, 1), a2, 1, last);
            PG8_WAIT_L(8); PG8_BAR; PG8_WAIT_L(0); PG8_MMA(0, 0, At, B0); PG8_BAR; PG8_SCHED;
            PG8_LDB(B1, 1, 1); PG8_STAGE(PG8_SB(1, 0), b3, voffB);
            PG8_BAR; PG8_WAIT_L(0); PG8_MMA(0, 1, At, B1); PG8_BAR;
            PG8_LDA(At, 1, 1); PG8_STAGE_A(PG8_SA(1, 0), a3, 0, last);
            PG8_BAR; PG8_WAIT_L(0); PG8_MMA(1, 0, At, B0); PG8_BAR; PG8_SCHED;
            PG8_STAGE(PG8_SB(1, 1), b3 + hstepB, voffB);
            PG8_WAIT_V(6); PG8_BAR; PG8_MMA(1, 1, At, B1); PG8_BAR;
            }
        }
        if constexpr (FP8) { asm volatile("s_nop 15\n\ts_nop 15" ::: "memory"); }
        if constexpr (ALIGN_EPI) { if (wr == 0) PG8_BAR; }
        if constexpr (!Epi::AFTER_DRAIN) { E(acc, cur, wr, wc, fr, fq); S.done(cur); }
        if (!has_next) break;
#pragma unroll
        for (int a = 0; a < 2; ++a)
#pragma unroll
            for (int b = 0; b < 2; ++b)
#pragma unroll
                for (int m = 0; m < 4; ++m)
#pragma unroll
                    for (int n = 0; n < 2; ++n) acc[a][b][m][n] = (f32x4){0.f, 0.f, 0.f, 0.f};
        cur = nxt; cA = nA; cB = nB; ++ui; pfc = pfn;
        if constexpr (GATHER) {
#pragma unroll
            for (int h_ = 0; h_ < 2; ++h_) { vgc[h_][0] = vgn[h_][0]; vgc[h_][1] = vgn[h_][1]; } }
        if constexpr (ALIGN_EPI) { if (wr == 1) PG8_BAR; }
    }
    PG8_WAIT_V(0);
    if constexpr (!ALIGN_EPI) { if (wr == 0) PG8_BAR; }
    PG8_BAR;
    if constexpr (Epi::AFTER_DRAIN) { E.fused(acc, cur, wr, wc, fr, fq, lds, wid, lane); S.done(cur); }
#undef PG8_SA
#undef PG8_SB
#undef PG8_STAGE
#undef PG8_STAGE_A
#undef PG8_GOFF
#undef PG8_PFBASE
#undef PG8_PREFETCH
#undef PG8_WAIT_VL
#undef PG8_LDA
#undef PG8_LDB
#undef PG8_MMA
#undef PG8_LD2
#undef PG8_WAIT_V
#undef PG8_WAIT_L
#undef PG8_BAR
#undef PG8_SCHED
}
}
#define GAS __attribute__((address_space(1)))
#define LAS __attribute__((address_space(3)))
typedef unsigned short bf16;
typedef unsigned v4u __attribute__((ext_vector_type(4)));
typedef float f32x4 __attribute__((ext_vector_type(4)));
typedef short bf16x8 __attribute__((ext_vector_type(8)));
typedef GAS unsigned gu32;
typedef GAS unsigned long long gu64;
#define RLX_AGENT __ATOMIC_RELAXED, __HIP_MEMORY_SCOPE_AGENT
#define LDS_WAIT() asm volatile("s_waitcnt lgkmcnt(0)" ::: "memory")
#define VM_WAIT() asm volatile("s_waitcnt vmcnt(0)" ::: "memory")
__device__ __forceinline__ unsigned long long rt() { return __builtin_amdgcn_s_memrealtime(); }
__device__ __forceinline__ unsigned f2bf(float f) { unsigned u = __builtin_bit_cast(unsigned, f); return (u + 0x7fffu + ((u >> 16) & 1u)) >> 16; }
__device__ __forceinline__ unsigned pk2(float lo, float hi) { return f2bf(lo) | (f2bf(hi) << 16); }

#define XB_TMO      128
#define XB_XCNT(j)  (256  + 64 * (j))
#define XB_XSUB(j)  (1280 + 64 * (j))
#define XB_XGEN(j)  (2304 + 64 * (j))
#define XB_TOP      3328
#define XB_TOPGEN   3392
#define XCD_BAR_WORDS 3456
#define XB_SPIN_CAP (1u << 18)

__device__ __forceinline__ unsigned xb_ld(unsigned* p)              { return __hip_atomic_load(p, __ATOMIC_RELAXED, __HIP_MEMORY_SCOPE_AGENT); }
__device__ __forceinline__ unsigned xb_add(unsigned* p, unsigned v) { return __hip_atomic_fetch_add(p, v, __ATOMIC_RELAXED, __HIP_MEMORY_SCOPE_AGENT); }
__device__ __forceinline__ unsigned xb_xcc_id() { return (unsigned)__builtin_amdgcn_s_getreg((3 << 11) | 20) & 0xFu; }
#define XB_SPIN(cond, bar) do { unsigned _sp = 0; while (cond) { __builtin_amdgcn_s_sleep(1); \
    if ((++_sp & 255u) == 0u) { if (xb_ld(&(bar)[XB_TMO])) break; if (_sp > XB_SPIN_CAP) { atomicAdd(&(bar)[XB_TMO], 1u); break; } } } } while (0)

struct XcdBarrier {
    unsigned* bar; unsigned x;
    volatile LAS unsigned* st;
};

__device__ __forceinline__ XcdBarrier xcd_barrier_post(unsigned* bar, volatile LAS unsigned* st) {
    XcdBarrier b; b.bar = bar; b.x = xb_xcc_id(); b.st = st;
    if (threadIdx.x == 0) (void)xb_add(&bar[XB_XCNT(b.x)], 1u);
    return b;
}
__device__ __forceinline__ void xcd_barrier_complete(unsigned* bar, unsigned x, unsigned& nloc, unsigned& nx) {
    const unsigned G = gridDim.x * gridDim.y * gridDim.z;
    unsigned sum, cnt, mine, sp = 0u;
    for (;;) {
        sum = 0u; cnt = 0u; mine = 0u;
#pragma unroll
        for (unsigned j = 0; j < 16; ++j) { const unsigned c = xb_ld(&bar[XB_XCNT(j)]); sum += c; cnt += (c > 0u) ? 1u : 0u; mine = (j == x) ? c : mine; }
        if (sum == G) break;
        __builtin_amdgcn_s_sleep(1);
        if ((++sp & 255u) == 0u) { if (xb_ld(&bar[XB_TMO])) break; if (sp > XB_SPIN_CAP) { atomicAdd(&bar[XB_TMO], 1u); break; } }
    }
    nloc = mine > 0u ? mine : 1u; nx = cnt > 0u ? cnt : 1u;
}

__device__ __forceinline__ void xcd_barrier(const XcdBarrier& b) {
    asm volatile("s_waitcnt vmcnt(0)" ::: "memory");
    __syncthreads();
    if (threadIdx.x == 0) {
        unsigned* bar = b.bar;
        __builtin_amdgcn_s_waitcnt(0);
        unsigned nloc = b.st[0], nx = b.st[1];
        if (nloc == 0u) { xcd_barrier_complete(bar, b.x, nloc, nx); b.st[0] = nloc; b.st[1] = nx; }
        const unsigned old = xb_add(&bar[XB_XSUB(b.x)], 1u);
        const unsigned gen = old / nloc;
        if (old + 1u == (gen + 1u) * nloc) {
            __builtin_amdgcn_fence(__ATOMIC_RELEASE, "agent");
            asm volatile("s_waitcnt vmcnt(0)" ::: "memory");
            const unsigned og = xb_add(&bar[XB_TOP], 1u);
            const unsigned tg = og / nx;
            if (og + 1u == (tg + 1u) * nx) xb_add(&bar[XB_TOPGEN], 1u);
            else XB_SPIN(xb_ld(&bar[XB_TOPGEN]) == tg, bar);
            __builtin_amdgcn_fence(__ATOMIC_ACQUIRE, "agent");
            xb_add(&bar[XB_XGEN(b.x)], 1u);
            asm volatile("s_waitcnt vmcnt(0)" ::: "memory");
        } else {
            XB_SPIN(xb_ld(&bar[XB_XGEN(b.x)]) == gen, bar);
            __builtin_amdgcn_fence(__ATOMIC_ACQUIRE, "agent");
            asm volatile("s_waitcnt vmcnt(0)" ::: "memory");
        }
    }
    __syncthreads();
}

constexpr int NWAVES = 8;
constexpr int BATCH = 2, SEQ = 8192, DM = 1024, NTOK = BATCH * SEQ;
constexpr int D_IN = 1792, D_FF = 2816, NEXP = 16, CAP = 1024;
constexpr int NROWS_E = NEXP * BATCH * CAP;
constexpr float EPS = 1e-6f;
constexpr int KS_ADA = 16;
#ifndef PF_DIST
#define PF_DIST 0
#ifndef P10_MODE
#define P10_MODE 0
#endif
#endif
constexpr float Y8_SCALE = 16.f;
constexpr float W8_SCALE = 64.f, W8_INV = 1.f / 64.f;

constexpr size_t MiB = 1u << 20;
constexpr size_t WS_CTL = 0, CTL_ZERO_BYTES = 32768;
constexpr size_t WS_MODP = 1 * MiB;
constexpr size_t WS_AFF = 2 * MiB;
constexpr size_t WS_SLOTS = 3 * MiB;
constexpr size_t WS_IDX = 4 * MiB;
constexpr size_t WS_GATES = 4 * MiB + 128 * 1024;
constexpr size_t WS_WSB = 4 * MiB + 256 * 1024;
constexpr size_t WS_VSTAT = 11 * MiB;
constexpr size_t WS_WINT = 5 * MiB;
constexpr size_t WS_WOUTT = 9 * MiB;
constexpr size_t WS_WGUT = 12 * MiB;
constexpr size_t WS_WDT = 188 * MiB;
constexpr size_t WS_H = 276 * MiB;
constexpr size_t WS_YROWS = 308 * MiB;
constexpr size_t WS_HID = 372 * MiB;
constexpr size_t WS_Q = 372 * MiB;
constexpr size_t WS_K = 388 * MiB;
constexpr size_t WS_VT = 392 * MiB;
constexpr size_t WS_U = 396 * MiB;
constexpr size_t WS_VGT = 412 * MiB;
constexpr size_t WS_MIX = 428 * MiB;
constexpr size_t WS_T = 460 * MiB;
constexpr size_t WS_XS = 548 * MiB;
constexpr size_t WS_X1 = 612 * MiB;
constexpr size_t WS_END = 676 * MiB;
constexpr int CW_BAR = 4096;
constexpr int CW_P0CNT = 128;

constexpr int RING_OFF = 0, RING_BYTES = 131072;
constexpr int LDSCTL_OFF = 143360, MISC_OFF = LDSCTL_OFF + 320;
constexpr int LDS_BYTES = 147456;

struct Frame {
    LAS unsigned char* lds;
    volatile LAS unsigned* MISC;
    gu32* ctl;
    int tid, lane, wave;
    int vcu, G;
    const float* in[21];
    float* out;
    unsigned char* ws;
};
#define IN_X 0
#define IN_C 1
#define IN_WADA 2
#define IN_BADA 3
#define IN_NPREMIX 4
#define IN_NPOSTMIX 5
#define IN_WIN 6
#define IN_SINK 7
#define IN_LNG 8
#define IN_LNB 9
#define IN_WS 10
#define IN_BS 11
#define IN_NOATTN 12
#define IN_NOGMLP 13
#define IN_WOUT 14
#define IN_NPREFFN 15
#define IN_NPOSTFFN 16
#define IN_WROUTER 17
#define IN_WGATE 18
#define IN_WUP 19
#define IN_WDOWN 20

#define DPP_ADDF(v, ctrl, rmask) (v) += __builtin_bit_cast(float, __builtin_amdgcn_update_dpp(0, __builtin_bit_cast(int, (v)), (ctrl), (rmask), 0xf, true))
__device__ __forceinline__ float wave_sum(float v) {
    DPP_ADDF(v, 0xB1, 0xf); DPP_ADDF(v, 0x4E, 0xf); DPP_ADDF(v, 0x141, 0xf); DPP_ADDF(v, 0x140, 0xf); DPP_ADDF(v, 0x142, 0xa); DPP_ADDF(v, 0x143, 0xc);
    return __builtin_bit_cast(float, __builtin_amdgcn_readlane(__builtin_bit_cast(int, v), 63));
}
#define DPP_MAXF(v, ctrl, rmask) (v) = fmaxf((v), __builtin_bit_cast(float, __builtin_amdgcn_update_dpp(__builtin_bit_cast(int, (v)), __builtin_bit_cast(int, (v)), (ctrl), (rmask), 0xf, false)))
__device__ __forceinline__ float wave_max(float v) {
    DPP_MAXF(v, 0xB1, 0xf); DPP_MAXF(v, 0x4E, 0xf); DPP_MAXF(v, 0x141, 0xf); DPP_MAXF(v, 0x140, 0xf); DPP_MAXF(v, 0x142, 0xa); DPP_MAXF(v, 0x143, 0xc);
    return __builtin_bit_cast(float, __builtin_amdgcn_readlane(__builtin_bit_cast(int, v), 63));
}
__device__ __forceinline__ float bf2f(unsigned short b) { return __uint_as_float((unsigned)b << 16); }
__device__ __forceinline__ float bflo(unsigned u) { return __uint_as_float(u << 16); }
__device__ __forceinline__ float bfhi(unsigned u) { return __uint_as_float(u & 0xffff0000u); }

__device__ __forceinline__ void transpose_item(const float* W, int N, int k0, int n0, bf16* WT, int ldt, int dest_row0, LAS float* scr, int lane) {
#pragma unroll 8
    for (int i = 0; i < 32; ++i) { const int kk = 2 * i + (lane >> 5); scr[kk * 33 + (lane & 31)] = W[(size_t)(k0 + kk) * N + n0 + (lane & 31)]; }
    LDS_WAIT(); asm volatile("" ::: "memory");
    const int c = lane & 7;
#pragma unroll
    for (int j = 0; j < 4; ++j) { const int n = (lane >> 3) + 8 * j; const LAS float* s = scr + (8 * c) * 33 + n;
        v4u o; o.x = pk2(s[0 * 33], s[1 * 33]); o.y = pk2(s[2 * 33], s[3 * 33]); o.z = pk2(s[4 * 33], s[5 * 33]); o.w = pk2(s[6 * 33], s[7 * 33]);
        *(GAS v4u*)(WT + (size_t)(dest_row0 + n) * ldt + k0 + 8 * c) = o; }
    LDS_WAIT(); asm volatile("" ::: "memory");
}

constexpr int XI_PER_MAT = (DM / 128) * (D_FF / 32);
constexpr int XI_TOTAL = NEXP * 3 * XI_PER_MAT;
struct XItem { const float* src; unsigned char* dst; int N, ldt; };
__device__ __forceinline__ XItem xitem_decode(Frame& F, int it) {
    const int e = it / (3 * XI_PER_MAT), r = it % (3 * XI_PER_MAT), ty = r / XI_PER_MAT, r3 = r % XI_PER_MAT; XItem d;
    if (ty < 2) { const int kb = r3 / (D_FF / 32), n0 = 32 * (r3 % (D_FF / 32)), k0 = 128 * kb;
        d.N = D_FF; d.ldt = DM; d.src = (ty ? F.in[IN_WUP] : F.in[IN_WGATE]) + (size_t)e * DM * D_FF + (size_t)k0 * D_FF + n0;
        d.ldt = 128; d.dst = (unsigned char*)(F.ws + WS_WGUT) + (size_t)e * (2 * D_FF) * DM + ((size_t)((n0 >> 7) * (DM / 128) + kb) * 256 + ty * 128 + (n0 & 127)) * 128; }
    else { const int kb = r3 / (DM / 32), n0 = 32 * (r3 % (DM / 32)), k0 = 128 * kb;
        d.N = DM; d.ldt = D_FF; d.src = F.in[IN_WDOWN] + (size_t)e * D_FF * DM + (size_t)k0 * DM + n0;
        d.ldt = 128; d.dst = (unsigned char*)(F.ws + WS_WDT) + (size_t)e * DM * D_FF + ((size_t)((n0 >> 8) * (D_FF / 128) + kb) * 256 + (n0 & 255)) * 128; }
    return d;
}
__device__ __forceinline__ void xitem_load(const XItem& d, f32x4 (&r)[16], int lane) {
    const float* p = d.src + (size_t)(lane >> 3) * d.N + 4 * (lane & 7);
#pragma unroll
    for (int i = 0; i < 16; ++i) r[i] = __builtin_nontemporal_load((const f32x4*)(p + (size_t)(8 * i) * d.N));
}
__device__ __forceinline__ void xitem_finish(const XItem& d, const f32x4 (&r)[16], LAS float* scr, int lane) {
    LAS float* w = scr + (lane >> 3) * 33 + 4 * (lane & 7);
#pragma unroll
    for (int i = 0; i < 16; ++i) { const f32x4 v = r[i] * W8_SCALE; w[i * 264] = v.x; w[i * 264 + 1] = v.y; w[i * 264 + 2] = v.z; w[i * 264 + 3] = v.w; }
    LDS_WAIT(); asm volatile("" ::: "memory");
    const int c = lane & 7;
#pragma unroll
    for (int j = 0; j < 4; ++j) { const int n = (lane >> 3) + 8 * j; const LAS float* s = scr + (16 * c) * 33 + n;
        v4u o;
        o.x = pg8::pk4_fp8(s[0 * 33], s[1 * 33], s[2 * 33], s[3 * 33]);
        o.y = pg8::pk4_fp8(s[4 * 33], s[5 * 33], s[6 * 33], s[7 * 33]);
        o.z = pg8::pk4_fp8(s[8 * 33], s[9 * 33], s[10 * 33], s[11 * 33]);
        o.w = pg8::pk4_fp8(s[12 * 33], s[13 * 33], s[14 * 33], s[15 * 33]);
        __builtin_nontemporal_store(o, (v4u*)(d.dst + (size_t)n * d.ldt + 16 * c)); }
    LDS_WAIT(); asm volatile("" ::: "memory");
}
constexpr int XI_R0 = 25600, XI_R1 = 28400;
__device__ __forceinline__ void p0_expert_items(Frame& F, int first, int end, int widx, int nworkers) {
    LAS float* scr = (LAS float*)(F.lds + F.wave * 16896);
    const int lane = F.lane;
    const int it0 = first + widx; if (it0 >= end) return;
    const int n = (end - it0 + nworkers - 1) / nworkers;
    f32x4 rA[16], rB[16]; XItem dA = xitem_decode(F, it0), dB; xitem_load(dA, rA, lane);
    int j = 1;
#pragma unroll 1
    for (; j + 1 < n; j += 2) {
        dB = xitem_decode(F, it0 + j * nworkers); xitem_load(dB, rB, lane); __builtin_amdgcn_sched_barrier(0);
        xitem_finish(dA, rA, scr, lane); __builtin_amdgcn_sched_barrier(0);
        dA = xitem_decode(F, it0 + (j + 1) * nworkers); xitem_load(dA, rA, lane); __builtin_amdgcn_sched_barrier(0);
        xitem_finish(dB, rB, scr, lane); __builtin_amdgcn_sched_barrier(0);
    }
    if (j < n) { dB = xitem_decode(F, it0 + j * nworkers); xitem_load(dB, rB, lane); xitem_finish(dA, rA, scr, lane); xitem_finish(dB, rB, scr, lane); }
    else xitem_finish(dA, rA, scr, lane);
}

__device__ __forceinline__ void p0_prologue(Frame& F) {
    LAS float* scr = (LAS float*)(F.lds + F.wave * 16896);
    const int gw = F.vcu * NWAVES + F.wave, NGW = F.G * NWAVES, lane = F.lane;
    {
        const float* c = F.in[IN_C]; const float* W = F.in[IN_WADA]; float* modp = (float*)(F.ws + WS_MODP);
        constexpr int KPS = DM / KS_ADA;
        for (int it = gw; it < 96 * KS_ADA; it += NGW) {
            const int cg = it % 96, ks = it / 96, col = cg * 64 + lane;
            float a0 = 0.f, a1 = 0.f;
#pragma unroll 16
            for (int kk = 0; kk < KPS; ++kk) { const int k = ks * KPS + kk; const float w = W[(size_t)k * 6144 + col];
                const float c0 = c[k], c1 = c[DM + k];
                a0 += (c0 / (1.f + __expf(-c0))) * w; a1 += (c1 / (1.f + __expf(-c1))) * w; }
            __hip_atomic_store(modp + (size_t)(ks * 2 + 0) * 6144 + col, a0, __ATOMIC_RELAXED, __HIP_MEMORY_SCOPE_AGENT);
            __hip_atomic_store(modp + (size_t)(ks * 2 + 1) * 6144 + col, a1, __ATOMIC_RELAXED, __HIP_MEMORY_SCOPE_AGENT);
        }
        asm volatile("s_waitcnt vmcnt(0)" ::: "memory");
        if (lane == 0) __hip_atomic_fetch_add((unsigned*)(F.ctl + CW_P0CNT), 1u, __ATOMIC_RELAXED, __HIP_MEMORY_SCOPE_AGENT);
    }
    {
        const float* wsf = F.in[IN_WS]; bf16* wsb = (bf16*)(F.ws + WS_WSB);
        for (int o = gw * 64 + lane; o < 8 * 8 * 4 * 64; o += NGW * 64) { const int ln = o & 63, tb = (o >> 6) & 3, ks = (o >> 8) & 7, g = o >> 11, r32 = ln & 31, hi = ln >> 5;
            const float* src = wsf + (size_t)(g * 128 + 32 * tb + r32) * 128 + 16 * ks + 8 * hi; const f32x4 v0 = *(const f32x4*)src, v1 = *(const f32x4*)(src + 4);
            v4u pk; pk.x = pk2(v0.x, v0.y); pk.y = pk2(v0.z, v0.w); pk.z = pk2(v1.x, v1.y); pk.w = pk2(v1.z, v1.w); *(v4u*)(wsb + (size_t)o * 8) = pk; }
    }
    constexpr int I_IN = (DM / 64) * (D_IN / 32), I_OUT = (DM / 64) * (DM / 32);
    for (int it = gw; it < I_IN + I_OUT; it += NGW) {
        int r = it;
        if (r < I_IN) { const int nb = D_IN / 32, kb = r / nb, n0 = 32 * (r % nb); transpose_item(F.in[IN_WIN], D_IN, 64 * kb, n0, (bf16*)(F.ws + WS_WINT), DM, n0, scr, lane); continue; } r -= I_IN;
        { const int nb = DM / 32, kb = r / nb, n0 = 32 * (r % nb); transpose_item(F.in[IN_WOUT], DM, 64 * kb, n0, (bf16*)(F.ws + WS_WOUTT), DM, n0, scr, lane); }
    }
    p0_expert_items(F, 0, XI_R0, gw, NGW);
}
__device__ __forceinline__ void p0_wait_published(Frame& F) {
    if (F.wave == 0) { const unsigned want = (unsigned)(F.G * NWAVES); unsigned sp = 0;
        while ((unsigned)__builtin_amdgcn_readfirstlane((int)__hip_atomic_load((unsigned*)(F.ctl + CW_P0CNT), __ATOMIC_RELAXED, __HIP_MEMORY_SCOPE_AGENT)) < want) { __builtin_amdgcn_s_sleep(2); if (++sp > (1u << 22)) break; }
        __builtin_amdgcn_fence(__ATOMIC_ACQUIRE, "agent"); asm volatile("s_waitcnt vmcnt(0)" ::: "memory"); }
    __syncthreads();
}

__device__ __forceinline__ void mod_to_lds(Frame& F, LAS float* dst, int col0, int ncols) {
    const float* modp = (const float*)(F.ws + WS_MODP); const float* bada = F.in[IN_BADA];
#pragma unroll 4
    for (int i = F.tid; i < 2 * ncols; i += NWAVES * 64) { const int b = i / ncols, j = i % ncols; float s = bada[col0 + j];
#pragma unroll
        for (int ks = 0; ks < KS_ADA; ++ks) s += modp[(size_t)(ks * 2 + b) * 6144 + col0 + j];
        dst[i] = s; }
    __syncthreads();
}
constexpr size_t WS_MODF = WS_MODP + (size_t)KS_ADA * 2 * 6144 * 4;
__device__ __forceinline__ void modf_write(Frame& F) {
    const float* modp = (const float*)(F.ws + WS_MODP); const float* bada = F.in[IN_BADA]; float* modf = (float*)(F.ws + WS_MODF);
    const int i = (int)blockIdx.x * NWAVES * 64 + F.tid;
    if (i < 2 * 4096) { const int b = i >> 12, col = 2048 + (i & 4095); float s = bada[col];
#pragma unroll
        for (int ks = 0; ks < KS_ADA; ++ks) s += modp[(size_t)(ks * 2 + b) * 6144 + col];
        modf[b * 6144 + col] = s; }
}
__device__ __forceinline__ void modf_to_lds(Frame& F, LAS float* dst, int col0, int ncols) {
    const float* modf = (const float*)(F.ws + WS_MODF);
#pragma unroll 4
    for (int i = F.tid; i < 2 * ncols; i += NWAVES * 64) { const int b = i / ncols, j = i % ncols; dst[i] = modf[b * 6144 + col0 + j]; }
    __syncthreads();
}

__device__ __forceinline__ void p1_prenorm(Frame& F) {
    LAS float* md = (LAS float*)(F.lds + RING_OFF);
    p0_wait_published(F);
    modf_write(F);
    mod_to_lds(F, md, 0, 2048);
    const int gw = F.vcu * NWAVES + F.wave, NGW = F.G * NWAVES, lane = F.lane;
    const float* x = F.in[IN_X]; const float* g = F.in[IN_NPREMIX]; bf16* h = (bf16*)(F.ws + WS_H);
    f32x4 gq[4];
#pragma unroll
    for (int j = 0; j < 4; ++j) gq[j] = *(const f32x4*)(g + 4 * lane + 256 * j);
    f32x4 vn[4];
    if (gw < NTOK) { const f32x4* xr = (const f32x4*)(x + (size_t)gw * DM) + lane;
#pragma unroll
        for (int j = 0; j < 4; ++j) vn[j] = xr[64 * j]; }
    for (int m = gw; m < NTOK; m += NGW) {
        const int b = m >> 13;
        f32x4 v[4]; float ss = 0.f;
#pragma unroll
        for (int j = 0; j < 4; ++j) { v[j] = vn[j]; ss += (v[j].x * v[j].x + v[j].y * v[j].y) + (v[j].z * v[j].z + v[j].w * v[j].w); }
        const float rstd = rsqrtf(wave_sum(ss) * (1.f / DM) + EPS);
        unsigned long long* o8 = (unsigned long long*)(h + (size_t)m * DM) + lane;
#pragma unroll
        for (int j = 0; j < 4; ++j) { const int col = 4 * lane + 256 * j; const f32x4 gg = gq[j];
            const f32x4 sh = *(const LAS f32x4*)(md + b * 2048 + col), sc = *(const LAS f32x4*)(md + b * 2048 + 1024 + col);
            const f32x4 r = (v[j] * rstd * gg) * (sc + 1.f) + sh;
            o8[64 * j] = (unsigned long long)pk2(r.x, r.y) | ((unsigned long long)pk2(r.z, r.w) << 32); }
        if (m + NGW < NTOK) { const f32x4* xr = (const f32x4*)(x + (size_t)(m + NGW) * DM) + lane;
#pragma unroll
            for (int j = 0; j < 4; ++j) vn[j] = xr[64 * j]; }
    }
    __syncthreads();
}

typedef float f32x16 __attribute__((ext_vector_type(16)));
typedef short s16x4 __attribute__((ext_vector_type(4)));
typedef float f32x2_t __attribute__((ext_vector_type(2))); typedef __bf16 bf16x2_t __attribute__((ext_vector_type(2)));
__device__ __forceinline__ unsigned cvtpk(float lo, float hi) { f32x2_t v = {lo, hi}; bf16x2_t bb = __builtin_convertvector(v, bf16x2_t); return __builtin_bit_cast(unsigned, bb); }
__device__ __forceinline__ int crow(int i, int hi) { return (i & 3) + 8 * (i >> 2) + 4 * hi; }
#define MFMA32(a, b, c) __builtin_amdgcn_mfma_f32_32x32x16_bf16((a), (b), (c), 0, 0, 0)
constexpr int AT_KB = 24576, AT_VB = 25600, AT_BUF = AT_KB + AT_VB, AT_SQ = 2 * AT_BUF;
struct AtStage { v4u k[3], v[3]; };
__device__ __forceinline__ void at_load(AtStage& st, const bf16* k, const bf16* vT, int b, int q0, int c, int tid) {
#pragma unroll
    for (int i = 0; i < 3; ++i) { const int kb = q0 - 128 + 32 * (3 * c + i), kbc = kb < 0 ? 0 : (kb > SEQ - 32 ? SEQ - 32 : kb);
        st.k[i] = *(const v4u*)(k + (size_t)(b * SEQ + kbc + (tid >> 4)) * 128 + (tid & 15) * 8);
        st.v[i] = *(const v4u*)(vT + (size_t)(b * 128 + (tid >> 2)) * SEQ + kbc + (tid & 3) * 8); }
}
__device__ __forceinline__ void at_store(const AtStage& st, LAS unsigned char* buf, int tid) {
#pragma unroll
    for (int i = 0; i < 3; ++i) { const int key = 32 * i + (tid >> 4), ch16 = tid & 15, kvh = ch16 >> 3, ch = ch16 & 7;
        *(LAS v4u*)(buf + kvh * 12288 + key * 128 + ((ch ^ (key & 7)) << 4)) = st.k[i];
        const int row = tid >> 2, pc = tid & 3; LAS unsigned char* vp = buf + AT_KB + (row >> 6) * 12800 + (row & 63) * 200 + (32 * i + 8 * pc) * 2;
        typedef unsigned u32x2_t __attribute__((ext_vector_type(2)));
        *(LAS u32x2_t*)vp = (u32x2_t){st.v[i].x, st.v[i].y}; *(LAS u32x2_t*)(vp + 8) = (u32x2_t){st.v[i].z, st.v[i].w}; }
}
#define AT_TILE(KT, TL, MODE) do { const int kb_ = q0 - 128 + 32 * (KT); if (kb_ >= 0 && kb_ < SEQ) { \
    const int key_ = 32 * (TL) + r32; bf16x8 kf_[4]; \
    _Pragma("unroll") for (int ks = 0; ks < 4; ++ks) kf_[ks] = *(const LAS bf16x8*)(kimg + key_ * 128 + (((2 * ks + hi) ^ (key_ & 7)) << 4)); \
    bf16x8 va_[2][2]; \
    _Pragma("unroll") for (int db = 0; db < 2; ++db) _Pragma("unroll") for (int sx = 0; sx < 2; ++sx) { const LAS unsigned char* vp_ = vimg + (32 * db + r32) * 200 + (32 * (TL) + 16 * sx + 4 * hi) * 2; \
        const s16x4 lo_ = *(const LAS s16x4*)vp_, hv_ = *(const LAS s16x4*)(vp_ + 16); va_[db][sx] = __builtin_shufflevector(lo_, hv_, 0, 1, 2, 3, 4, 5, 6, 7); } \
    f32x16 st_; _Pragma("unroll") for (int i = 0; i < 16; ++i) st_[i] = 0.f; \
    _Pragma("unroll") for (int ks = 0; ks < 4; ++ks) st_ = MFMA32(kf_[ks], *(const LAS bf16x8*)(ot + ks * 1024 + lane * 16), st_); \
    float bt_ = 0.f; \
    if (MODE == 1) { bt_ = Bp - sl2 * (float)(128 - 32 * (KT)); _Pragma("unroll") for (int i = 0; i < 16; ++i) st_[i] = __builtin_fmaf(st_[i], c0, Kc[i]); } \
    else if (MODE == 2) { bt_ = -Bp - sl2 * (float)(32 * (KT) - 128); _Pragma("unroll") for (int i = 0; i < 16; ++i) st_[i] = __builtin_fmaf(st_[i], c0, -Kc[i]); } \
    else if (MODE == 3) { bt_ = Bp - sl2 * 128.f;              \
        _Pragma("unroll") for (int i = 0; i < 16; ++i) st_[i] = ((i & 3) + 8 * (i >> 2) + 4 * hi >= r32) ? __builtin_fmaf(st_[i], c0, Kc[i]) : -1e30f; } \
    else if (MODE == 4) { bt_ = -Bp - sl2 * 128.f;             \
        _Pragma("unroll") for (int i = 0; i < 16; ++i) st_[i] = ((i & 3) + 8 * (i >> 2) + 4 * hi <= r32) ? __builtin_fmaf(st_[i], c0, -Kc[i]) : -1e30f; } \
    else {                                                     \
        _Pragma("unroll") for (int i = 0; i < 16; ++i) st_[i] = __builtin_fmaf(-sl2, __builtin_fabsf(rh - (float)((i & 3) + 8 * (i >> 2))), st_[i] * c0); } \
    float ta_ = fmaxf(fmaxf(st_[0], st_[1]), st_[2]), tb_ = fmaxf(fmaxf(st_[3], st_[4]), st_[5]); \
    ta_ = fmaxf(fmaxf(ta_, st_[6]), st_[7]); tb_ = fmaxf(fmaxf(tb_, st_[8]), st_[9]); ta_ = fmaxf(fmaxf(ta_, st_[10]), st_[11]); tb_ = fmaxf(fmaxf(tb_, st_[12]), st_[13]); \
    float tmax_ = fmaxf(fmaxf(ta_, tb_), fmaxf(st_[14], st_[15])) + bt_; tmax_ = fmaxf(tmax_, __shfl_xor(tmax_, 32)); \
    if (__any(tmax_ > m_run)) { const float mn_ = fmaxf(m_run, tmax_), al_ = __builtin_amdgcn_exp2f(m_run - mn_); m_run = mn_; l_run *= al_; \
        _Pragma("unroll") for (int i = 0; i < 16; ++i) { o0[i] *= al_; o1[i] *= al_; } } \
    const float dl_ = bt_ - m_run; float ps_ = 0.f; \
    _Pragma("unroll") for (int i = 0; i < 16; ++i) { const float p_ = __builtin_amdgcn_exp2f(st_[i] + dl_); st_[i] = p_; ps_ += p_; } \
    ps_ += __shfl_xor(ps_, 32); l_run += ps_; \
    v4u p0_, p1_; \
    p0_.x = cvtpk(st_[0], st_[1]); p0_.y = cvtpk(st_[2], st_[3]); p0_.z = cvtpk(st_[4], st_[5]); p0_.w = cvtpk(st_[6], st_[7]); \
    p1_.x = cvtpk(st_[8], st_[9]); p1_.y = cvtpk(st_[10], st_[11]); p1_.z = cvtpk(st_[12], st_[13]); p1_.w = cvtpk(st_[14], st_[15]); \
    const bf16x8 pb0_ = __builtin_bit_cast(bf16x8, p0_), pb1_ = __builtin_bit_cast(bf16x8, p1_); \
    o0 = MFMA32(va_[0][0], pb0_, o0); o0 = MFMA32(va_[0][1], pb1_, o0); o1 = MFMA32(va_[1][0], pb0_, o1); o1 = MFMA32(va_[1][1], pb1_, o1); } } while (0)
#define AT_CHUNK(C, NC, NU, M0, M1, M2) do { LAS unsigned char* buf = ring + par * AT_BUF; par ^= 1; at_store(st, buf, tid); __syncthreads(); \
    if ((NU) < uend) at_load(st, k, vT, ((NU) * 32) >> 13, ((NU) * 32) & 8191, (NC), tid); \
    const LAS unsigned char* kimg = buf + kvh * 12288; const LAS unsigned char* vimg = buf + AT_KB + kvh * 12800; \
    AT_TILE(3 * (C) + 0, 0, M0); __builtin_amdgcn_sched_barrier(0); AT_TILE(3 * (C) + 1, 1, M1); __builtin_amdgcn_sched_barrier(0); AT_TILE(3 * (C) + 2, 2, M2); } while (0)
__device__ __forceinline__ void p3_attn_mfma(Frame& F) {
    const int tid = F.tid, lane = F.lane, r32 = lane & 31, hi = lane >> 5, hh = F.wave, kvh = hh >> 2;
    LAS unsigned char* ring = F.lds + RING_OFF; LAS float* SQ = (LAS float*)(ring + AT_SQ);
    const bf16* q = (const bf16*)(F.ws + WS_Q); const bf16* k = (const bf16*)(F.ws + WS_K); const bf16* vT = (const bf16*)(F.ws + WS_VT);
    bf16* mix = (bf16*)(F.ws + WS_MIX); const float* gn = F.in[IN_NOATTN];
    constexpr float LOG2E = 1.4426950408889634f;
    const float slope = exp2f(-(float)(hh + 1)), sl2 = slope * LOG2E, c0 = 0.125f * LOG2E, sink2 = F.in[IN_SINK][hh] * LOG2E;
    const float rh = (float)(r32 - 4 * hi), Bp = -sl2 * rh;
    float Kc[16];
#pragma unroll
    for (int i = 0; i < 16; ++i) Kc[i] = sl2 * (float)((i & 3) + 8 * (i >> 2));
    LAS unsigned char* ot = ring + AT_SQ + 1024 + hh * 4096;
    const int nunits = NTOK / 32; const bool bal = (F.G == 256); const int ustep = bal ? 128 : F.G, uend = bal ? (F.vcu < 128 ? F.vcu + 1 : nunits) : nunits;
    int unit = F.vcu; if (unit >= uend) return;
    AtStage st; at_load(st, k, vT, (unit * 32) >> 13, (unit * 32) & 8191, 1, tid);
    int par = 0;
    for (; unit < uend; unit += ustep) {
        const int tok0 = unit * 32, b = tok0 >> 13, q0 = tok0 & 8191, qpos = q0 + r32;
#pragma unroll
        for (int ks = 0; ks < 4; ++ks) *(LAS bf16x8*)(ot + ks * 1024 + lane * 16) = *(const bf16x8*)(q + (size_t)(tok0 + r32) * 512 + hh * 64 + 16 * ks + 8 * hi);
        f32x16 o0, o1;
#pragma unroll
        for (int i = 0; i < 16; ++i) { o0[i] = 0.f; o1[i] = 0.f; }
        float m_run = sink2, l_run = 1.f;
        AT_CHUNK(1, 0, unit, 1, 0, 2);
        AT_CHUNK(0, 2, unit, 3, 1, 1);
        AT_CHUNK(2, 1, unit + ustep, 2, 2, 4);
        (void)b;
        const float inv = 1.f / l_run; float sq = 0.f;
#pragma unroll
        for (int i = 0; i < 16; ++i) { o0[i] *= inv; o1[i] *= inv; sq += o0[i] * o0[i] + o1[i] * o1[i]; }
        sq += __shfl_xor(sq, 32);
        if (hi == 0) SQ[hh * 32 + r32] = sq;
        __syncthreads();
        float tot = 0.f;
#pragma unroll
        for (int w8 = 0; w8 < 8; ++w8) tot += SQ[w8 * 32 + r32];
        const float rstd = rsqrtf(tot * (1.f / 512.f) + EPS);
#pragma unroll
        for (int g4 = 0; g4 < 4; ++g4) { const int d0 = 8 * g4 + 4 * hi; const f32x4 ga = *(const GAS f32x4*)(gn + hh * 64 + d0), gb = *(const GAS f32x4*)(gn + hh * 64 + 32 + d0);
            *(LAS unsigned long long*)(ot + r32 * 128 + ((g4 ^ (r32 & 7)) << 4) + 8 * hi) = (unsigned long long)cvtpk(o0[4 * g4] * rstd * ga.x, o0[4 * g4 + 1] * rstd * ga.y) | ((unsigned long long)cvtpk(o0[4 * g4 + 2] * rstd * ga.z, o0[4 * g4 + 3] * rstd * ga.w) << 32);
            *(LAS unsigned long long*)(ot + r32 * 128 + (((4 + g4) ^ (r32 & 7)) << 4) + 8 * hi) = (unsigned long long)cvtpk(o1[4 * g4] * rstd * gb.x, o1[4 * g4 + 1] * rstd * gb.y) | ((unsigned long long)cvtpk(o1[4 * g4 + 2] * rstd * gb.z, o1[4 * g4 + 3] * rstd * gb.w) << 32); }
#pragma unroll
        for (int i = 0; i < 4; ++i) { const int qq = 8 * i + (lane >> 3); const v4u v = *(const LAS v4u*)(ot + qq * 128 + (((lane & 7) ^ (qq & 7)) << 4));
            *(v4u*)(mix + (size_t)(tok0 + qq) * DM + hh * 64 + (lane & 7) * 8) = v; }
        __syncthreads();
    }
}
#undef AT_TILE
#undef AT_CHUNK

__device__ __forceinline__ void p3_gmlp_mfma(Frame& F) {
    __syncthreads();
    const int lane = F.lane, r32 = lane & 31, hi = lane >> 5, w = F.wave, ch0 = w * 64;
    LAS float* L = (LAS float*)(F.lds + RING_OFF + 131072);
    LAS float* MU = L; LAS float* RS = L + 128; LAS float* SQ = L + 256;
    LAS unsigned char* wt = F.lds + RING_OFF + w * 16384;
    const bf16* vgT = (const bf16*)(F.ws + WS_VGT); const bf16* u = (const bf16*)(F.ws + WS_U); bf16* mix = (bf16*)(F.ws + WS_MIX); const bf16* wsb = (const bf16*)(F.ws + WS_WSB);
    const float* bs = F.in[IN_BS]; const float* lng = F.in[IN_LNG]; const float* lnb = F.in[IN_LNB]; const float* gn = F.in[IN_NOGMLP];
    for (int unit = F.vcu; unit < BATCH * (SEQ / 128); unit += F.G) {
        const int b = unit >> 6, s0 = (unit & 63) * 128;
#pragma unroll
        for (int hb = 0; hb < 2; ++hb) { v4u ur[8];
#pragma unroll
          for (int i = 0; i < 8; ++i) ur[i] = *(const v4u*)(u + ((size_t)b * SEQ + s0 + 8 * (8 * hb + i) + (lane >> 3)) * 512 + ch0 + (lane & 7) * 8);
#pragma unroll
          for (int i = 0; i < 8; ++i) { const int t = 8 * (8 * hb + i) + (lane >> 3); *(LAS v4u*)(wt + t * 128 + (((lane & 7) ^ (t & 7)) << 4)) = ur[i]; }
          asm volatile("s_waitcnt lgkmcnt(0)" ::: "memory"); }
        if (F.tid < 128) { const float* vs = (const float*)(F.ws + WS_VSTAT) + ((size_t)b * SEQ + s0 + F.tid) * 2; float s1 = 0.f, s2 = 0.f;
#pragma unroll
            for (int p = 0; p < 8; ++p) { const f32x2_t t2 = *(const f32x2_t*)(vs + (size_t)p * NTOK * 2); s1 += t2.x; s2 += t2.y; }
            const float mean = s1 * (1.f / 512.f); float var = s2 * (1.f / 512.f) - mean * mean; var = var < 0.f ? 0.f : var;
            MU[F.tid] = mean; RS[F.tid] = rsqrtf(var + EPS); }
        __syncthreads();
        f32x16 z[2][4];
#pragma unroll
        for (int cb = 0; cb < 2; ++cb)
#pragma unroll
            for (int tb = 0; tb < 4; ++tb)
#pragma unroll
                for (int i = 0; i < 16; ++i) z[cb][tb][i] = 0.f;
        const float lg0 = lng[ch0 + r32], lb0 = lnb[ch0 + r32], lg1 = lng[ch0 + 32 + r32], lb1 = lnb[ch0 + 32 + r32];
#pragma unroll 2
        for (int ks = 0; ks < 8; ++ks) {
            const int sb = 16 * ks + 8 * hi;
            const f32x4 mua = *(const LAS f32x4*)(MU + sb), mub = *(const LAS f32x4*)(MU + sb + 4), rsa = *(const LAS f32x4*)(RS + sb), rsb = *(const LAS f32x4*)(RS + sb + 4);
            bf16x8 af[2];
#pragma unroll
            for (int cb = 0; cb < 2; ++cb) { const float lg = cb ? lg1 : lg0, lb = cb ? lb1 : lb0;
                const v4u raw = *(const v4u*)(vgT + ((((size_t)(b * 64 + (unit & 63)) * 8 + w) * 2 + cb) * 8 + ks) * 512 + lane * 8);
                v4u pk;
                pk.x = cvtpk((bflo(raw.x) - mua.x) * rsa.x * lg + lb, (bfhi(raw.x) - mua.y) * rsa.y * lg + lb);
                pk.y = cvtpk((bflo(raw.y) - mua.z) * rsa.z * lg + lb, (bfhi(raw.y) - mua.w) * rsa.w * lg + lb);
                pk.z = cvtpk((bflo(raw.z) - mub.x) * rsb.x * lg + lb, (bfhi(raw.z) - mub.y) * rsb.y * lg + lb);
                pk.w = cvtpk((bflo(raw.w) - mub.z) * rsb.z * lg + lb, (bfhi(raw.w) - mub.w) * rsb.w * lg + lb);
                af[cb] = __builtin_bit_cast(bf16x8, pk); }
#pragma unroll
            for (int tb = 0; tb < 4; ++tb) { const bf16x8 bfr = *(const bf16x8*)(wsb + ((size_t)((w * 8 + ks) * 4 + tb) * 64 + lane) * 8);
                z[0][tb] = MFMA32(af[0], bfr, z[0][tb]); z[1][tb] = MFMA32(af[1], bfr, z[1][tb]); }
        }
        int lq = lane; asm volatile("" : "+v"(lq)); const int r32e = lq & 31, hie = lq >> 5, l8 = lq & 7, l3 = lq >> 3;
        const float* bsl = bs; const float* gnl = gn; asm volatile("" : "+s"(bsl), "+s"(gnl));
#pragma unroll
        for (int tb = 0; tb < 4; ++tb) { const int t = 32 * tb + r32e; const float bsv = *(const GAS float*)(bsl + w * 128 + t); float sq = 0.f;
#pragma unroll
            for (int cb = 0; cb < 2; ++cb)
#pragma unroll
                for (int g4 = 0; g4 < 4; ++g4) { typedef unsigned u32x2_t __attribute__((ext_vector_type(2))); const u32x2_t ur = *(const LAS u32x2_t*)(wt + t * 128 + (((4 * cb + g4) ^ (t & 7)) << 4) + 8 * hie);
                    const float g0 = bflo(ur.x) * (z[cb][tb][4 * g4] + bsv), g1 = bfhi(ur.x) * (z[cb][tb][4 * g4 + 1] + bsv), g2 = bflo(ur.y) * (z[cb][tb][4 * g4 + 2] + bsv), g3 = bfhi(ur.y) * (z[cb][tb][4 * g4 + 3] + bsv);
                    z[cb][tb][4 * g4] = g0; z[cb][tb][4 * g4 + 1] = g1; z[cb][tb][4 * g4 + 2] = g2; z[cb][tb][4 * g4 + 3] = g3; sq += (g0 * g0 + g1 * g1) + (g2 * g2 + g3 * g3); }
            sq += __shfl_xor(sq, 32);
            if (hie == 0) SQ[w * 128 + t] = sq; asm volatile("" ::: "memory"); }
        __syncthreads();
#pragma unroll
        for (int tb = 0; tb < 4; ++tb) { const int t = 32 * tb + r32e; float tot = 0.f;
#pragma unroll
            for (int ww = 0; ww < 8; ++ww) tot += SQ[ww * 128 + t];
            const float rstd = rsqrtf(tot * (1.f / 512.f) + EPS);
#pragma unroll
            for (int cb = 0; cb < 2; ++cb)
#pragma unroll
                for (int g4 = 0; g4 < 4; ++g4) { const int c0 = 32 * cb + 8 * g4 + 4 * hie; const f32x4 gg = *(const GAS f32x4*)(gnl + ch0 + c0);
                    *(LAS unsigned long long*)(wt + t * 128 + (((4 * cb + g4) ^ (t & 7)) << 4) + 8 * hie) = (unsigned long long)cvtpk(z[cb][tb][4 * g4] * rstd * gg.x, z[cb][tb][4 * g4 + 1] * rstd * gg.y) | ((unsigned long long)cvtpk(z[cb][tb][4 * g4 + 2] * rstd * gg.z, z[cb][tb][4 * g4 + 3] * rstd * gg.w) << 32); } asm volatile("" ::: "memory"); }
#pragma unroll
        for (int i = 0; i < 16; ++i) { const int t = 8 * i + l3; const v4u v = *(const LAS v4u*)(wt + t * 128 + ((l8 ^ (t & 7)) << 4));
            *(v4u*)(mix + ((size_t)b * SEQ + s0 + t) * DM + 512 + ch0 + l8 * 8) = v; }
        __syncthreads();
    }
}

struct P5Ctx { LAS float* md; LAS float* wrT; const float* x; const bf16* t; unsigned char* h2; float* aff; bf16* x1; int lane, NGW; };
__device__ __forceinline__ void p5_issue(const P5Ctx& C, f32x4 (&xb)[4], uint2 (&tb)[4], int row) {
    const bool in = row < NTOK; const int ln = in ? C.lane : 0; const size_t ro = in ? (size_t)row * DM : 0;
    const f32x4* xr = (const f32x4*)(C.x + ro) + ln; const uint2* tr = (const uint2*)(C.t + ro) + ln;
#pragma unroll
    for (int j = 0; j < 4; ++j) { xb[j] = __builtin_nontemporal_load(xr + 64 * j); { typedef unsigned u32x2_t __attribute__((ext_vector_type(2))); const u32x2_t tq = __builtin_nontemporal_load((const u32x2_t*)(tr + 64 * j)); tb[j].x = tq.x; tb[j].y = tq.y; } }
}
__device__ __forceinline__ void p5_row(const P5Ctx& C, const f32x4 (&g1q)[4], const f32x4 (&g2q)[4], f32x4 (&xb)[4], uint2 (&tb)[4], int m) {
    if (m >= NTOK) return;
    LAS float* md = C.md; LAS float* wrT = C.wrT; unsigned char* h2 = C.h2; float* aff = C.aff; const int lane = C.lane;
        const int b = m >> 13, s = m & 8191;
        f32x4 tv[4], xv[4]; float ss = 0.f;
#pragma unroll
        for (int j = 0; j < 4; ++j) { const uint2 tq = tb[j]; tv[j] = (f32x4){bflo(tq.x), bfhi(tq.x), bflo(tq.y), bfhi(tq.y)}; xv[j] = xb[j]; ss += (tv[j].x * tv[j].x + tv[j].y * tv[j].y) + (tv[j].z * tv[j].z + tv[j].w * tv[j].w); }
        const float rstd1 = rsqrtf(wave_sum(ss) * (1.f / DM) + EPS);
        float ss2 = 0.f; unsigned long long* orow = (unsigned long long*)(C.x1 + (size_t)m * DM) + lane;
#pragma unroll
        for (int j = 0; j < 4; ++j) { const int col = 4 * lane + 256 * j; const f32x4 gg = g1q[j], ga = *(const LAS f32x4*)(md + b * 3072 + col);
            xv[j] = xv[j] + ga * (tv[j] * rstd1 * gg); orow[64 * j] = (unsigned long long)cvtpk(xv[j].x, xv[j].y) | ((unsigned long long)cvtpk(xv[j].z, xv[j].w) << 32);
            ss2 += (xv[j].x * xv[j].x + xv[j].y * xv[j].y) + (xv[j].z * xv[j].z + xv[j].w * xv[j].w); }
        const float rstd2 = rsqrtf(wave_sum(ss2) * (1.f / DM) + EPS);
        unsigned* o8 = (unsigned*)(h2 + (size_t)m * DM) + lane;
        f32x4 hv[4];
#pragma unroll
        for (int j = 0; j < 4; ++j) { const int col = 4 * lane + 256 * j; const f32x4 gg = g2q[j];
            const f32x4 sh = *(const LAS f32x4*)(md + b * 3072 + 1024 + col), sc = *(const LAS f32x4*)(md + b * 3072 + 2048 + col);
            hv[j] = (xv[j] * rstd2 * gg) * (sc + 1.f) + sh;
            o8[64 * j] = pg8::pk4_fp8(hv[j].x, hv[j].y, hv[j].z, hv[j].w); }
        float lg[16];
#pragma unroll
        for (int eg = 0; eg < 4; ++eg) { f32x4 wv[4][4];
#pragma unroll
            for (int e4 = 0; e4 < 4; ++e4)
#pragma unroll
                for (int j = 0; j < 4; ++j) wv[e4][j] = *(const LAS f32x4*)(wrT + (4 * eg + e4) * DM + 4 * lane + 256 * j);
#pragma unroll
            for (int e4 = 0; e4 < 4; ++e4) { f32x2_t a2 = {0.f, 0.f};
#pragma unroll
                for (int j = 0; j < 4; ++j) { a2 += (f32x2_t){hv[j].x, hv[j].y} * (f32x2_t){wv[e4][j].x, wv[e4][j].y}; a2 += (f32x2_t){hv[j].z, hv[j].w} * (f32x2_t){wv[e4][j].z, wv[e4][j].w}; }
                float a = a2.x + a2.y; asm volatile("" : "+v"(a)); lg[4 * eg + e4] = a; } }
        float v8[8];
#pragma unroll
        for (int e = 0; e < 8; ++e) { const auto r = __builtin_amdgcn_permlane32_swap(__float_as_uint(lg[e]), __float_as_uint(lg[e + 8]), false, false); v8[e] = __uint_as_float(r[0]) + __uint_as_float(r[1]); }
        const bool b4 = (lane & 16) != 0, b3 = (lane & 8) != 0, b2 = (lane & 4) != 0;
        float v4[4];
#pragma unroll
        for (int i = 0; i < 4; ++i) { const float snd = b4 ? v8[i] : v8[i + 4], kp = b4 ? v8[i + 4] : v8[i]; v4[i] = kp + __shfl_xor(snd, 16); }
        float v2[2];
#pragma unroll
        for (int i = 0; i < 2; ++i) { const float snd = b3 ? v4[i] : v4[i + 2], kp = b3 ? v4[i + 2] : v4[i]; v2[i] = kp + __shfl_xor(snd, 8); }
        float tl; { const float snd = b2 ? v2[0] : v2[1], kp = b2 ? v2[1] : v2[0]; tl = kp + __shfl_xor(snd, 4); }
        DPP_ADDF(tl, 0x4E, 0xf); DPP_ADDF(tl, 0xB1, 0xf);
        const float mx = wave_max(tl), ex = __expf(tl - mx), se = wave_sum(ex) * 0.25f;
        if ((lane & 3) == 0) aff[(size_t)(b * NEXP + (lane >> 2)) * SEQ + s] = ex / se;
}
__device__ __forceinline__ void p5_postmix(Frame& F) {
    LAS float* md = (LAS float*)(F.lds + RING_OFF);
    LAS float* wrT = (LAS float*)(F.lds + RING_OFF + 32768);
#pragma unroll 16
    for (int i = F.tid; i < DM * NEXP; i += NWAVES * 64) { const int col = i >> 4, e = i & 15; wrT[e * DM + col] = F.in[IN_WROUTER][i]; }
    modf_to_lds(F, md, 2048, 3072);
    const int gw = F.vcu * NWAVES + F.wave, NGW = F.G * NWAVES, lane = F.lane;
    const float* g1 = F.in[IN_NPOSTMIX]; const float* g2 = F.in[IN_NPREFFN];
    const P5Ctx C{md, wrT, F.in[IN_X], (const bf16*)(F.ws + WS_T), (unsigned char*)(F.ws + WS_H), (float*)(F.ws + WS_AFF), (bf16*)(F.ws + WS_X1), lane, NGW};
    f32x4 g1q[4], g2q[4];
#pragma unroll
    for (int j = 0; j < 4; ++j) { g1q[j] = *(const f32x4*)(g1 + 4 * lane + 256 * j); g2q[j] = *(const f32x4*)(g2 + 4 * lane + 256 * j); }
    f32x4 xA[4], xB[4]; uint2 tA[4], tB[4];
    p5_issue(C, xA, tA, gw); __builtin_amdgcn_sched_barrier(0);
#pragma unroll 1
    for (int m = gw; m < NTOK; m += 2 * NGW) {
        p5_issue(C, xB, tB, m + NGW); __builtin_amdgcn_sched_barrier(0);
        p5_row(C, g1q, g2q, xA, tA, m); __builtin_amdgcn_sched_barrier(0);
        p5_issue(C, xA, tA, m + 2 * NGW); __builtin_amdgcn_sched_barrier(0);
        p5_row(C, g1q, g2q, xB, tB, m + NGW); __builtin_amdgcn_sched_barrier(0);
    }
    __syncthreads();
}

__device__ __forceinline__ void p6_topk(Frame& F) {
    LAS unsigned* vals = (LAS unsigned*)(F.lds + RING_OFF);
    LAS unsigned* hist = (LAS unsigned*)(F.lds + RING_OFF + 32768);
    LAS unsigned* misc = (LAS unsigned*)(F.lds + RING_OFF + 32768 + 1024);
    const int tid = F.tid, lane = F.lane, w = F.wave;
    const float* aff = (const float*)(F.ws + WS_AFF); int* slots = (int*)(F.ws + WS_SLOTS); int* idx = (int*)(F.ws + WS_IDX); float* gates = (float*)(F.ws + WS_GATES);
    if (F.vcu >= BATCH * NEXP) { if (F.G > BATCH * NEXP) p0_expert_items(F, XI_R1, XI_TOTAL, (F.vcu - BATCH * NEXP) * NWAVES + F.wave, (F.G - BATCH * NEXP) * NWAVES); return; }
    if (F.G <= BATCH * NEXP && F.vcu == 0) p0_expert_items(F, XI_R1, XI_TOTAL, F.wave, NWAVES);
    for (int unit = F.vcu; unit < BATCH * NEXP; unit += F.G) {
        const int b = unit >> 4, e = unit & 15;
        __syncthreads();
        const unsigned* src = (const unsigned*)(aff + (size_t)unit * SEQ);
        for (int i = tid; i < SEQ; i += NWAVES * 64) vals[i] = src[i];
        unsigned prefix = 0u, mask = 0u, need = CAP;
#pragma unroll 1
        for (int pass = 0; pass < 4; ++pass) {
            const int shift = 24 - 8 * pass;
            if (tid < 256) hist[tid] = 0u;
            __syncthreads();
            for (int i = tid; i < SEQ; i += NWAVES * 64) { const unsigned v = vals[i]; if ((v & mask) == prefix) __hip_atomic_fetch_add(&hist[(v >> shift) & 255u], 1u, __ATOMIC_RELAXED, __HIP_MEMORY_SCOPE_WORKGROUP); }
            __syncthreads();
            if (w == 0) {
                const unsigned b0 = hist[4 * lane], b1 = hist[4 * lane + 1], b2 = hist[4 * lane + 2], b3 = hist[4 * lane + 3];
                const unsigned sl = b0 + b1 + b2 + b3; unsigned suf = sl;
#pragma unroll
                for (int o = 1; o < 64; o <<= 1) { const unsigned tv = __shfl_down(suf, o); if (lane + o < 64) suf += tv; }
                const unsigned above = suf - sl;
                if (above < need && need <= above + sl) {
                    unsigned cnt = above, dig, nn;
                    if (cnt + b3 >= need) { dig = 3; nn = need - cnt; } else { cnt += b3;
                    if (cnt + b2 >= need) { dig = 2; nn = need - cnt; } else { cnt += b2;
                    if (cnt + b1 >= need) { dig = 1; nn = need - cnt; } else { cnt += b1; dig = 0; nn = need - cnt; } } }
                    misc[0] = 4u * lane + dig; misc[1] = nn; }
            }
            __syncthreads();
            prefix |= misc[0] << shift; mask |= 255u << shift; need = misc[1];
            __syncthreads();
        }
        const unsigned T = prefix; unsigned gt = 0u, eq = 0u; unsigned v16[16];
#pragma unroll
        for (int i = 0; i < 16; ++i) { v16[i] = vals[16 * tid + i]; gt += (v16[i] > T) ? 1u : 0u; eq += (v16[i] == T) ? 1u : 0u; }
        unsigned pk = gt | (eq << 16), inc = pk;
#pragma unroll
        for (int o = 1; o < 64; o <<= 1) { const unsigned tv = __shfl_up(inc, o); if (lane >= o) inc += tv; }
        if (lane == 63) misc[16 + w] = inc;
        __syncthreads();
        unsigned base = 0u;
#pragma unroll
        for (int ww = 0; ww < 8; ++ww) base += (ww < w) ? misc[16 + ww] : 0u;
        const unsigned exc = base + inc - pk; unsigned gtb = exc & 0xffffu, eqb = exc >> 16;
#pragma unroll
        for (int i = 0; i < 16; ++i) { const int tok = 16 * tid + i; const unsigned v = v16[i]; int slot = -1;
            if (v > T) { slot = (int)(gtb + (eqb < need ? eqb : need)); ++gtb; }
            else if (v == T) { if (eqb < need) slot = (int)(gtb + eqb); ++eqb; }
            slots[(size_t)(b * SEQ + tok) * NEXP + e] = slot;
            if (slot >= 0) { idx[(e * BATCH + b) * CAP + slot] = b * SEQ + tok; gates[unit * CAP + slot] = __uint_as_float(v); } }
    }
    __syncthreads();
}

__device__ __forceinline__ void p6b_gather(Frame& F) {
    const int gw = F.vcu * NWAVES + F.wave, NGW = F.G * NWAVES, lane = F.lane;
    const int* idx = (const int*)(F.ws + WS_IDX); const unsigned char* h2 = (const unsigned char*)(F.ws + WS_H); unsigned char* xs = (unsigned char*)(F.ws + WS_XS);
    for (int r = gw; r < NROWS_E; r += NGW) { const int e = r >> 11, b = (r >> 10) & 1, c = r & 1023; const int tok = idx[(b * NEXP + e) * CAP + c];
        const v4u* sp = (const v4u*)(h2 + (size_t)(b * SEQ + tok) * DM) + lane; v4u* dp = (v4u*)(xs + (size_t)r * DM) + lane;
        dp[0] = sp[0]; }
}

typedef unsigned u32x2_t __attribute__((ext_vector_type(2)));
struct P10Set { float gt[4]; unsigned r[4][4]; u32x2_t x1[4]; unsigned okb, mask; int slotv; };
__device__ __forceinline__ void p10_gather4(float (&gt)[4], unsigned (&r)[4][4], unsigned& okb, unsigned& mask, int slotv, int b, const float* gates, const unsigned char* yrows, int lane, int dflt) {
    int rowi = dflt, gi = dflt; okb = 0u;
#pragma unroll
    for (int q = 0; q < 4; ++q) { const bool ok = mask != 0u; const int e = ok ? __builtin_ctz(mask) : 0; mask = ok ? (mask & (mask - 1u)) : 0u;
        const int sl = __builtin_amdgcn_readlane(slotv, e);
        rowi = ok ? e * 2048 + b * 1024 + sl : rowi; gi = ok ? (b * NEXP + e) * CAP + sl : gi; okb |= ok ? (1u << q) : 0u;
        gt[q] = gates[gi]; const unsigned* yr = (const unsigned*)(yrows + (size_t)rowi * DM) + lane;
#pragma unroll
        for (int j = 0; j < 4; ++j) r[q][j] = __builtin_nontemporal_load(yr + 64 * j); }
}
__device__ __forceinline__ void p10_accum(const float (&gt)[4], const unsigned (&r)[4][4], unsigned okb, float (&y)[16]) {
#pragma unroll
    for (int q = 0; q < 4; ++q) { const float g = ((okb >> q) & 1u) ? gt[q] * (1.f / Y8_SCALE) : 0.f;
#pragma unroll
        for (int j = 0; j < 4; ++j) { const f32x2_t lo = __builtin_amdgcn_cvt_pk_f32_fp8((int)r[q][j], false), hi = __builtin_amdgcn_cvt_pk_f32_fp8((int)r[q][j], true);
            y[4 * j] += g * lo.x; y[4 * j + 1] += g * lo.y; y[4 * j + 2] += g * hi.x; y[4 * j + 3] += g * hi.y; } }
}
struct P10Ctx { const float* gates; const unsigned char* yrows; const bf16* x1; float* out; LAS float* md; LAS int* sl; int gw, NGW, nrows, lane; };
__device__ __forceinline__ void p10_issue_row(const P10Ctx& C, P10Set& S, int k) {
    const int kk = k < C.nrows ? k : C.nrows - 1, m = C.gw + kk * C.NGW, lane = C.lane;
    S.slotv = C.sl[kk * 16 + (lane & 15)]; S.slotv = (lane < 16) ? S.slotv : -1;
    S.mask = (unsigned)(__ballot(S.slotv >= 0) & 0xffffull);
    p10_gather4(S.gt, S.r, S.okb, S.mask, S.slotv, m >> 13, C.gates, C.yrows, lane, m & 32767);
    const u32x2_t* xr = (const u32x2_t*)(C.x1 + (size_t)m * DM) + lane;
#pragma unroll
    for (int j = 0; j < 4; ++j) S.x1[j] = xr[64 * j];
}
__device__ __forceinline__ void p10_finish_row(const P10Ctx& C, P10Set& S, const f32x4 (&gnq)[4], int k) {
    if (k >= C.nrows) return;
    const int m = C.gw + k * C.NGW, b = m >> 13, lane = C.lane;
    float y[16];
#pragma unroll
    for (int i = 0; i < 16; ++i) y[i] = 0.f;
    p10_accum(S.gt, S.r, S.okb, y);
    while (S.mask) { float gt[4]; unsigned r[4][4]; unsigned okb; p10_gather4(gt, r, okb, S.mask, S.slotv, b, C.gates, C.yrows, lane, m & 32767); p10_accum(gt, r, okb, y); }
    float ss = 0.f;
#pragma unroll
    for (int i = 0; i < 16; ++i) ss += y[i] * y[i];
    const float rstd = rsqrtf(wave_sum(ss) * (1.f / DM) + EPS);
    float* orow = C.out + (size_t)m * DM + 4 * lane;
#pragma unroll
    for (int j = 0; j < 4; ++j) { const u32x2_t xq = S.x1[j]; const f32x4 gg = gnq[j], ga = *(const LAS f32x4*)(C.md + b * 1024 + 4 * lane + 256 * j);
        const f32x4 yv = {y[4 * j], y[4 * j + 1], y[4 * j + 2], y[4 * j + 3]}, x1 = {bflo(xq.x), bfhi(xq.x), bflo(xq.y), bfhi(xq.y)};
        __builtin_nontemporal_store(x1 + ga * (yv * rstd * gg), (f32x4*)(orow + 256 * j)); }
}
template <int PM = 0> __device__ __forceinline__ void p9_combine(Frame& F) {
    LAS float* md = (LAS float*)(F.lds + RING_OFF);
    modf_to_lds(F, md, 5120, 1024);
    const int gw = F.vcu * NWAVES + F.wave, NGW = F.G * NWAVES, lane = F.lane;
    if (gw >= NTOK) return;
    const int nrows = (NTOK - gw + NGW - 1) / NGW;
    LAS int* sl = (LAS int*)(F.lds + RING_OFF + 16384) + F.wave * 2048;
    const int* slots = (const int*)(F.ws + WS_SLOTS);
    for (int k0 = 0; k0 < nrows && k0 < 128; k0 += 4) { const int k = k0 + (lane >> 4); if (k < nrows) sl[k * 16 + (lane & 15)] = slots[(size_t)(gw + k * NGW) * NEXP + (lane & 15)]; }
    const float* gn = F.in[IN_NPOSTFFN];
    f32x4 gnq[4];
#pragma unroll
    for (int j = 0; j < 4; ++j) gnq[j] = *(const f32x4*)(gn + 4 * lane + 256 * j);
    asm volatile("s_waitcnt vmcnt(0) lgkmcnt(0)" ::: "memory");
    const P10Ctx C{(const float*)(F.ws + WS_GATES), (const unsigned char*)(F.ws + WS_YROWS), (const bf16*)(F.ws + WS_X1), F.out, md, sl, gw, NGW, nrows < 128 ? nrows : 128, lane};
    P10Set A, B;
    p10_issue_row(C, A, 0); __builtin_amdgcn_sched_barrier(0);
#pragma unroll 1
    for (int k = 0; k < C.nrows; k += 2) {
        p10_issue_row(C, B, k + 1); __builtin_amdgcn_sched_barrier(0);
        p10_finish_row(C, A, gnq, k); __builtin_amdgcn_sched_barrier(0);
        p10_issue_row(C, A, k + 2); __builtin_amdgcn_sched_barrier(0);
        p10_finish_row(C, B, gnq, k + 1); __builtin_amdgcn_sched_barrier(0);
    }
}


__device__ __forceinline__ void ph2_inproj(Frame& F) {
    pg8::Gemm g{(const pg8::bf16_t*)(F.ws + WS_H), (const pg8::bf16_t*)(F.ws + WS_WINT), NTOK, D_IN, DM, nullptr}; pg8::StaticOrder S; S.init(NTOK, D_IN, F.G, (int)blockIdx.x);
    pg8::EpiProj E{(pg8::bf16_t*)(F.ws + WS_Q), (pg8::bf16_t*)(F.ws + WS_K), (pg8::bf16_t*)(F.ws + WS_VT), (pg8::bf16_t*)(F.ws + WS_U), (pg8::bf16_t*)(F.ws + WS_VGT), (float*)(F.ws + WS_VSTAT)};
    pg8::gemm_phase<pg8::EpiProj, pg8::StaticOrder, true, true>(F.lds + RING_OFF, g, S, E);
    { pg8::Unit u2; if (!S.next(1, u2)) {
        const int nlight = 2 * F.G - (NTOK / 256) * (D_IN / 256), first_light = F.G - nlight;
        if (nlight > 0 && (int)blockIdx.x >= first_light) p0_expert_items(F, XI_R0, XI_R1, ((int)blockIdx.x - first_light) * NWAVES + F.wave, nlight * NWAVES);
        else if (nlight <= 0 && blockIdx.x == 0) p0_expert_items(F, XI_R0, XI_R1, F.wave, NWAVES); } }
}
#ifndef PROBE_DUP
#define PROBE_DUP -1
#endif
__device__ __forceinline__ void ph3_mixer(Frame& F) { p3_attn_mfma(F); if (PROBE_DUP == 31) { __syncthreads(); p3_attn_mfma(F); } p3_gmlp_mfma(F); if (PROBE_DUP == 32) p3_gmlp_mfma(F); }
__device__ __forceinline__ void ph4_outproj(Frame& F) {
    pg8::Gemm g{(const pg8::bf16_t*)(F.ws + WS_MIX), (const pg8::bf16_t*)(F.ws + WS_WOUTT), NTOK, DM, DM, nullptr}; pg8::StaticOrder S; S.init(NTOK, DM, F.G, (int)blockIdx.x);
    pg8::EpiDown E{(pg8::bf16_t*)(F.ws + WS_T), 4};
    pg8::gemm_phase<pg8::EpiDown, pg8::StaticOrder, true, true>(F.lds + RING_OFF, g, S, E);
}
__device__ __forceinline__ void ph8_gateup(Frame& F) {
    pg8::Gemm g{(const pg8::bf16_t*)(F.ws + WS_H), (const pg8::bf16_t*)(F.ws + WS_WGUT), NROWS_E, 2 * D_FF, DM / 2, (const int*)(F.ws + WS_IDX)}; pg8::MoeOrder S; S.init(NEXP, 8, 22, F.G, (int)blockIdx.x);
    pg8::EpiSwiGLU8 E{(unsigned char*)(F.ws + WS_HID), 22, W8_INV};
    pg8::Unit u0;
    for (int base = 0; S.next(base, u0); base += 12) { pg8::SubOrder SS{S, base, 12};
        pg8::gemm_phase<pg8::EpiSwiGLU8, pg8::SubOrder, true, true, true, true, PF_DIST, true>(F.lds + RING_OFF, g, SS, E); }
}
__device__ __forceinline__ void ph9_down(Frame& F) {
    pg8::Gemm g{(const pg8::bf16_t*)(F.ws + WS_HID), (const pg8::bf16_t*)(F.ws + WS_WDT), NROWS_E, DM, D_FF / 2, nullptr}; pg8::MoeOrder S; S.init(NEXP, 8, 4, F.G, (int)blockIdx.x);
    pg8::EpiDown8 E{(unsigned char*)(F.ws + WS_YROWS), 4, W8_INV * Y8_SCALE};
    pg8::gemm_phase<pg8::EpiDown8, pg8::MoeOrder, true, true, true, false, PF_DIST, true>(F.lds + RING_OFF, g, S, E);
}
constexpr int NPHASES = 11;
#ifndef MK_N_LAUNCHES
#define MK_N_LAUNCHES 1
#endif
struct Args { const float* in[21]; float* out; unsigned char* ws; int ph_lo, ph_hi, li, pad; };
__global__ void __launch_bounds__(NWAVES * 64, 2) hymba_fwd(Args args) {
    extern __shared__ __attribute__((aligned(16))) unsigned char lds[];
    Frame F;
    F.lds = (LAS unsigned char*)lds;
    F.MISC = (volatile LAS unsigned*)(F.lds + MISC_OFF);
    F.tid = threadIdx.x; F.lane = F.tid & 63; F.wave = __builtin_amdgcn_readfirstlane(F.tid >> 6);
    F.G = gridDim.x; { const int bx = blockIdx.x; F.vcu = (F.G % 8 == 0) ? (bx % 8) * (F.G / 8) + bx / 8 : bx; }
#pragma unroll
    for (int i = 0; i < 21; ++i) F.in[i] = args.in[i];
    F.out = args.out; F.ws = args.ws; F.ctl = (gu32*)(args.ws + WS_CTL);
    for (int u = F.tid; u < (LDS_BYTES - LDSCTL_OFF) / 4; u += NWAVES * 64) ((LAS unsigned*)(F.lds + LDSCTL_OFF))[u] = 0u;
    __syncthreads();
    XcdBarrier bar; bar.bar = (unsigned*)(F.ctl + CW_BAR); bar.x = 0; bar.st = nullptr;
    const bool one_launch = (args.ph_hi - args.ph_lo) > 1;
    if (one_launch) bar = xcd_barrier_post((unsigned*)(F.ctl + CW_BAR), F.MISC + 8);
    const int lo = args.ph_lo, hi = args.ph_hi;
#ifndef PHASE_MASK
#define PHASE_MASK 0x7ff
#endif
#define IN(k) (((PHASE_MASK >> (k)) & 1) && lo <= (k) && (k) < hi)
#define BOTH(k) (IN(k) && IN((k) + 1))
#define GRID_BAR() xcd_barrier(bar)
#ifndef PROBE_DUP
#define PROBE_DUP -1
#endif
#define PHASE(k, call) if (IN(k)) { call; if (PROBE_DUP == (k)) { GRID_BAR(); call; } if (BOTH(k)) GRID_BAR(); }
    if (IN(0)) { p0_prologue(F); if (PROBE_DUP == 0) { GRID_BAR(); p0_prologue(F); } }
    PHASE(1, p1_prenorm(F))
    PHASE(2, ph2_inproj(F))
    PHASE(3, ph3_mixer(F))
    PHASE(4, ph4_outproj(F))
    PHASE(5, p5_postmix(F))
    PHASE(6, p6_topk(F))
    PHASE(8, ph8_gateup(F))
    PHASE(9, ph9_down(F))
    if (IN(10)) { if (PROBE_DUP == 10) { p9_combine<P10_MODE>(F); GRID_BAR(); } p9_combine<0>(F); }
#undef PHASE
#undef IN
#undef BOTH
#undef GRID_BAR
}

extern "C" void kernel_launch(void* const* d_in, const int* in_sizes, int n_in, void* d_out, int out_size, void* d_ws, size_t ws_size, hipStream_t stream) {
    static int grid = 0;
    if (grid == 0) {
        if (n_in != 21 || out_size != NTOK * DM || ws_size < WS_END) { fprintf(stderr, "kernel_launch: unexpected shapes (n_in %d out %d ws %zu)\n", n_in, out_size, ws_size); grid = -1; return; }
        int dev = 0, cus = 0;
        if (hipGetDevice(&dev) != hipSuccess || hipDeviceGetAttribute(&cus, hipDeviceAttributeMultiprocessorCount, dev) != hipSuccess) { grid = -1; return; }
        if (hipFuncSetAttribute((const void*)hymba_fwd, hipFuncAttributeMaxDynamicSharedMemorySize, LDS_BYTES) != hipSuccess) { fprintf(stderr, "kernel_launch: hipFuncSetAttribute failed\n"); grid = -1; return; }
        int per_cu = 0;
        if (hipOccupancyMaxActiveBlocksPerMultiprocessor(&per_cu, (const void*)hymba_fwd, NWAVES * 64, LDS_BYTES) != hipSuccess || per_cu < 1) fprintf(stderr, "kernel_launch: occupancy query reports %d\n", per_cu);
        (void)hipGetLastError();
        grid = cus;
    }
    if (grid < 0) return;
    (void)hipMemsetAsync((char*)d_ws + WS_CTL, 0, CTL_ZERO_BYTES, stream);
    Args a{};
    for (int i = 0; i < 21; ++i) a.in[i] = (const float*)d_in[i];
    a.out = (float*)d_out; a.ws = (unsigned char*)d_ws;
    if (MK_N_LAUNCHES == 1) { a.ph_lo = 0; a.ph_hi = NPHASES; a.li = 0; hipLaunchKernelGGL(hymba_fwd, dim3(grid), dim3(NWAVES * 64), LDS_BYTES, stream, a); }
    else for (int li = 0; li < NPHASES; ++li) { a.ph_lo = li; a.ph_hi = li + 1; a.li = li; hipLaunchKernelGGL(hymba_fwd, dim3(grid), dim3(NWAVES * 64), LDS_BYTES, stream, a); }
}
```

```cpp
#include <hip/hip_runtime.h>
#include <cstdio>
#include <cstdint>
namespace pg8 {
#define PG8_LAS __attribute__((address_space(3)))
typedef unsigned short bf16_t;
typedef short bf16x8 __attribute__((ext_vector_type(8)));
typedef float f32x4 __attribute__((ext_vector_type(4)));
typedef unsigned u32x4 __attribute__((ext_vector_type(4)));
constexpr int BM = 256, BK = 64, HALF = 128, HTB = HALF * BK * 2  , STAGE_BYTES = 8 * HTB, NXCD = 8, WGM = 8;

__host__ __device__ __forceinline__ int lds_byte(int r, int c) { const int st = (r >> 4) * 2 + (c >> 5), rr = r & 15, cc = c & 31, ob = rr * 64 + cc * 2; return st * 1024 + (ob ^ (((ob >> 9) & 1) << 5)); }
__host__ __device__ __forceinline__ void stage_rc(int b, int& R, int& C) { const int st = b / 1024, sb = b % 1024, swz = sb ^ (((sb >> 9) & 1) << 5); R = (st >> 1) * 16 + swz / 64; C = (st & 1) * 32 + (swz % 64) / 2; }
__host__ __device__ __forceinline__ int perm32(int rho) { const int n = rho >> 4, i = rho & 15; return 8 * (i >> 2) + 4 * n + (i & 3); }

struct Unit { int pm, pn; };
struct Gemm { const bf16_t* A; const bf16_t* Bt; int M, N, K; const int* rowmap; };

struct StaticOrder {
    int nM, nN, nwg, G, c;
    __host__ __device__ void init(int M, int N, int G_, int c_) { nM = M / BM; nN = N / BM; nwg = nM * nN; G = G_; c = c_; }
    __host__ __device__ bool next(int i, Unit& u) const {
        const long L = (long)i * G + c; if (L >= nwg) return false;
        int wgid = (int)L; { const int q = nwg / NXCD, r = nwg % NXCD, xcd = wgid % NXCD, off = wgid / NXCD; wgid = (xcd < r ? xcd * (q + 1) : r * (q + 1) + (xcd - r) * q) + off; }
        const int nig = WGM * nN, gid = wgid / nig, fm = gid * WGM, gsz = (nM - fm) < WGM ? (nM - fm) : WGM;
        u.pm = fm + ((wgid % nig) % gsz); u.pn = (wgid % nig) / gsz; return true;
    }
    __device__ __forceinline__ void a_ready(const Unit&) const {}
    __device__ __forceinline__ void done(const Unit&) const {}
};


typedef float f32x2 __attribute__((ext_vector_type(2))); typedef float f32x2_t __attribute__((ext_vector_type(2))); typedef __bf16 bf16x2_t __attribute__((ext_vector_type(2))); typedef int i32x4_t __attribute__((ext_vector_type(4)));
__device__ __forceinline__ unsigned cvtpk(float lo, float hi) { f32x2_t v = {lo, hi}; bf16x2_t b = __builtin_convertvector(v, bf16x2_t); return __builtin_bit_cast(unsigned, b); }
__device__ __forceinline__ bf16_t f2bf1(float f) { return (bf16_t)(cvtpk(f, 0.f) & 0xffffu); }
__device__ __forceinline__ void store8(bf16_t* p, const f32x4 v0, const f32x4 v1) {
    u32x4 w; w.x = cvtpk(v0[0], v0[1]); w.y = cvtpk(v0[2], v0[3]); w.z = cvtpk(v1[0], v1[1]); w.w = cvtpk(v1[2], v1[3]); *(u32x4*)p = w; }
__device__ __forceinline__ float gelu_tanh(float x) {
    const float t = x * __builtin_fmaf(x * x, -0.10294324f, -2.30220823f);
    return x * __builtin_amdgcn_rcpf(1.f + __builtin_amdgcn_exp2f(t));
}
__device__ __forceinline__ float silu_f(float x) { return x / (1.f + __expf(-x)); }

struct MoeOrder {
    int nE, nM, nN, U, G, c;
    __device__ void init(int nE_, int nM_, int nN_, int G_, int c_) { nE = nE_; nM = nM_; nN = nN_; U = nE * nM * nN; G = G_; c = c_; }
    __device__ bool next(int i, Unit& u) const {
        int gl;
        if ((G & 7) == 0 && (U & 7) == 0) { const int x = c & 7, j = c >> 3, per = G >> 3, li = i * per + j, ux = U >> 3; if (li >= ux) return false; gl = x * ux + li; }
        else { const long L = (long)i * G + c; if (L >= U) return false; gl = (int)L; }
        const int per_e = nM * nN, e = gl / per_e, r = gl % per_e;
        u.pm = e * nM + (r % nM); u.pn = e * nN + (r / nM); return true;
    }
    __device__ __forceinline__ void a_ready(const Unit&) const {}
    __device__ __forceinline__ void done(const Unit&) const {}
};

struct SubOrder {
    MoeOrder S; int base, cnt;
    __device__ bool next(int i, Unit& u) const { return i < cnt && S.next(base + i, u); }
    __device__ __forceinline__ void a_ready(const Unit&) const {}
    __device__ __forceinline__ void done(const Unit&) const {}
};

struct EpiProj {
    static constexpr bool PERM = true, AFTER_DRAIN = false;
    bf16_t *q, *k, *vT, *u, *vgT; float* vstat;
    __device__ __forceinline__ void operator()(const f32x4 (&acc)[2][2][4][2], const Unit& un, int wr, int wc, int fr, int fq) const {
        const int row0 = un.pm * BM + wr * 64 + fr, pn = un.pn, cw = wc * 32 + 8 * fq;
        const int b = (un.pm * BM) >> 13;
        if (pn < 2) {
#pragma unroll
            for (int ai = 0; ai < 2; ++ai)
#pragma unroll
                for (int m = 0; m < 4; ++m) { bf16_t* rowp = q + (size_t)(row0 + ai * HALF + m * 16) * 512 + pn * 256 + cw;
#pragma unroll
                    for (int bj = 0; bj < 2; ++bj) store8(rowp + bj * HALF, acc[ai][bj][m][0], acc[ai][bj][m][1]); }
        } else if (pn == 2) {
#pragma unroll
            for (int ai = 0; ai < 2; ++ai)
#pragma unroll
                for (int m = 0; m < 4; ++m) { const int r = row0 + ai * HALF + m * 16, s = r & 8191;
                    store8(k + (size_t)r * 128 + cw, acc[ai][0][m][0], acc[ai][0][m][1]);
#pragma unroll
                    for (int n = 0; n < 2; ++n)
#pragma unroll
                        for (int j = 0; j < 4; ++j) vT[(size_t)(b * 128 + cw + 4 * n + j) * 8192 + s] = f2bf1(acc[ai][1][m][n][j]); }
        } else if (pn < 5) {
#pragma unroll
            for (int ai = 0; ai < 2; ++ai)
#pragma unroll
                for (int m = 0; m < 4; ++m) { bf16_t* rowp = u + (size_t)(row0 + ai * HALF + m * 16) * 512 + (pn - 3) * 256 + cw;
#pragma unroll
                    for (int bj = 0; bj < 2; ++bj) { f32x4 v0 = acc[ai][bj][m][0], v1 = acc[ai][bj][m][1];
#pragma unroll
                        for (int j = 0; j < 4; ++j) { v0[j] = gelu_tanh(v0[j]); v1[j] = gelu_tanh(v1[j]); }
                        store8(rowp + bj * HALF, v0, v1); } }
        } else {
#pragma unroll
            for (int ai = 0; ai < 2; ++ai)
#pragma unroll
                for (int m = 0; m < 4; ++m) { const int r = row0 + ai * HALF + m * 16, s = r & 8191, nch = s >> 7, sl = s & 127, ks = sl >> 4, hi = (sl >> 3) & 1, jj = sl & 7;
                    float ps = 0.f, pq = 0.f;
#pragma unroll
                    for (int bj = 0; bj < 2; ++bj)
#pragma unroll
                        for (int n = 0; n < 2; ++n)
#pragma unroll
                            for (int j = 0; j < 4; ++j) { const int ch = (pn - 5) * 256 + bj * HALF + cw + 4 * n + j, g = ch >> 6, cb = (ch >> 5) & 1, r32 = ch & 31;
                                const bf16_t hb = f2bf1(gelu_tanh(acc[ai][bj][m][n][j])); const float hv = __uint_as_float((unsigned)hb << 16); ps += hv; pq += hv * hv;
                                vgT[((((size_t)(b * 64 + nch) * 8 + g) * 2 + cb) * 8 + ks) * 512 + (hi * 32 + r32) * 8 + jj] = hb; }
                    ps += __shfl_xor(ps, 16); ps += __shfl_xor(ps, 32); pq += __shfl_xor(pq, 16); pq += __shfl_xor(pq, 32);
                    if (fq == 0) { f32x2 st2 = {ps, pq}; *(f32x2*)(vstat + ((size_t)((pn - 5) * 4 + wc) * 16384 + r) * 2) = st2; } }
        }
    }
};

struct EpiF32 {
    static constexpr bool PERM = false, AFTER_DRAIN = false;
    float* C; int ldc;
    __device__ __forceinline__ void operator()(const f32x4 (&acc)[2][2][4][2], const Unit& u, int wr, int wc, int fr, int fq) const {
        const int row0 = u.pm * BM + wr * 64 + fr, col0 = u.pn * BM + wc * 32 + 4 * fq;
#pragma unroll
        for (int ai = 0; ai < 2; ++ai)
#pragma unroll
            for (int m = 0; m < 4; ++m) { float* rowp = C + (size_t)(row0 + ai * HALF + m * 16) * ldc + col0;
#pragma unroll
                for (int bj = 0; bj < 2; ++bj)
#pragma unroll
                    for (int n = 0; n < 2; ++n) *(f32x4*)(rowp + bj * HALF + n * 16) = acc[ai][bj][m][n]; }
    }
};

struct EpiSwiGLU {
    static constexpr bool PERM = true, AFTER_DRAIN = false;
    bf16_t* hid; int nN;
    __device__ __forceinline__ void operator()(const f32x4 (&acc)[2][2][4][2], const Unit& un, int wr, int wc, int fr, int fq) const {
        const int row0 = un.pm * BM + wr * 64 + fr, pnl = un.pn % nN, col0 = pnl * HALF + wc * 32 + 8 * fq;
#pragma unroll
        for (int ai = 0; ai < 2; ++ai)
#pragma unroll
            for (int m = 0; m < 4; ++m) { bf16_t* rowp = hid + (size_t)(row0 + ai * HALF + m * 16) * 2816 + col0;
                f32x4 v0, v1;
#pragma unroll
                for (int j = 0; j < 4; ++j) { v0[j] = silu_f(acc[ai][0][m][0][j]) * acc[ai][1][m][0][j]; v1[j] = silu_f(acc[ai][0][m][1][j]) * acc[ai][1][m][1][j]; }
                store8(rowp, v0, v1); }
    }
};

struct EpiDown {
    static constexpr bool PERM = true, AFTER_DRAIN = false;
    bf16_t* y; int nN;
    __device__ __forceinline__ void operator()(const f32x4 (&acc)[2][2][4][2], const Unit& un, int wr, int wc, int fr, int fq) const {
        const int row0 = un.pm * BM + wr * 64 + fr, pnl = un.pn % nN, col0 = pnl * BM + wc * 32 + 8 * fq;
#pragma unroll
        for (int ai = 0; ai < 2; ++ai)
#pragma unroll
            for (int m = 0; m < 4; ++m) { bf16_t* rowp = y + (size_t)(row0 + ai * HALF + m * 16) * 1024 + col0;
#pragma unroll
                for (int bj = 0; bj < 2; ++bj) store8(rowp + bj * HALF, acc[ai][bj][m][0], acc[ai][bj][m][1]); }
    }
};

__device__ __forceinline__ unsigned pk4_fp8(float a, float b, float c, float d) { int w = __builtin_amdgcn_cvt_pk_fp8_f32(a, b, 0, false); w = __builtin_amdgcn_cvt_pk_fp8_f32(c, d, w, true); return (unsigned)w; }
__device__ __forceinline__ float clamp448(float x) { return __builtin_fminf(__builtin_fmaxf(x, -448.f), 448.f); }
struct EpiSwiGLU8 {
    static constexpr bool PERM = true, AFTER_DRAIN = false;
    unsigned char* hid; int nN; float inv_scale;
    __device__ __forceinline__ void operator()(const f32x4 (&acc)[2][2][4][2], const Unit& un, int wr, int wc, int fr, int fq) const {
        const int row0 = un.pm * BM + wr * 64 + fr, pnl = un.pn % nN, col0 = pnl * HALF + wc * 32 + 8 * fq;
        const float c1 = -inv_scale * 1.4426950408889634f, s2 = inv_scale * inv_scale;
#pragma unroll
        for (int ai = 0; ai < 2; ++ai)
#pragma unroll
            for (int m = 0; m < 4; ++m) { unsigned char* rowp = hid + (size_t)(row0 + ai * HALF + m * 16) * 2816 + col0;
                float v[8];
#pragma unroll
                for (int n = 0; n < 2; ++n)
#pragma unroll
                    for (int j = 0; j < 4; j += 2) { const f32x2 g = {acc[ai][0][m][n][j], acc[ai][0][m][n][j + 1]}, u = {acc[ai][1][m][n][j], acc[ai][1][m][n][j + 1]};
                        const f32x2 p = (g * u) * s2, x = g * c1; f32x2 d; d.x = __builtin_amdgcn_exp2f(x.x); d.y = __builtin_amdgcn_exp2f(x.y); d = d + 1.0f;
                        f32x2 r; r.x = __builtin_amdgcn_rcpf(d.x); r.y = __builtin_amdgcn_rcpf(d.y); const f32x2 o = p * r;
                        v[4 * n + j] = __builtin_amdgcn_fmed3f(o.x, -448.f, 448.f); v[4 * n + j + 1] = __builtin_amdgcn_fmed3f(o.y, -448.f, 448.f); }
                uint2 w; w.x = pk4_fp8(v[0], v[1], v[2], v[3]); w.y = pk4_fp8(v[4], v[5], v[6], v[7]); *(uint2*)rowp = w; }
    }
};
struct EpiDown8 {
    static constexpr bool PERM = true, AFTER_DRAIN = false;
    unsigned char* y; int nN; float inv_scale;
    __device__ __forceinline__ void operator()(const f32x4 (&acc)[2][2][4][2], const Unit& un, int wr, int wc, int fr, int fq) const {
        const int row0 = un.pm * BM + wr * 64 + fr, pnl = un.pn % nN, col0 = pnl * BM + wc * 32 + 8 * fq;
#pragma unroll
        for (int ai = 0; ai < 2; ++ai)
#pragma unroll
            for (int m = 0; m < 4; ++m) { unsigned char* rowp = y + (size_t)(row0 + ai * HALF + m * 16) * 1024 + col0;
#pragma unroll
                for (int bj = 0; bj < 2; ++bj) { const f32x4 v0 = acc[ai][bj][m][0] * inv_scale, v1 = acc[ai][bj][m][1] * inv_scale;
                    uint2 w; w.x = pk4_fp8(__builtin_amdgcn_fmed3f(v0[0], -448.f, 448.f), __builtin_amdgcn_fmed3f(v0[1], -448.f, 448.f), __builtin_amdgcn_fmed3f(v0[2], -448.f, 448.f), __builtin_amdgcn_fmed3f(v0[3], -448.f, 448.f));
                    w.y = pk4_fp8(__builtin_amdgcn_fmed3f(v1[0], -448.f, 448.f), __builtin_amdgcn_fmed3f(v1[1], -448.f, 448.f), __builtin_amdgcn_fmed3f(v1[2], -448.f, 448.f), __builtin_amdgcn_fmed3f(v1[3], -448.f, 448.f));
                    *(uint2*)(rowp + bj * HALF) = w; } }
    }
};
typedef int i32x8_t __attribute__((ext_vector_type(8)));
template <bool FP8> struct OperandT { typedef bf16x8 type; };
template <> struct OperandT<true> { typedef i32x8_t type; };
__device__ __forceinline__ void ld_bf16(bf16x8& d, const PG8_LAS unsigned char* p) { d = *(const PG8_LAS bf16x8*)p; }
__device__ __forceinline__ void ld_bf16(i32x8_t&, const PG8_LAS unsigned char*) {}
__device__ __forceinline__ void ld_fp8(i32x8_t& d, const PG8_LAS unsigned char* p) { const i32x4_t lo = *(const PG8_LAS i32x4_t*)p, hi = *(const PG8_LAS i32x4_t*)(p + 1024); d = __builtin_shufflevector(lo, hi, 0, 1, 2, 3, 4, 5, 6, 7); }
__device__ __forceinline__ void ld_fp8(bf16x8&, const PG8_LAS unsigned char*) {}
__device__ __forceinline__ f32x4 mma_bf16(const bf16x8& a, const bf16x8& b, const f32x4& c) { return __builtin_amdgcn_mfma_f32_16x16x32_bf16(a, b, c, 0, 0, 0); }
__device__ __forceinline__ f32x4 mma_bf16(const i32x8_t&, const i32x8_t&, const f32x4& c) { return c; }
__device__ __forceinline__ f32x4 mma_fp8(const i32x8_t& a, const i32x8_t& b, const f32x4& c) { f32x4 d = c; const int sc = 0x7f7f7f7f;
    asm volatile("v_mfma_scale_f32_16x16x128_f8f6f4 %0, %1, %2, %0, %3, %3 op_sel_hi:[0,0,0]" : "+v"(d) : "v"(a), "v"(b), "v"(sc)); return d; }
__device__ __forceinline__ f32x4 mma_fp8(const bf16x8&, const bf16x8&, const f32x4& c) { return c; }
template <class Epi, class Sched, bool ALIGN_EPI = false, bool SP2 = false, bool FP8 = false, bool GATHER = false, int PF = 0, bool BTM = false>
__device__ __forceinline__ void gemm_phase(PG8_LAS unsigned char* lds, const Gemm g, const Sched& S, const Epi& E) {
    const int tid = threadIdx.x, wid = __builtin_amdgcn_readfirstlane(tid >> 6), lane = tid & 63, wr = wid >> 2, wc = wid & 3, fr = lane & 15, fq = lane >> 4;
    const int K = g.K, nt = K / BK;
    unsigned voffA[2], voffB[2];
#pragma unroll
    for (int i = 0; i < 2; ++i) { int R, C; stage_rc(tid * 16 + i * 8192, R, C); const int Rb = Epi::PERM ? ((R & ~31) + perm32(R & 31)) : R;
        voffA[i] = (unsigned)(R * K + C) * 2u; voffB[i] = BTM ? (unsigned)(Rb * BK + C) * 2u : (unsigned)(Rb * K + C) * 2u; }
    const size_t kstep = (size_t)(BK * 2);
    const size_t hstep = (size_t)HALF * K * 2;
    const size_t kstepB = BTM ? (size_t)BM * BK * 2 : kstep, hstepB = BTM ? (size_t)HALF * BK * 2 : hstep;
    const size_t tstep = 2 * hstep;
    const unsigned ldsw = (unsigned)wid * 1024u;
    const int aoff = lds_byte(wr * 64 + fr, fq * 8), boff = lds_byte(wc * 32 + fr, fq * 8);
#define PG8_SA(b, h) (((b) * 2 + (h)) * HTB)
#define PG8_SB(b, h) ((4 + (b) * 2 + (h)) * HTB)
#define PG8_STAGE(bufoff, gbase, voff) do { _Pragma("unroll") for (int _i = 0; _i < 2; ++_i) \
        __builtin_amdgcn_global_load_lds((const unsigned*)((const char*)(gbase) + (voff)[_i]), (PG8_LAS unsigned*)(lds + (bufoff) + ldsw + _i * 8192), 16, 0, 0); } while (0)
#define PG8_STAGE_A(bufoff, gbase, h, usenext) do { if constexpr (GATHER) { _Pragma("unroll") for (int _i = 0; _i < 2; ++_i) \
        __builtin_amdgcn_global_load_lds((const unsigned*)((const char*)(gbase) + ((usenext) ? vgn[h][_i] : vgc[h][_i])), (PG8_LAS unsigned*)(lds + (bufoff) + ldsw + _i * 8192), 16, 0, 0); } \
    else { PG8_STAGE(bufoff, (gbase) + ((h) ? hstep : 0), voffA); } } while (0)
#define PG8_LD2(base) PG8_CAT(*(const PG8_LAS i32x4_t*)(base), *(const PG8_LAS i32x4_t*)((base) + 1024))
#define PG8_LDA(dst, b, h) do { _Pragma("unroll") for (int m = 0; m < 4; ++m) { if constexpr (FP8) { ld_fp8(dst[m][0], lds + PG8_SA(b, h) + aoff + m * 2048); } else { _Pragma("unroll") for (int k = 0; k < (FP8 ? 1 : 2); ++k) ld_bf16(dst[m][k], lds + PG8_SA(b, h) + aoff + m * 2048 + k * 1024); } } } while (0)
#define PG8_LDB(dst, b, h) do { _Pragma("unroll") for (int n = 0; n < 2; ++n) { if constexpr (FP8) { ld_fp8(dst[n][0], lds + PG8_SB(b, h) + boff + n * 2048); } else { _Pragma("unroll") for (int k = 0; k < (FP8 ? 1 : 2); ++k) ld_bf16(dst[n][k], lds + PG8_SB(b, h) + boff + n * 2048 + k * 1024); } } } while (0)
#define PG8_MMA(ai, bj, At, Bt) do { __builtin_amdgcn_s_setprio(1); _Pragma("unroll") for (int m = 0; m < 4; ++m) _Pragma("unroll") for (int n = 0; n < 2; ++n) { \
        if constexpr (FP8) { acc[ai][bj][m][n] = mma_fp8(Bt[n][0], At[m][0], acc[ai][bj][m][n]); } \
        else { _Pragma("unroll") for (int k = 0; k < (FP8 ? 1 : 2); ++k) acc[ai][bj][m][n] = mma_bf16(Bt[n][k], At[m][k], acc[ai][bj][m][n]); } } __builtin_amdgcn_s_setprio(0); } while (0)
#define PG8_WAIT_V(n) asm volatile("s_waitcnt vmcnt(" #n ")" ::: "memory")
#define PG8_WAIT_L(n) asm volatile("s_waitcnt lgkmcnt(" #n ")" ::: "memory")
#define PG8_BAR __builtin_amdgcn_s_barrier()
#define PG8_SCHED __builtin_amdgcn_sched_barrier(0)
    Unit cur, nxt; int ui = 0;
    if (!S.next(0, cur)) return;
    f32x4 acc[2][2][4][2];
#pragma unroll
    for (int a = 0; a < 2; ++a)
#pragma unroll
        for (int b = 0; b < 2; ++b)
#pragma unroll
            for (int m = 0; m < 4; ++m)
#pragma unroll
                for (int n = 0; n < 2; ++n) acc[a][b][m][n] = (f32x4){0.f, 0.f, 0.f, 0.f};
    typename OperandT<FP8>::type At[4][FP8 ? 1 : 2], B0[2][FP8 ? 1 : 2], B1[2][FP8 ? 1 : 2];
    const char* cA = GATHER ? (const char*)g.A : (const char*)g.A + (size_t)cur.pm * tstep; const char* cB = (const char*)g.Bt + (size_t)cur.pn * tstep;
    unsigned vgc[2][2], vgn[2][2]; int stR[2], stC[2];
#pragma unroll
    for (int i = 0; i < 2; ++i) { stage_rc(tid * 16 + i * 8192, stR[i], stC[i]); }
    constexpr int RM_MAXU = 12; PG8_LAS int* rml = (PG8_LAS int*)(lds + STAGE_BYTES);
    if constexpr (GATHER) { Unit uu;
        for (int i = 0; i < RM_MAXU && S.next(i, uu); ++i) { if (tid < BM) rml[i * BM + tid] = g.rowmap[uu.pm * BM + tid]; }
        asm volatile("s_waitcnt vmcnt(0) lgkmcnt(0)" ::: "memory"); __builtin_amdgcn_s_barrier(); asm volatile("" ::: "memory"); }
#define PG8_GOFF(dst, uidx, pmv) do { _Pragma("unroll") for (int _h = 0; _h < 2; ++_h) _Pragma("unroll") for (int _i = 0; _i < 2; ++_i) { \
        const int _r = _h * HALF + stR[_i]; const int _row = !GATHER ? 0 : rml[(uidx) * BM + _r]; \
        dst[_h][_i] = ((unsigned)_row * (unsigned)K + (unsigned)stC[_i]) * 2u; } } while (0)
    PG8_GOFF(vgc, 0, cur.pm);
    static_assert(PF == 0 || SP2, "the L2 prefetch is wired into the super-phase loop only");
    const size_t rowb = (size_t)K * 2;
#define PG8_PFBASE(un, uidx) ((tid < BM) ? (GATHER ? (unsigned)rml[(GATHER ? (uidx) : 0) * BM + (tid & (BM - 1))] * (unsigned)rowb : ((unsigned)(un).pm * BM + tid) * (unsigned)rowb) \
                                         : ((unsigned)(un).pn * BM + (tid - BM)) * (unsigned)rowb)
    unsigned pfc = PF ? PG8_PFBASE(cur, 0) : 0u; unsigned pfn = pfc;
#define PG8_PREFETCH(tt) do { if constexpr (PF > 0) { const int _tt = (tt); const bool _in = _tt < nt; const char* _b = (tid < BM) ? (const char*)g.A : (const char*)g.Bt; \
        const char* _p = (_in || !has_next) ? _b + pfc + (size_t)(_in ? _tt : 0) * kstep : _b + pfn + (size_t)(_tt - nt) * kstep; \
        __builtin_amdgcn_global_load_lds((const unsigned*)_p, (PG8_LAS unsigned*)(lds + STAGE_BYTES + 12032), 4, 0, 0); } } while (0)
#define PG8_WAIT_VL() do { if constexpr (PF > 0) PG8_WAIT_V(9); else PG8_WAIT_V(8); } while (0)
#pragma unroll
    for (int h_ = 0; h_ < 2; ++h_) { vgn[h_][0] = vgc[h_][0]; vgn[h_][1] = vgc[h_][1]; }
    S.a_ready(cur);
    if constexpr (SP2) {
        PG8_STAGE(PG8_SB(0, 0), cB, voffB); PG8_STAGE(PG8_SB(0, 1), cB + hstepB, voffB); PG8_STAGE_A(PG8_SA(0, 0), cA, 0, false); PG8_STAGE_A(PG8_SA(0, 1), cA, 1, false);
        if (wr == 1) PG8_BAR;
        PG8_WAIT_V(2); PG8_BAR;
        PG8_STAGE(PG8_SB(1, 0), cB + kstepB, voffB); PG8_STAGE_A(PG8_SA(1, 0), cA + kstep, 0, false); PG8_STAGE(PG8_SB(1, 1), cB + hstepB + kstepB, voffB);
        PG8_WAIT_V(6); PG8_BAR;
    } else {
        PG8_STAGE(PG8_SB(0, 0), cB, voffB); PG8_STAGE_A(PG8_SA(0, 0), cA, 0, false); PG8_STAGE(PG8_SB(0, 1), cB + hstepB, voffB); PG8_STAGE_A(PG8_SA(0, 1), cA, 1, false);
        if (wr == 1) PG8_BAR;
        PG8_WAIT_V(4); PG8_BAR;
        PG8_STAGE(PG8_SB(1, 0), cB + kstepB, voffB); PG8_STAGE_A(PG8_SA(1, 0), cA + kstep, 0, false); PG8_STAGE(PG8_SB(1, 1), cB + hstepB + kstepB, voffB);
        PG8_WAIT_V(6); PG8_BAR;
    }
    for (;;) {
        const bool has_next = S.next(ui + 1, nxt);
        if constexpr (GATHER) { if (has_next) PG8_GOFF(vgn, ui + 1, nxt.pm); }
        if constexpr (PF > 0) { if (has_next) pfn = PG8_PFBASE(nxt, ui + 1); }
        const char* nA = (has_next && !GATHER) ? (const char*)g.A + (size_t)nxt.pm * tstep : cA; const char* nB = has_next ? (const char*)g.Bt + (size_t)nxt.pn * tstep : cB;
#pragma unroll 1
        for (int t = 0; t < nt; t += 2) {
            const bool last = (t == nt - 2);
            const char* a1 = cA + (size_t)(t + 1) * kstep;
            const char* a2 = last ? nA : cA + (size_t)(t + 2) * kstep; const char* b2 = last ? nB : cB + (size_t)(t + 2) * kstepB;
            const char* a3 = a2 + kstep; const char* b3 = b2 + kstepB;
            if (last && has_next) S.a_ready(nxt);
            if constexpr (SP2) {
            PG8_LDB(B0, 0, 0); PG8_LDB(B1, 0, 1); PG8_SCHED; PG8_LDA(At, 0, 0); PG8_STAGE_A(PG8_SA(1, 1), a1, 1, false); PG8_PREFETCH(t + PF);
            PG8_WAIT_VL(); PG8_WAIT_L(0); PG8_BAR; PG8_MMA(0, 0, At, B0); PG8_MMA(0, 1, At, B1); PG8_BAR; PG8_SCHED;
            PG8_LDA(At, 0, 1); PG8_STAGE(PG8_SB(0, 0), b2, voffB); PG8_STAGE(PG8_SB(0, 1), b2 + hstepB, voffB); PG8_STAGE_A(PG8_SA(0, 0), a2, 0, last);
            PG8_WAIT_VL(); PG8_WAIT_L(0); PG8_BAR; PG8_MMA(1, 0, At, B0); PG8_MMA(1, 1, At, B1); PG8_BAR; PG8_SCHED;
            PG8_LDB(B0, 1, 0); PG8_LDB(B1, 1, 1); PG8_SCHED; PG8_LDA(At, 1, 0); PG8_STAGE_A(PG8_SA(0, 1), a2, 1, last); PG8_PREFETCH(t + 1 + PF);
            PG8_WAIT_VL(); PG8_WAIT_L(0); PG8_BAR; PG8_MMA(0, 0, At, B0); PG8_MMA(0, 1, At, B1); PG8_BAR; PG8_SCHED;
            PG8_LDA(At, 1, 1); PG8_STAGE(PG8_SB(1, 0), b3, voffB); PG8_STAGE(PG8_SB(1, 1), b3 + hstepB, voffB); PG8_STAGE_A(PG8_SA(1, 0), a3, 0, last);
            PG8_WAIT_VL(); PG8_WAIT_L(0); PG8_BAR; PG8_MMA(1, 0, At, B0); PG8_MMA(1, 1, At, B1); PG8_BAR; PG8_SCHED;
            } else {
            PG8_LDB(B0, 0, 0); PG8_SCHED; PG8_LDA(At, 0, 0); PG8_STAGE_A(PG8_SA(1, 1), a1, 1, false);
            PG8_WAIT_L(8); PG8_BAR; PG8_WAIT_L(0); PG8_MMA(0, 0, At, B0); PG8_BAR; PG8_SCHED;
            PG8_LDB(B1, 0, 1); PG8_STAGE(PG8_SB(0, 0), b2, voffB);
            PG8_BAR; PG8_WAIT_L(0); PG8_MMA(0, 1, At, B1); PG8_BAR;
            PG8_LDA(At, 0, 1); PG8_STAGE_A(PG8_SA(0, 0), a2, 0, last);
            PG8_BAR; PG8_WAIT_L(0); PG8_MMA(1, 0, At, B0); PG8_BAR; PG8_SCHED;
            PG8_STAGE(PG8_SB(0, 1), b2 + hstepB, voffB);
            PG8_WAIT_V(6); PG8_BAR; PG8_MMA(1, 1, At, B1); PG8_BAR;
            PG8_LDB(B0, 1, 0); PG8_SCHED; PG8_LDA(At, 1, 0); PG8_STAGE_A(PG8_SA(0, 1), a2, 1, last);
            PG8_WAIT_L(8); PG8_BAR; PG8_WAIT_L(0); PG8_MMA(0, 0, At, B0); PG8_BAR; PG8_SCHED;
            PG8_LDB(B1, 1, 1); PG8_STAGE(PG8_SB(1, 0), b3, voffB);
            PG8_BAR; PG8_WAIT_L(0); PG8_MMA(0, 1, At, B1); PG8_BAR;
            PG8_LDA(At, 1, 1); PG8_STAGE_A(PG8_SA(1, 0), a3, 0, last);
            PG8_BAR; PG8_WAIT_L(0); PG8_MMA(1, 0, At, B0); PG8_BAR; PG8_SCHED;
            PG8_STAGE(PG8_SB(1, 1), b3 + hstepB, voffB);
            PG8_WAIT_V(6); PG8_BAR; PG8_MMA(1, 1, At, B1); PG8_BAR;
            }
        }
        if constexpr (FP8) { asm volatile("s_nop 15\n\ts_nop 15" ::: "memory"); }
        if constexpr (ALIGN_EPI) { if (wr == 0) PG8_BAR; }
        if constexpr (!Epi::AFTER_DRAIN) { E(acc, cur, wr, wc, fr, fq); S.done(cur); }
        if (!has_next) break;
#pragma unroll
        for (int a = 0; a < 2; ++a)
#pragma unroll
            for (int b = 0; b < 2; ++b)
#pragma unroll
                for (int m = 0; m < 4; ++m)
#pragma unroll
                    for (int n = 0; n < 2; ++n) acc[a][b][m][n] = (f32x4){0.f, 0.f, 0.f, 0.f};
        cur = nxt; cA = nA; cB = nB; ++ui; pfc = pfn;
        if constexpr (GATHER) {
#pragma unroll
            for (int h_ = 0; h_ < 2; ++h_) { vgc[h_][0] = vgn[h_][0]; vgc[h_][1] = vgn[h_][1]; } }
        if constexpr (ALIGN_EPI) { if (wr == 1) PG8_BAR; }
    }
    PG8_WAIT_V(0);
    if constexpr (!ALIGN_EPI) { if (wr == 0) PG8_BAR; }
    PG8_BAR;
    if constexpr (Epi::AFTER_DRAIN) { E.fused(acc, cur, wr, wc, fr, fq, lds, wid, lane); S.done(cur); }
#undef PG8_SA
#undef PG8_SB
#undef PG8_STAGE
#undef PG8_STAGE_A
#undef PG8_GOFF
#undef PG8_PFBASE
#undef PG8_PREFETCH
#undef PG8_WAIT_VL
#undef PG8_LDA
#undef PG8_LDB
#undef PG8_MMA
#undef PG8_LD2
#undef PG8_WAIT_V
#undef PG8_WAIT_L
#undef PG8_BAR
#undef PG8_SCHED
}
}
#define GAS __attribute__((address_space(1)))
#define LAS __attribute__((address_space(3)))
typedef unsigned short bf16;
typedef unsigned v4u __attribute__((ext_vector_type(4)));
typedef float f32x4 __attribute__((ext_vector_type(4)));
typedef short bf16x8 __attribute__((ext_vector_type(8)));
typedef GAS unsigned gu32;
typedef GAS unsigned long long gu64;
#define RLX_AGENT __ATOMIC_RELAXED, __HIP_MEMORY_SCOPE_AGENT
#define LDS_WAIT() asm volatile("s_waitcnt lgkmcnt(0)" ::: "memory")
#define VM_WAIT() asm volatile("s_waitcnt vmcnt(0)" ::: "memory")
__device__ __forceinline__ unsigned long long rt() { return __builtin_amdgcn_s_memrealtime(); }
__device__ __forceinline__ unsigned f2bf(float f) { unsigned u = __builtin_bit_cast(unsigned, f); return (u + 0x7fffu + ((u >> 16) & 1u)) >> 16; }
__device__ __forceinline__ unsigned pk2(float lo, float hi) { return f2bf(lo) | (f2bf(hi) << 16); }

#define XB_TMO      128
#define XB_XCNT(j)  (256  + 64 * (j))
#define XB_XSUB(j)  (1280 + 64 * (j))
#define XB_XGEN(j)  (2304 + 64 * (j))
#define XB_TOP      3328
#define XB_TOPGEN   3392
#define XCD_BAR_WORDS 3456
#define XB_SPIN_CAP (1u << 18)

__device__ __forceinline__ unsigned xb_ld(unsigned* p)              { return __hip_atomic_load(p, __ATOMIC_RELAXED, __HIP_MEMORY_SCOPE_AGENT); }
__device__ __forceinline__ unsigned xb_add(unsigned* p, unsigned v) { return __hip_atomic_fetch_add(p, v, __ATOMIC_RELAXED, __HIP_MEMORY_SCOPE_AGENT); }
__device__ __forceinline__ unsigned xb_xcc_id() { return (unsigned)__builtin_amdgcn_s_getreg((3 << 11) | 20) & 0xFu; }
#define XB_SPIN(cond, bar) do { unsigned _sp = 0; while (cond) { __builtin_amdgcn_s_sleep(1); \
    if ((++_sp & 255u) == 0u) { if (xb_ld(&(bar)[XB_TMO])) break; if (_sp > XB_SPIN_CAP) { atomicAdd(&(bar)[XB_TMO], 1u); break; } } } } while (0)

struct XcdBarrier {
    unsigned* bar; unsigned x;
    volatile LAS unsigned* st;
};

__device__ __forceinline__ XcdBarrier xcd_barrier_post(unsigned* bar, volatile LAS unsigned* st) {
    XcdBarrier b; b.bar = bar; b.x = xb_xcc_id(); b.st = st;
    if (threadIdx.x == 0) (void)xb_add(&bar[XB_XCNT(b.x)], 1u);
    return b;
}
__device__ __forceinline__ void xcd_barrier_complete(unsigned* bar, unsigned x, unsigned& nloc, unsigned& nx) {
    const unsigned G = gridDim.x * gridDim.y * gridDim.z;
    unsigned sum, cnt, mine, sp = 0u;
    for (;;) {
        sum = 0u; cnt = 0u; mine = 0u;
#pragma unroll
        for (unsigned j = 0; j < 16; ++j) { const unsigned c = xb_ld(&bar[XB_XCNT(j)]); sum += c; cnt += (c > 0u) ? 1u : 0u; mine = (j == x) ? c : mine; }
        if (sum == G) break;
        __builtin_amdgcn_s_sleep(1);
        if ((++sp & 255u) == 0u) { if (xb_ld(&bar[XB_TMO])) break; if (sp > XB_SPIN_CAP) { atomicAdd(&bar[XB_TMO], 1u); break; } }
    }
    nloc = mine > 0u ? mine : 1u; nx = cnt > 0u ? cnt : 1u;
}

__device__ __forceinline__ void xcd_barrier(const XcdBarrier& b) {
    asm volatile("s_waitcnt vmcnt(0)" ::: "memory");
    __syncthreads();
    if (threadIdx.x == 0) {
        unsigned* bar = b.bar;
        __builtin_amdgcn_s_waitcnt(0);
        unsigned nloc = b.st[0], nx = b.st[1];
        if (nloc == 0u) { xcd_barrier_complete(bar, b.x, nloc, nx); b.st[0] = nloc; b.st[1] = nx; }
        const unsigned old = xb_add(&bar[XB_XSUB(b.x)], 1u);
        const unsigned gen = old / nloc;
        if (old + 1u == (gen + 1u) * nloc) {
            __builtin_amdgcn_fence(__ATOMIC_RELEASE, "agent");
            asm volatile("s_waitcnt vmcnt(0)" ::: "memory");
            const unsigned og = xb_add(&bar[XB_TOP], 1u);
            const unsigned tg = og / nx;
            if (og + 1u == (tg + 1u) * nx) xb_add(&bar[XB_TOPGEN], 1u);
            else XB_SPIN(xb_ld(&bar[XB_TOPGEN]) == tg, bar);
            __builtin_amdgcn_fence(__ATOMIC_ACQUIRE, "agent");
            xb_add(&bar[XB_XGEN(b.x)], 1u);
            asm volatile("s_waitcnt vmcnt(0)" ::: "memory");
        } else {
            XB_SPIN(xb_ld(&bar[XB_XGEN(b.x)]) == gen, bar);
            __builtin_amdgcn_fence(__ATOMIC_ACQUIRE, "agent");
            asm volatile("s_waitcnt vmcnt(0)" ::: "memory");
        }
    }
    __syncthreads();
}

constexpr int NWAVES = 8;
constexpr int BATCH = 2, SEQ = 8192, DM = 1024, NTOK = BATCH * SEQ;
constexpr int D_IN = 1792, D_FF = 2816, NEXP = 16, CAP = 1024;
constexpr int NROWS_E = NEXP * BATCH * CAP;
constexpr float EPS = 1e-6f;
constexpr int KS_ADA = 16;
#ifndef PF_DIST
#define PF_DIST 0
#ifndef P10_MODE
#define P10_MODE 0
#endif
#endif
constexpr float Y8_SCALE = 16.f;
constexpr float W8_SCALE = 64.f, W8_INV = 1.f / 64.f;

constexpr size_t MiB = 1u << 20;
constexpr size_t WS_CTL = 0, CTL_ZERO_BYTES = 32768;
constexpr size_t WS_MODP = 1 * MiB;
constexpr size_t WS_AFF = 2 * MiB;
constexpr size_t WS_SLOTS = 3 * MiB;
constexpr size_t WS_IDX = 4 * MiB;
constexpr size_t WS_GATES = 4 * MiB + 128 * 1024;
constexpr size_t WS_WSB = 4 * MiB + 256 * 1024;
constexpr size_t WS_VSTAT = 11 * MiB;
constexpr size_t WS_WINT = 5 * MiB;
constexpr size_t WS_WOUTT = 9 * MiB;
constexpr size_t WS_WGUT = 12 * MiB;
constexpr size_t WS_WDT = 188 * MiB;
constexpr size_t WS_H = 276 * MiB;
constexpr size_t WS_YROWS = 308 * MiB;
constexpr size_t WS_HID = 372 * MiB;
constexpr size_t WS_Q = 372 * MiB;
constexpr size_t WS_K = 388 * MiB;
constexpr size_t WS_VT = 392 * MiB;
constexpr size_t WS_U = 396 * MiB;
constexpr size_t WS_VGT = 412 * MiB;
constexpr size_t WS_MIX = 428 * MiB;
constexpr size_t WS_T = 460 * MiB;
constexpr size_t WS_XS = 548 * MiB;
constexpr size_t WS_X1 = 612 * MiB;
constexpr size_t WS_END = 676 * MiB;
constexpr int CW_BAR = 4096;
constexpr int CW_P0CNT = 128;

constexpr int RING_OFF = 0, RING_BYTES = 131072;
constexpr int LDSCTL_OFF = 143360, MISC_OFF = LDSCTL_OFF + 320;
constexpr int LDS_BYTES = 147456;

struct Frame {
    LAS unsigned char* lds;
    volatile LAS unsigned* MISC;
    gu32* ctl;
    int tid, lane, wave;
    int vcu, G;
    const float* in[21];
    float* out;
    unsigned char* ws;
};
#define IN_X 0
#define IN_C 1
#define IN_WADA 2
#define IN_BADA 3
#define IN_NPREMIX 4
#define IN_NPOSTMIX 5
#define IN_WIN 6
#define IN_SINK 7
#define IN_LNG 8
#define IN_LNB 9
#define IN_WS 10
#define IN_BS 11
#define IN_NOATTN 12
#define IN_NOGMLP 13
#define IN_WOUT 14
#define IN_NPREFFN 15
#define IN_NPOSTFFN 16
#define IN_WROUTER 17
#define IN_WGATE 18
#define IN_WUP 19
#define IN_WDOWN 20

#define DPP_ADDF(v, ctrl, rmask) (v) += __builtin_bit_cast(float, __builtin_amdgcn_update_dpp(0, __builtin_bit_cast(int, (v)), (ctrl), (rmask), 0xf, true))
__device__ __forceinline__ float wave_sum(float v) {
    DPP_ADDF(v, 0xB1, 0xf); DPP_ADDF(v, 0x4E, 0xf); DPP_ADDF(v, 0x141, 0xf); DPP_ADDF(v, 0x140, 0xf); DPP_ADDF(v, 0x142, 0xa); DPP_ADDF(v, 0x143, 0xc);
    return __builtin_bit_cast(float, __builtin_amdgcn_readlane(__builtin_bit_cast(int, v), 63));
}
#define DPP_MAXF(v, ctrl, rmask) (v) = fmaxf((v), __builtin_bit_cast(float, __builtin_amdgcn_update_dpp(__builtin_bit_cast(int, (v)), __builtin_bit_cast(int, (v)), (ctrl), (rmask), 0xf, false)))
__device__ __forceinline__ float wave_max(float v) {
    DPP_MAXF(v, 0xB1, 0xf); DPP_MAXF(v, 0x4E, 0xf); DPP_MAXF(v, 0x141, 0xf); DPP_MAXF(v, 0x140, 0xf); DPP_MAXF(v, 0x142, 0xa); DPP_MAXF(v, 0x143, 0xc);
    return __builtin_bit_cast(float, __builtin_amdgcn_readlane(__builtin_bit_cast(int, v), 63));
}
__device__ __forceinline__ float bf2f(unsigned short b) { return __uint_as_float((unsigned)b << 16); }
__device__ __forceinline__ float bflo(unsigned u) { return __uint_as_float(u << 16); }
__device__ __forceinline__ float bfhi(unsigned u) { return __uint_as_float(u & 0xffff0000u); }

__device__ __forceinline__ void transpose_item(const float* W, int N, int k0, int n0, bf16* WT, int ldt, int dest_row0, LAS float* scr, int lane) {
#pragma unroll 8
    for (int i = 0; i < 32; ++i) { const int kk = 2 * i + (lane >> 5); scr[kk * 33 + (lane & 31)] = W[(size_t)(k0 + kk) * N + n0 + (lane & 31)]; }
    LDS_WAIT(); asm volatile("" ::: "memory");
    const int c = lane & 7;
#pragma unroll
    for (int j = 0; j < 4; ++j) { const int n = (lane >> 3) + 8 * j; const LAS float* s = scr + (8 * c) * 33 + n;
        v4u o; o.x = pk2(s[0 * 33], s[1 * 33]); o.y = pk2(s[2 * 33], s[3 * 33]); o.z = pk2(s[4 * 33], s[5 * 33]); o.w = pk2(s[6 * 33], s[7 * 33]);
        *(GAS v4u*)(WT + (size_t)(dest_row0 + n) * ldt + k0 + 8 * c) = o; }
    LDS_WAIT(); asm volatile("" ::: "memory");
}

constexpr int XI_PER_MAT = (DM / 128) * (D_FF / 32);
constexpr int XI_TOTAL = NEXP * 3 * XI_PER_MAT;
struct XItem { const float* src; unsigned char* dst; int N, ldt; };
__device__ __forceinline__ XItem xitem_decode(Frame& F, int it) {
    const int e = it / (3 * XI_PER_MAT), r = it % (3 * XI_PER_MAT), ty = r / XI_PER_MAT, r3 = r % XI_PER_MAT; XItem d;
    if (ty < 2) { const int kb = r3 / (D_FF / 32), n0 = 32 * (r3 % (D_FF / 32)), k0 = 128 * kb;
        d.N = D_FF; d.ldt = DM; d.src = (ty ? F.in[IN_WUP] : F.in[IN_WGATE]) + (size_t)e * DM * D_FF + (size_t)k0 * D_FF + n0;
        d.ldt = 128; d.dst = (unsigned char*)(F.ws + WS_WGUT) + (size_t)e * (2 * D_FF) * DM + ((size_t)((n0 >> 7) * (DM / 128) + kb) * 256 + ty * 128 + (n0 & 127)) * 128; }
    else { const int kb = r3 / (DM / 32), n0 = 32 * (r3 % (DM / 32)), k0 = 128 * kb;
        d.N = DM; d.ldt = D_FF; d.src = F.in[IN_WDOWN] + (size_t)e * D_FF * DM + (size_t)k0 * DM + n0;
        d.ldt = 128; d.dst = (unsigned char*)(F.ws + WS_WDT) + (size_t)e * DM * D_FF + ((size_t)((n0 >> 8) * (D_FF / 128) + kb) * 256 + (n0 & 255)) * 128; }
    return d;
}
__device__ __forceinline__ void xitem_load(const XItem& d, f32x4 (&r)[16], int lane) {
    const float* p = d.src + (size_t)(lane >> 3) * d.N + 4 * (lane & 7);
#pragma unroll
    for (int i = 0; i < 16; ++i) r[i] = __builtin_nontemporal_load((const f32x4*)(p + (size_t)(8 * i) * d.N));
}
__device__ __forceinline__ void xitem_finish(const XItem& d, const f32x4 (&r)[16], LAS float* scr, int lane) {
    LAS float* w = scr + (lane >> 3) * 33 + 4 * (lane & 7);
#pragma unroll
    for (int i = 0; i < 16; ++i) { const f32x4 v = r[i] * W8_SCALE; w[i * 264] = v.x; w[i * 264 + 1] = v.y; w[i * 264 + 2] = v.z; w[i * 264 + 3] = v.w; }
    LDS_WAIT(); asm volatile("" ::: "memory");
    const int c = lane & 7;
#pragma unroll
    for (int j = 0; j < 4; ++j) { const int n = (lane >> 3) + 8 * j; const LAS float* s = scr + (16 * c) * 33 + n;
        v4u o;
        o.x = pg8::pk4_fp8(s[0 * 33], s[1 * 33], s[2 * 33], s[3 * 33]);
        o.y = pg8::pk4_fp8(s[4 * 33], s[5 * 33], s[6 * 33], s[7 * 33]);
        o.z = pg8::pk4_fp8(s[8 * 33], s[9 * 33], s[10 * 33], s[11 * 33]);
        o.w = pg8::pk4_fp8(s[12 * 33], s[13 * 33], s[14 * 33], s[15 * 33]);
        __builtin_nontemporal_store(o, (v4u*)(d.dst + (size_t)n * d.ldt + 16 * c)); }
    LDS_WAIT(); asm volatile("" ::: "memory");
}
constexpr int XI_R0 = 24576, XI_R1 = 27648, P6_CONV = 192;
__device__ __forceinline__ void p0_expert_items(Frame& F, int first, int end, int widx, int nworkers) {
    LAS float* scr = (LAS float*)(F.lds + F.wave * 16896);
    const int lane = F.lane;
    const int it0 = first + widx; if (it0 >= end) return;
    const int n = (end - it0 + nworkers - 1) / nworkers;
    f32x4 rA[16], rB[16]; XItem dA = xitem_decode(F, it0), dB; xitem_load(dA, rA, lane);
    int j = 1;
#pragma unroll 1
    for (; j + 1 < n; j += 2) {
        dB = xitem_decode(F, it0 + j * nworkers); xitem_load(dB, rB, lane); __builtin_amdgcn_sched_barrier(0);
        xitem_finish(dA, rA, scr, lane); __builtin_amdgcn_sched_barrier(0);
        dA = xitem_decode(F, it0 + (j + 1) * nworkers); xitem_load(dA, rA, lane); __builtin_amdgcn_sched_barrier(0);
        xitem_finish(dB, rB, scr, lane); __builtin_amdgcn_sched_barrier(0);
    }
    if (j < n) { dB = xitem_decode(F, it0 + j * nworkers); xitem_load(dB, rB, lane); xitem_finish(dA, rA, scr, lane); xitem_finish(dB, rB, scr, lane); }
    else xitem_finish(dA, rA, scr, lane);
}

__device__ __forceinline__ void p0_prologue(Frame& F) {
    LAS float* scr = (LAS float*)(F.lds + F.wave * 16896);
    const int gw = F.vcu * NWAVES + F.wave, NGW = F.G * NWAVES, lane = F.lane;
    {
        const float* c = F.in[IN_C]; const float* W = F.in[IN_WADA]; float* modp = (float*)(F.ws + WS_MODP);
        constexpr int KPS = DM / KS_ADA;
        for (int it = gw; it < 96 * KS_ADA; it += NGW) {
            const int cg = it % 96, ks = it / 96, col = cg * 64 + lane;
            float a0 = 0.f, a1 = 0.f;
#pragma unroll 16
            for (int kk = 0; kk < KPS; ++kk) { const int k = ks * KPS + kk; const float w = W[(size_t)k * 6144 + col];
                const float c0 = c[k], c1 = c[DM + k];
                a0 += (c0 / (1.f + __expf(-c0))) * w; a1 += (c1 / (1.f + __expf(-c1))) * w; }
            __hip_atomic_store(modp + (size_t)(ks * 2 + 0) * 6144 + col, a0, __ATOMIC_RELAXED, __HIP_MEMORY_SCOPE_AGENT);
            __hip_atomic_store(modp + (size_t)(ks * 2 + 1) * 6144 + col, a1, __ATOMIC_RELAXED, __HIP_MEMORY_SCOPE_AGENT);
        }
        asm volatile("s_waitcnt vmcnt(0)" ::: "memory");
        if (lane == 0) __hip_atomic_fetch_add((unsigned*)(F.ctl + CW_P0CNT), 1u, __ATOMIC_RELAXED, __HIP_MEMORY_SCOPE_AGENT);
    }
    {
        const float* wsf = F.in[IN_WS]; bf16* wsb = (bf16*)(F.ws + WS_WSB);
        for (int o = gw * 64 + lane; o < 8 * 8 * 4 * 64; o += NGW * 64) { const int ln = o & 63, tb = (o >> 6) & 3, ks = (o >> 8) & 7, g = o >> 11, r32 = ln & 31, hi = ln >> 5;
            const float* src = wsf + (size_t)(g * 128 + 32 * tb + r32) * 128 + 16 * ks + 8 * hi; const f32x4 v0 = *(const f32x4*)src, v1 = *(const f32x4*)(src + 4);
            v4u pk; pk.x = pk2(v0.x, v0.y); pk.y = pk2(v0.z, v0.w); pk.z = pk2(v1.x, v1.y); pk.w = pk2(v1.z, v1.w); *(v4u*)(wsb + (size_t)o * 8) = pk; }
    }
    constexpr int I_IN = (DM / 64) * (D_IN / 32), I_OUT = (DM / 64) * (DM / 32);
    for (int it = gw; it < I_IN + I_OUT; it += NGW) {
        int r = it;
        if (r < I_IN) { const int nb = D_IN / 32, kb = r / nb, n0 = 32 * (r % nb); transpose_item(F.in[IN_WIN], D_IN, 64 * kb, n0, (bf16*)(F.ws + WS_WINT), DM, n0, scr, lane); continue; } r -= I_IN;
        { const int nb = DM / 32, kb = r / nb, n0 = 32 * (r % nb); transpose_item(F.in[IN_WOUT], DM, 64 * kb, n0, (bf16*)(F.ws + WS_WOUTT), DM, n0, scr, lane); }
    }
    p0_expert_items(F, 0, XI_R0, gw, NGW);
}
__device__ __forceinline__ void p0_wait_published(Frame& F) {
    if (F.wave == 0) { const unsigned want = (unsigned)(F.G * NWAVES); unsigned sp = 0;
        while ((unsigned)__builtin_amdgcn_readfirstlane((int)__hip_atomic_load((unsigned*)(F.ctl + CW_P0CNT), __ATOMIC_RELAXED, __HIP_MEMORY_SCOPE_AGENT)) < want) { __builtin_amdgcn_s_sleep(2); if (++sp > (1u << 22)) break; }
        __builtin_amdgcn_fence(__ATOMIC_ACQUIRE, "agent"); asm volatile("s_waitcnt vmcnt(0)" ::: "memory"); }
    __syncthreads();
}

__device__ __forceinline__ void mod_to_lds(Frame& F, LAS float* dst, int col0, int ncols) {
    const float* modp = (const float*)(F.ws + WS_MODP); const float* bada = F.in[IN_BADA];
#pragma unroll 4
    for (int i = F.tid; i < 2 * ncols; i += NWAVES * 64) { const int b = i / ncols, j = i % ncols; float s = bada[col0 + j];
#pragma unroll
        for (int ks = 0; ks < KS_ADA; ++ks) s += modp[(size_t)(ks * 2 + b) * 6144 + col0 + j];
        dst[i] = s; }
    __syncthreads();
}
constexpr size_t WS_MODF = WS_MODP + (size_t)KS_ADA * 2 * 6144 * 4;
__device__ __forceinline__ void modf_write(Frame& F) {
    const float* modp = (const float*)(F.ws + WS_MODP); const float* bada = F.in[IN_BADA]; float* modf = (float*)(F.ws + WS_MODF);
    const int i = (int)blockIdx.x * NWAVES * 64 + F.tid;
    if (i < 2 * 4096) { const int b = i >> 12, col = 2048 + (i & 4095); float s = bada[col];
#pragma unroll
        for (int ks = 0; ks < KS_ADA; ++ks) s += modp[(size_t)(ks * 2 + b) * 6144 + col];
        modf[b * 6144 + col] = s; }
}
__device__ __forceinline__ void modf_to_lds(Frame& F, LAS float* dst, int col0, int ncols) {
    const float* modf = (const float*)(F.ws + WS_MODF);
#pragma unroll 4
    for (int i = F.tid; i < 2 * ncols; i += NWAVES * 64) { const int b = i / ncols, j = i % ncols; dst[i] = modf[b * 6144 + col0 + j]; }
    __syncthreads();
}

__device__ __forceinline__ void p1_prenorm(Frame& F) {
    LAS float* md = (LAS float*)(F.lds + RING_OFF);
    p0_wait_published(F);
    modf_write(F);
    mod_to_lds(F, md, 0, 2048);
    const int gw = F.vcu * NWAVES + F.wave, NGW = F.G * NWAVES, lane = F.lane;
    const float* x = F.in[IN_X]; const float* g = F.in[IN_NPREMIX]; bf16* h = (bf16*)(F.ws + WS_H);
    f32x4 gq[4];
#pragma unroll
    for (int j = 0; j < 4; ++j) gq[j] = *(const f32x4*)(g + 4 * lane + 256 * j);
    f32x4 vn[4];
    if (gw < NTOK) { const f32x4* xr = (const f32x4*)(x + (size_t)gw * DM) + lane;
#pragma unroll
        for (int j = 0; j < 4; ++j) vn[j] = xr[64 * j]; }
    for (int m = gw; m < NTOK; m += NGW) {
        const int b = m >> 13;
        f32x4 v[4]; float ss = 0.f;
#pragma unroll
        for (int j = 0; j < 4; ++j) { v[j] = vn[j]; ss += (v[j].x * v[j].x + v[j].y * v[j].y) + (v[j].z * v[j].z + v[j].w * v[j].w); }
        const float rstd = rsqrtf(wave_sum(ss) * (1.f / DM) + EPS);
        unsigned long long* o8 = (unsigned long long*)(h + (size_t)m * DM) + lane;
#pragma unroll
        for (int j = 0; j < 4; ++j) { const int col = 4 * lane + 256 * j; const f32x4 gg = gq[j];
            const f32x4 sh = *(const LAS f32x4*)(md + b * 2048 + col), sc = *(const LAS f32x4*)(md + b * 2048 + 1024 + col);
            const f32x4 r = (v[j] * rstd * gg) * (sc + 1.f) + sh;
            o8[64 * j] = (unsigned long long)pk2(r.x, r.y) | ((unsigned long long)pk2(r.z, r.w) << 32); }
        if (m + NGW < NTOK) { const f32x4* xr = (const f32x4*)(x + (size_t)(m + NGW) * DM) + lane;
#pragma unroll
            for (int j = 0; j < 4; ++j) vn[j] = xr[64 * j]; }
    }
    __syncthreads();
}

typedef float f32x16 __attribute__((ext_vector_type(16)));
typedef short s16x4 __attribute__((ext_vector_type(4)));
typedef float f32x2_t __attribute__((ext_vector_type(2))); typedef __bf16 bf16x2_t __attribute__((ext_vector_type(2)));
__device__ __forceinline__ unsigned cvtpk(float lo, float hi) { f32x2_t v = {lo, hi}; bf16x2_t bb = __builtin_convertvector(v, bf16x2_t); return __builtin_bit_cast(unsigned, bb); }
__device__ __forceinline__ int crow(int i, int hi) { return (i & 3) + 8 * (i >> 2) + 4 * hi; }
#define MFMA32(a, b, c) __builtin_amdgcn_mfma_f32_32x32x16_bf16((a), (b), (c), 0, 0, 0)
constexpr int AT_KB = 24576, AT_VB = 25600, AT_BUF = AT_KB + AT_VB, AT_SQ = 2 * AT_BUF;
struct AtStage { v4u k[3], v[3]; };
__device__ __forceinline__ void at_load(AtStage& st, const bf16* k, const bf16* vT, int b, int q0, int c, int tid) {
#pragma unroll
    for (int i = 0; i < 3; ++i) { const int kb = q0 - 128 + 32 * (3 * c + i), kbc = kb < 0 ? 0 : (kb > SEQ - 32 ? SEQ - 32 : kb);
        st.k[i] = *(const v4u*)(k + (size_t)(b * SEQ + kbc + (tid >> 4)) * 128 + (tid & 15) * 8);
        st.v[i] = *(const v4u*)(vT + (size_t)(b * 128 + (tid >> 2)) * SEQ + kbc + (tid & 3) * 8); }
}
__device__ __forceinline__ void at_store(const AtStage& st, LAS unsigned char* buf, int tid) {
#pragma unroll
    for (int i = 0; i < 3; ++i) { const int key = 32 * i + (tid >> 4), ch16 = tid & 15, kvh = ch16 >> 3, ch = ch16 & 7;
        *(LAS v4u*)(buf + kvh * 12288 + key * 128 + ((ch ^ (key & 7)) << 4)) = st.k[i];
        const int row = tid >> 2, pc = tid & 3; LAS unsigned char* vp = buf + AT_KB + (row >> 6) * 12800 + (row & 63) * 200 + (32 * i + 8 * pc) * 2;
        typedef unsigned u32x2_t __attribute__((ext_vector_type(2)));
        *(LAS u32x2_t*)vp = (u32x2_t){st.v[i].x, st.v[i].y}; *(LAS u32x2_t*)(vp + 8) = (u32x2_t){st.v[i].z, st.v[i].w}; }
}
#define AT_TILE(KT, TL, MODE) do { const int kb_ = q0 - 128 + 32 * (KT); if (kb_ >= 0 && kb_ < SEQ) { \
    const int key_ = 32 * (TL) + r32; bf16x8 kf_[4]; \
    _Pragma("unroll") for (int ks = 0; ks < 4; ++ks) kf_[ks] = *(const LAS bf16x8*)(kimg + key_ * 128 + (((2 * ks + hi) ^ (key_ & 7)) << 4)); \
    bf16x8 va_[2][2]; \
    _Pragma("unroll") for (int db = 0; db < 2; ++db) _Pragma("unroll") for (int sx = 0; sx < 2; ++sx) { const LAS unsigned char* vp_ = vimg + (32 * db + r32) * 200 + (32 * (TL) + 16 * sx + 4 * hi) * 2; \
        const s16x4 lo_ = *(const LAS s16x4*)vp_, hv_ = *(const LAS s16x4*)(vp_ + 16); va_[db][sx] = __builtin_shufflevector(lo_, hv_, 0, 1, 2, 3, 4, 5, 6, 7); } \
    f32x16 st_; _Pragma("unroll") for (int i = 0; i < 16; ++i) st_[i] = 0.f; \
    _Pragma("unroll") for (int ks = 0; ks < 4; ++ks) st_ = MFMA32(kf_[ks], *(const LAS bf16x8*)(ot + ks * 1024 + lane * 16), st_); \
    float bt_ = 0.f; \
    if (MODE == 1) { bt_ = Bp - sl2 * (float)(128 - 32 * (KT)); _Pragma("unroll") for (int i = 0; i < 16; ++i) st_[i] = __builtin_fmaf(st_[i], c0, Kc[i]); } \
    else if (MODE == 2) { bt_ = -Bp - sl2 * (float)(32 * (KT) - 128); _Pragma("unroll") for (int i = 0; i < 16; ++i) st_[i] = __builtin_fmaf(st_[i], c0, -Kc[i]); } \
    else if (MODE == 3) { bt_ = Bp - sl2 * 128.f;              \
        _Pragma("unroll") for (int i = 0; i < 16; ++i) st_[i] = ((i & 3) + 8 * (i >> 2) + 4 * hi >= r32) ? __builtin_fmaf(st_[i], c0, Kc[i]) : -1e30f; } \
    else if (MODE == 4) { bt_ = -Bp - sl2 * 128.f;             \
        _Pragma("unroll") for (int i = 0; i < 16; ++i) st_[i] = ((i & 3) + 8 * (i >> 2) + 4 * hi <= r32) ? __builtin_fmaf(st_[i], c0, -Kc[i]) : -1e30f; } \
    else {                                                     \
        _Pragma("unroll") for (int i = 0; i < 16; ++i) st_[i] = __builtin_fmaf(-sl2, __builtin_fabsf(rh - (float)((i & 3) + 8 * (i >> 2))), st_[i] * c0); } \
    float ta_ = fmaxf(fmaxf(st_[0], st_[1]), st_[2]), tb_ = fmaxf(fmaxf(st_[3], st_[4]), st_[5]); \
    ta_ = fmaxf(fmaxf(ta_, st_[6]), st_[7]); tb_ = fmaxf(fmaxf(tb_, st_[8]), st_[9]); ta_ = fmaxf(fmaxf(ta_, st_[10]), st_[11]); tb_ = fmaxf(fmaxf(tb_, st_[12]), st_[13]); \
    float tmax_ = fmaxf(fmaxf(ta_, tb_), fmaxf(st_[14], st_[15])) + bt_; tmax_ = fmaxf(tmax_, __shfl_xor(tmax_, 32)); \
    if (__any(tmax_ > m_run)) { const float mn_ = fmaxf(m_run, tmax_), al_ = __builtin_amdgcn_exp2f(m_run - mn_); m_run = mn_; l_run *= al_; \
        _Pragma("unroll") for (int i = 0; i < 16; ++i) { o0[i] *= al_; o1[i] *= al_; } } \
    const float dl_ = bt_ - m_run; float ps_ = 0.f; \
    _Pragma("unroll") for (int i = 0; i < 16; ++i) { const float p_ = __builtin_amdgcn_exp2f(st_[i] + dl_); st_[i] = p_; ps_ += p_; } \
    ps_ += __shfl_xor(ps_, 32); l_run += ps_; \
    v4u p0_, p1_; \
    p0_.x = cvtpk(st_[0], st_[1]); p0_.y = cvtpk(st_[2], st_[3]); p0_.z = cvtpk(st_[4], st_[5]); p0_.w = cvtpk(st_[6], st_[7]); \
    p1_.x = cvtpk(st_[8], st_[9]); p1_.y = cvtpk(st_[10], st_[11]); p1_.z = cvtpk(st_[12], st_[13]); p1_.w = cvtpk(st_[14], st_[15]); \
    const bf16x8 pb0_ = __builtin_bit_cast(bf16x8, p0_), pb1_ = __builtin_bit_cast(bf16x8, p1_); \
    o0 = MFMA32(va_[0][0], pb0_, o0); o0 = MFMA32(va_[0][1], pb1_, o0); o1 = MFMA32(va_[1][0], pb0_, o1); o1 = MFMA32(va_[1][1], pb1_, o1); } } while (0)
#define AT_CHUNK(C, NC, NU, M0, M1, M2) do { LAS unsigned char* buf = ring + par * AT_BUF; par ^= 1; at_store(st, buf, tid); __syncthreads(); \
    if ((NU) < uend) at_load(st, k, vT, ((NU) * 32) >> 13, ((NU) * 32) & 8191, (NC), tid); \
    const LAS unsigned char* kimg = buf + kvh * 12288; const LAS unsigned char* vimg = buf + AT_KB + kvh * 12800; \
    AT_TILE(3 * (C) + 0, 0, M0); __builtin_amdgcn_sched_barrier(0); AT_TILE(3 * (C) + 1, 1, M1); __builtin_amdgcn_sched_barrier(0); AT_TILE(3 * (C) + 2, 2, M2); } while (0)
__device__ __forceinline__ void p3_attn_mfma(Frame& F) {
    const int tid = F.tid, lane = F.lane, r32 = lane & 31, hi = lane >> 5, hh = F.wave, kvh = hh >> 2;
    LAS unsigned char* ring = F.lds + RING_OFF; LAS float* SQ = (LAS float*)(ring + AT_SQ);
    const bf16* q = (const bf16*)(F.ws + WS_Q); const bf16* k = (const bf16*)(F.ws + WS_K); const bf16* vT = (const bf16*)(F.ws + WS_VT);
    bf16* mix = (bf16*)(F.ws + WS_MIX); const float* gn = F.in[IN_NOATTN];
    constexpr float LOG2E = 1.4426950408889634f;
    const float slope = exp2f(-(float)(hh + 1)), sl2 = slope * LOG2E, c0 = 0.125f * LOG2E, sink2 = F.in[IN_SINK][hh] * LOG2E;
    const float rh = (float)(r32 - 4 * hi), Bp = -sl2 * rh;
    float Kc[16];
#pragma unroll
    for (int i = 0; i < 16; ++i) Kc[i] = sl2 * (float)((i & 3) + 8 * (i >> 2));
    LAS unsigned char* ot = ring + AT_SQ + 1024 + hh * 4096;
    const int nunits = NTOK / 32; const bool bal = (F.G == 256); const int ustep = bal ? 128 : F.G, uend = bal ? (F.vcu < 128 ? F.vcu + 1 : nunits) : nunits;
    int unit = F.vcu; if (unit >= uend) return;
    AtStage st; at_load(st, k, vT, (unit * 32) >> 13, (unit * 32) & 8191, 1, tid);
    int par = 0;
    for (; unit < uend; unit += ustep) {
        const int tok0 = unit * 32, b = tok0 >> 13, q0 = tok0 & 8191, qpos = q0 + r32;
#pragma unroll
        for (int ks = 0; ks < 4; ++ks) *(LAS bf16x8*)(ot + ks * 1024 + lane * 16) = *(const bf16x8*)(q + (size_t)(tok0 + r32) * 512 + hh * 64 + 16 * ks + 8 * hi);
        f32x16 o0, o1;
#pragma unroll
        for (int i = 0; i < 16; ++i) { o0[i] = 0.f; o1[i] = 0.f; }
        float m_run = sink2, l_run = 1.f;
        AT_CHUNK(1, 0, unit, 1, 0, 2);
        AT_CHUNK(0, 2, unit, 3, 1, 1);
        AT_CHUNK(2, 1, unit + ustep, 2, 2, 4);
        (void)b;
        const float inv = 1.f / l_run; float sq = 0.f;
#pragma unroll
        for (int i = 0; i < 16; ++i) { o0[i] *= inv; o1[i] *= inv; sq += o0[i] * o0[i] + o1[i] * o1[i]; }
        sq += __shfl_xor(sq, 32);
        if (hi == 0) SQ[hh * 32 + r32] = sq;
        __syncthreads();
        float tot = 0.f;
#pragma unroll
        for (int w8 = 0; w8 < 8; ++w8) tot += SQ[w8 * 32 + r32];
        const float rstd = rsqrtf(tot * (1.f / 512.f) + EPS);
#pragma unroll
        for (int g4 = 0; g4 < 4; ++g4) { const int d0 = 8 * g4 + 4 * hi; const f32x4 ga = *(const GAS f32x4*)(gn + hh * 64 + d0), gb = *(const GAS f32x4*)(gn + hh * 64 + 32 + d0);
            *(LAS unsigned long long*)(ot + r32 * 128 + ((g4 ^ (r32 & 7)) << 4) + 8 * hi) = (unsigned long long)cvtpk(o0[4 * g4] * rstd * ga.x, o0[4 * g4 + 1] * rstd * ga.y) | ((unsigned long long)cvtpk(o0[4 * g4 + 2] * rstd * ga.z, o0[4 * g4 + 3] * rstd * ga.w) << 32);
            *(LAS unsigned long long*)(ot + r32 * 128 + (((4 + g4) ^ (r32 & 7)) << 4) + 8 * hi) = (unsigned long long)cvtpk(o1[4 * g4] * rstd * gb.x, o1[4 * g4 + 1] * rstd * gb.y) | ((unsigned long long)cvtpk(o1[4 * g4 + 2] * rstd * gb.z, o1[4 * g4 + 3] * rstd * gb.w) << 32); }
#pragma unroll
        for (int i = 0; i < 4; ++i) { const int qq = 8 * i + (lane >> 3); const v4u v = *(const LAS v4u*)(ot + qq * 128 + (((lane & 7) ^ (qq & 7)) << 4));
            *(v4u*)(mix + (size_t)(tok0 + qq) * DM + hh * 64 + (lane & 7) * 8) = v; }
        __syncthreads();
    }
}
#undef AT_TILE
#undef AT_CHUNK

__device__ __forceinline__ void p3_gmlp_mfma(Frame& F) {
    __syncthreads();
    const int lane = F.lane, r32 = lane & 31, hi = lane >> 5, w = F.wave, ch0 = w * 64;
    LAS float* L = (LAS float*)(F.lds + RING_OFF + 131072);
    LAS float* MU = L; LAS float* RS = L + 128; LAS float* SQ = L + 256;
    LAS unsigned char* wt = F.lds + RING_OFF + w * 16384;
    const bf16* vgT = (const bf16*)(F.ws + WS_VGT); const bf16* u = (const bf16*)(F.ws + WS_U); bf16* mix = (bf16*)(F.ws + WS_MIX); const bf16* wsb = (const bf16*)(F.ws + WS_WSB);
    const float* bs = F.in[IN_BS]; const float* lng = F.in[IN_LNG]; const float* lnb = F.in[IN_LNB]; const float* gn = F.in[IN_NOGMLP];
    for (int unit = F.vcu; unit < BATCH * (SEQ / 128); unit += F.G) {
        const int b = unit >> 6, s0 = (unit & 63) * 128;
#pragma unroll
        for (int hb = 0; hb < 2; ++hb) { v4u ur[8];
#pragma unroll
          for (int i = 0; i < 8; ++i) ur[i] = *(const v4u*)(u + ((size_t)b * SEQ + s0 + 8 * (8 * hb + i) + (lane >> 3)) * 512 + ch0 + (lane & 7) * 8);
#pragma unroll
          for (int i = 0; i < 8; ++i) { const int t = 8 * (8 * hb + i) + (lane >> 3); *(LAS v4u*)(wt + t * 128 + (((lane & 7) ^ (t & 7)) << 4)) = ur[i]; }
          asm volatile("s_waitcnt lgkmcnt(0)" ::: "memory"); }
        if (F.tid < 128) { const float* vs = (const float*)(F.ws + WS_VSTAT) + ((size_t)b * SEQ + s0 + F.tid) * 2; float s1 = 0.f, s2 = 0.f;
#pragma unroll
            for (int p = 0; p < 8; ++p) { const f32x2_t t2 = *(const f32x2_t*)(vs + (size_t)p * NTOK * 2); s1 += t2.x; s2 += t2.y; }
            const float mean = s1 * (1.f / 512.f); float var = s2 * (1.f / 512.f) - mean * mean; var = var < 0.f ? 0.f : var;
            MU[F.tid] = mean; RS[F.tid] = rsqrtf(var + EPS); }
        __syncthreads();
        f32x16 z[2][4];
#pragma unroll
        for (int cb = 0; cb < 2; ++cb)
#pragma unroll
            for (int tb = 0; tb < 4; ++tb)
#pragma unroll
                for (int i = 0; i < 16; ++i) z[cb][tb][i] = 0.f;
        const float lg0 = lng[ch0 + r32], lb0 = lnb[ch0 + r32], lg1 = lng[ch0 + 32 + r32], lb1 = lnb[ch0 + 32 + r32];
#pragma unroll 2
        for (int ks = 0; ks < 8; ++ks) {
            const int sb = 16 * ks + 8 * hi;
            const f32x4 mua = *(const LAS f32x4*)(MU + sb), mub = *(const LAS f32x4*)(MU + sb + 4), rsa = *(const LAS f32x4*)(RS + sb), rsb = *(const LAS f32x4*)(RS + sb + 4);
            bf16x8 af[2];
#pragma unroll
            for (int cb = 0; cb < 2; ++cb) { const float lg = cb ? lg1 : lg0, lb = cb ? lb1 : lb0;
                const v4u raw = *(const v4u*)(vgT + ((((size_t)(b * 64 + (unit & 63)) * 8 + w) * 2 + cb) * 8 + ks) * 512 + lane * 8);
                v4u pk;
                pk.x = cvtpk((bflo(raw.x) - mua.x) * rsa.x * lg + lb, (bfhi(raw.x) - mua.y) * rsa.y * lg + lb);
                pk.y = cvtpk((bflo(raw.y) - mua.z) * rsa.z * lg + lb, (bfhi(raw.y) - mua.w) * rsa.w * lg + lb);
                pk.z = cvtpk((bflo(raw.z) - mub.x) * rsb.x * lg + lb, (bfhi(raw.z) - mub.y) * rsb.y * lg + lb);
                pk.w = cvtpk((bflo(raw.w) - mub.z) * rsb.z * lg + lb, (bfhi(raw.w) - mub.w) * rsb.w * lg + lb);
                af[cb] = __builtin_bit_cast(bf16x8, pk); }
#pragma unroll
            for (int tb = 0; tb < 4; ++tb) { const bf16x8 bfr = *(const bf16x8*)(wsb + ((size_t)((w * 8 + ks) * 4 + tb) * 64 + lane) * 8);
                z[0][tb] = MFMA32(af[0], bfr, z[0][tb]); z[1][tb] = MFMA32(af[1], bfr, z[1][tb]); }
        }
        int lq = lane; asm volatile("" : "+v"(lq)); const int r32e = lq & 31, hie = lq >> 5, l8 = lq & 7, l3 = lq >> 3;
        const float* bsl = bs; const float* gnl = gn; asm volatile("" : "+s"(bsl), "+s"(gnl));
#pragma unroll
        for (int tb = 0; tb < 4; ++tb) { const int t = 32 * tb + r32e; const float bsv = *(const GAS float*)(bsl + w * 128 + t); float sq = 0.f;
#pragma unroll
            for (int cb = 0; cb < 2; ++cb)
#pragma unroll
                for (int g4 = 0; g4 < 4; ++g4) { typedef unsigned u32x2_t __attribute__((ext_vector_type(2))); const u32x2_t ur = *(const LAS u32x2_t*)(wt + t * 128 + (((4 * cb + g4) ^ (t & 7)) << 4) + 8 * hie);
                    const float g0 = bflo(ur.x) * (z[cb][tb][4 * g4] + bsv), g1 = bfhi(ur.x) * (z[cb][tb][4 * g4 + 1] + bsv), g2 = bflo(ur.y) * (z[cb][tb][4 * g4 + 2] + bsv), g3 = bfhi(ur.y) * (z[cb][tb][4 * g4 + 3] + bsv);
                    z[cb][tb][4 * g4] = g0; z[cb][tb][4 * g4 + 1] = g1; z[cb][tb][4 * g4 + 2] = g2; z[cb][tb][4 * g4 + 3] = g3; sq += (g0 * g0 + g1 * g1) + (g2 * g2 + g3 * g3); }
            sq += __shfl_xor(sq, 32);
            if (hie == 0) SQ[w * 128 + t] = sq; asm volatile("" ::: "memory"); }
        __syncthreads();
#pragma unroll
        for (int tb = 0; tb < 4; ++tb) { const int t = 32 * tb + r32e; float tot = 0.f;
#pragma unroll
            for (int ww = 0; ww < 8; ++ww) tot += SQ[ww * 128 + t];
            const float rstd = rsqrtf(tot * (1.f / 512.f) + EPS);
#pragma unroll
            for (int cb = 0; cb < 2; ++cb)
#pragma unroll
                for (int g4 = 0; g4 < 4; ++g4) { const int c0 = 32 * cb + 8 * g4 + 4 * hie; const f32x4 gg = *(const GAS f32x4*)(gnl + ch0 + c0);
                    *(LAS unsigned long long*)(wt + t * 128 + (((4 * cb + g4) ^ (t & 7)) << 4) + 8 * hie) = (unsigned long long)cvtpk(z[cb][tb][4 * g4] * rstd * gg.x, z[cb][tb][4 * g4 + 1] * rstd * gg.y) | ((unsigned long long)cvtpk(z[cb][tb][4 * g4 + 2] * rstd * gg.z, z[cb][tb][4 * g4 + 3] * rstd * gg.w) << 32); } asm volatile("" ::: "memory"); }
#pragma unroll
        for (int i = 0; i < 16; ++i) { const int t = 8 * i + l3; const v4u v = *(const LAS v4u*)(wt + t * 128 + ((l8 ^ (t & 7)) << 4));
            *(v4u*)(mix + ((size_t)b * SEQ + s0 + t) * DM + 512 + ch0 + l8 * 8) = v; }
        __syncthreads();
    }
}

struct P5Ctx { LAS float* md; LAS float* wrT; const float* x; const bf16* t; unsigned char* h2; float* aff; bf16* x1; int lane, NGW; };
__device__ __forceinline__ void p5_issue(const P5Ctx& C, f32x4 (&xb)[4], uint2 (&tb)[4], int row) {
    const bool in = row < NTOK; const int ln = in ? C.lane : 0; const size_t ro = in ? (size_t)row * DM : 0;
    const f32x4* xr = (const f32x4*)(C.x + ro) + ln; const uint2* tr = (const uint2*)(C.t + ro) + ln;
#pragma unroll
    for (int j = 0; j < 4; ++j) { xb[j] = __builtin_nontemporal_load(xr + 64 * j); { typedef unsigned u32x2_t __attribute__((ext_vector_type(2))); const u32x2_t tq = __builtin_nontemporal_load((const u32x2_t*)(tr + 64 * j)); tb[j].x = tq.x; tb[j].y = tq.y; } }
}
__device__ __forceinline__ void p5_row(const P5Ctx& C, const f32x4 (&g1q)[4], const f32x4 (&g2q)[4], f32x4 (&xb)[4], uint2 (&tb)[4], int m) {
    if (m >= NTOK) return;
    LAS float* md = C.md; LAS float* wrT = C.wrT; unsigned char* h2 = C.h2; float* aff = C.aff; const int lane = C.lane;
        const int b = m >> 13, s = m & 8191;
        f32x4 tv[4], xv[4]; float ss = 0.f;
#pragma unroll
        for (int j = 0; j < 4; ++j) { const uint2 tq = tb[j]; tv[j] = (f32x4){bflo(tq.x), bfhi(tq.x), bflo(tq.y), bfhi(tq.y)}; xv[j] = xb[j]; ss += (tv[j].x * tv[j].x + tv[j].y * tv[j].y) + (tv[j].z * tv[j].z + tv[j].w * tv[j].w); }
        const float rstd1 = rsqrtf(wave_sum(ss) * (1.f / DM) + EPS);
        float ss2 = 0.f; unsigned long long* orow = (unsigned long long*)(C.x1 + (size_t)m * DM) + lane;
#pragma unroll
        for (int j = 0; j < 4; ++j) { const int col = 4 * lane + 256 * j; const f32x4 gg = g1q[j], ga = *(const LAS f32x4*)(md + b * 3072 + col);
            xv[j] = xv[j] + ga * (tv[j] * rstd1 * gg); orow[64 * j] = (unsigned long long)cvtpk(xv[j].x, xv[j].y) | ((unsigned long long)cvtpk(xv[j].z, xv[j].w) << 32);
            ss2 += (xv[j].x * xv[j].x + xv[j].y * xv[j].y) + (xv[j].z * xv[j].z + xv[j].w * xv[j].w); }
        const float rstd2 = rsqrtf(wave_sum(ss2) * (1.f / DM) + EPS);
        unsigned* o8 = (unsigned*)(h2 + (size_t)m * DM) + lane;
        f32x4 hv[4];
#pragma unroll
        for (int j = 0; j < 4; ++j) { const int col = 4 * lane + 256 * j; const f32x4 gg = g2q[j];
            const f32x4 sh = *(const LAS f32x4*)(md + b * 3072 + 1024 + col), sc = *(const LAS f32x4*)(md + b * 3072 + 2048 + col);
            hv[j] = (xv[j] * rstd2 * gg) * (sc + 1.f) + sh;
            o8[64 * j] = pg8::pk4_fp8(hv[j].x, hv[j].y, hv[j].z, hv[j].w); }
        float lg[16];
#pragma unroll
        for (int eg = 0; eg < 4; ++eg) { f32x4 wv[4][4];
#pragma unroll
            for (int e4 = 0; e4 < 4; ++e4)
#pragma unroll
                for (int j = 0; j < 4; ++j) wv[e4][j] = *(const LAS f32x4*)(wrT + (4 * eg + e4) * DM + 4 * lane + 256 * j);
#pragma unroll
            for (int e4 = 0; e4 < 4; ++e4) { f32x2_t a2 = {0.f, 0.f};
#pragma unroll
                for (int j = 0; j < 4; ++j) { a2 += (f32x2_t){hv[j].x, hv[j].y} * (f32x2_t){wv[e4][j].x, wv[e4][j].y}; a2 += (f32x2_t){hv[j].z, hv[j].w} * (f32x2_t){wv[e4][j].z, wv[e4][j].w}; }
                float a = a2.x + a2.y; asm volatile("" : "+v"(a)); lg[4 * eg + e4] = a; } }
        float v8[8];
#pragma unroll
        for (int e = 0; e < 8; ++e) { const auto r = __builtin_amdgcn_permlane32_swap(__float_as_uint(lg[e]), __float_as_uint(lg[e + 8]), false, false); v8[e] = __uint_as_float(r[0]) + __uint_as_float(r[1]); }
        const bool b4 = (lane & 16) != 0, b3 = (lane & 8) != 0, b2 = (lane & 4) != 0;
        float v4[4];
#pragma unroll
        for (int i = 0; i < 4; ++i) { const float snd = b4 ? v8[i] : v8[i + 4], kp = b4 ? v8[i + 4] : v8[i]; v4[i] = kp + __shfl_xor(snd, 16); }
        float v2[2];
#pragma unroll
        for (int i = 0; i < 2; ++i) { const float snd = b3 ? v4[i] : v4[i + 2], kp = b3 ? v4[i + 2] : v4[i]; v2[i] = kp + __shfl_xor(snd, 8); }
        float tl; { const float snd = b2 ? v2[0] : v2[1], kp = b2 ? v2[1] : v2[0]; tl = kp + __shfl_xor(snd, 4); }
        DPP_ADDF(tl, 0x4E, 0xf); DPP_ADDF(tl, 0xB1, 0xf);
        const float mx = wave_max(tl), ex = __expf(tl - mx), se = wave_sum(ex) * 0.25f;
        if ((lane & 3) == 0) aff[(size_t)(b * NEXP + (lane >> 2)) * SEQ + s] = ex / se;
}
__device__ __forceinline__ void p5_postmix(Frame& F) {
    LAS float* md = (LAS float*)(F.lds + RING_OFF);
    LAS float* wrT = (LAS float*)(F.lds + RING_OFF + 32768);
#pragma unroll 16
    for (int i = F.tid; i < DM * NEXP; i += NWAVES * 64) { const int col = i >> 4, e = i & 15; wrT[e * DM + col] = F.in[IN_WROUTER][i]; }
    modf_to_lds(F, md, 2048, 3072);
    const int gw = F.vcu * NWAVES + F.wave, NGW = F.G * NWAVES, lane = F.lane;
    const float* g1 = F.in[IN_NPOSTMIX]; const float* g2 = F.in[IN_NPREFFN];
    const P5Ctx C{md, wrT, F.in[IN_X], (const bf16*)(F.ws + WS_T), (unsigned char*)(F.ws + WS_H), (float*)(F.ws + WS_AFF), (bf16*)(F.ws + WS_X1), lane, NGW};
    f32x4 g1q[4], g2q[4];
#pragma unroll
    for (int j = 0; j < 4; ++j) { g1q[j] = *(const f32x4*)(g1 + 4 * lane + 256 * j); g2q[j] = *(const f32x4*)(g2 + 4 * lane + 256 * j); }
    f32x4 xA[4], xB[4]; uint2 tA[4], tB[4];
    p5_issue(C, xA, tA, gw); __builtin_amdgcn_sched_barrier(0);
#pragma unroll 1
    for (int m = gw; m < NTOK; m += 2 * NGW) {
        p5_issue(C, xB, tB, m + NGW); __builtin_amdgcn_sched_barrier(0);
        p5_row(C, g1q, g2q, xA, tA, m); __builtin_amdgcn_sched_barrier(0);
        p5_issue(C, xA, tA, m + 2 * NGW); __builtin_amdgcn_sched_barrier(0);
        p5_row(C, g1q, g2q, xB, tB, m + NGW); __builtin_amdgcn_sched_barrier(0);
    }
    __syncthreads();
}

__device__ __forceinline__ void p6_topk(Frame& F) {
    LAS unsigned* vals = (LAS unsigned*)(F.lds + RING_OFF);
    LAS unsigned* hist = (LAS unsigned*)(F.lds + RING_OFF + 32768);
    LAS unsigned* misc = (LAS unsigned*)(F.lds + RING_OFF + 32768 + 1024);
    const int tid = F.tid, lane = F.lane, w = F.wave;
    const float* aff = (const float*)(F.ws + WS_AFF); int* slots = (int*)(F.ws + WS_SLOTS); int* idx = (int*)(F.ws + WS_IDX); float* gates = (float*)(F.ws + WS_GATES);
    if (F.vcu >= BATCH * NEXP) {
        const int ncv = (F.G - BATCH * NEXP) < P6_CONV ? (F.G - BATCH * NEXP) : P6_CONV;
        if (F.vcu - BATCH * NEXP < ncv) p0_expert_items(F, XI_R1, XI_TOTAL, (F.vcu - BATCH * NEXP) * NWAVES + F.wave, ncv * NWAVES);
        return; }
    if (F.G <= BATCH * NEXP && F.vcu == 0) p0_expert_items(F, XI_R1, XI_TOTAL, F.wave, NWAVES);
    for (int unit = F.vcu; unit < BATCH * NEXP; unit += F.G) {
        const int b = unit >> 4, e = unit & 15;
        __syncthreads();
        const unsigned* src = (const unsigned*)(aff + (size_t)unit * SEQ);
        for (int i = tid; i < SEQ; i += NWAVES * 64) vals[i] = src[i];
        unsigned prefix = 0u, mask = 0u, need = CAP;
#pragma unroll 1
        for (int pass = 0; pass < 4; ++pass) {
            const int shift = 24 - 8 * pass;
            if (tid < 256) hist[tid] = 0u;
            __syncthreads();
            for (int i = tid; i < SEQ; i += NWAVES * 64) { const unsigned v = vals[i]; if ((v & mask) == prefix) __hip_atomic_fetch_add(&hist[(v >> shift) & 255u], 1u, __ATOMIC_RELAXED, __HIP_MEMORY_SCOPE_WORKGROUP); }
            __syncthreads();
            if (w == 0) {
                const unsigned b0 = hist[4 * lane], b1 = hist[4 * lane + 1], b2 = hist[4 * lane + 2], b3 = hist[4 * lane + 3];
                const unsigned sl = b0 + b1 + b2 + b3; unsigned suf = sl;
#pragma unroll
                for (int o = 1; o < 64; o <<= 1) { const unsigned tv = __shfl_down(suf, o); if (lane + o < 64) suf += tv; }
                const unsigned above = suf - sl;
                if (above < need && need <= above + sl) {
                    unsigned cnt = above, dig, nn;
                    if (cnt + b3 >= need) { dig = 3; nn = need - cnt; } else { cnt += b3;
                    if (cnt + b2 >= need) { dig = 2; nn = need - cnt; } else { cnt += b2;
                    if (cnt + b1 >= need) { dig = 1; nn = need - cnt; } else { cnt += b1; dig = 0; nn = need - cnt; } } }
                    misc[0] = 4u * lane + dig; misc[1] = nn; }
            }
            __syncthreads();
            prefix |= misc[0] << shift; mask |= 255u << shift; need = misc[1];
            __syncthreads();
        }
        const unsigned T = prefix; unsigned gt = 0u, eq = 0u; unsigned v16[16];
#pragma unroll
        for (int i = 0; i < 16; ++i) { v16[i] = vals[16 * tid + i]; gt += (v16[i] > T) ? 1u : 0u; eq += (v16[i] == T) ? 1u : 0u; }
        unsigned pk = gt | (eq << 16), inc = pk;
#pragma unroll
        for (int o = 1; o < 64; o <<= 1) { const unsigned tv = __shfl_up(inc, o); if (lane >= o) inc += tv; }
        if (lane == 63) misc[16 + w] = inc;
        __syncthreads();
        unsigned base = 0u;
#pragma unroll
        for (int ww = 0; ww < 8; ++ww) base += (ww < w) ? misc[16 + ww] : 0u;
        const unsigned exc = base + inc - pk; unsigned gtb = exc & 0xffffu, eqb = exc >> 16;
#pragma unroll
        for (int i = 0; i < 16; ++i) { const int tok = 16 * tid + i; const unsigned v = v16[i]; int slot = -1;
            if (v > T) { slot = (int)(gtb + (eqb < need ? eqb : need)); ++gtb; }
            else if (v == T) { if (eqb < need) slot = (int)(gtb + eqb); ++eqb; }
            slots[(size_t)(b * SEQ + tok) * NEXP + e] = slot;
            if (slot >= 0) { idx[(e * BATCH + b) * CAP + slot] = b * SEQ + tok; gates[unit * CAP + slot] = __uint_as_float(v); } }
    }
    __syncthreads();
}

__device__ __forceinline__ void p6b_gather(Frame& F) {
    const int gw = F.vcu * NWAVES + F.wave, NGW = F.G * NWAVES, lane = F.lane;
    const int* idx = (const int*)(F.ws + WS_IDX); const unsigned char* h2 = (const unsigned char*)(F.ws + WS_H); unsigned char* xs = (unsigned char*)(F.ws + WS_XS);
    for (int r = gw; r < NROWS_E; r += NGW) { const int e = r >> 11, b = (r >> 10) & 1, c = r & 1023; const int tok = idx[(b * NEXP + e) * CAP + c];
        const v4u* sp = (const v4u*)(h2 + (size_t)(b * SEQ + tok) * DM) + lane; v4u* dp = (v4u*)(xs + (size_t)r * DM) + lane;
        dp[0] = sp[0]; }
}

typedef unsigned u32x2_t __attribute__((ext_vector_type(2)));
struct P10Set { float gt[4]; unsigned r[4][4]; u32x2_t x1[4]; unsigned okb, mask; int slotv; };
__device__ __forceinline__ void p10_gather4(float (&gt)[4], unsigned (&r)[4][4], unsigned& okb, unsigned& mask, int slotv, int b, const float* gates, const unsigned char* yrows, int lane, int dflt) {
    int rowi = dflt, gi = dflt; okb = 0u;
#pragma unroll
    for (int q = 0; q < 4; ++q) { const bool ok = mask != 0u; const int e = ok ? __builtin_ctz(mask) : 0; mask = ok ? (mask & (mask - 1u)) : 0u;
        const int sl = __builtin_amdgcn_readlane(slotv, e);
        rowi = ok ? e * 2048 + b * 1024 + sl : rowi; gi = ok ? (b * NEXP + e) * CAP + sl : gi; okb |= ok ? (1u << q) : 0u;
        gt[q] = gates[gi]; const unsigned* yr = (const unsigned*)(yrows + (size_t)rowi * DM) + lane;
#pragma unroll
        for (int j = 0; j < 4; ++j) r[q][j] = __builtin_nontemporal_load(yr + 64 * j); }
}
__device__ __forceinline__ void p10_accum(const float (&gt)[4], const unsigned (&r)[4][4], unsigned okb, float (&y)[16]) {
#pragma unroll
    for (int q = 0; q < 4; ++q) { const float g = ((okb >> q) & 1u) ? gt[q] * (1.f / Y8_SCALE) : 0.f;
#pragma unroll
        for (int j = 0; j < 4; ++j) { const f32x2_t lo = __builtin_amdgcn_cvt_pk_f32_fp8((int)r[q][j], false), hi = __builtin_amdgcn_cvt_pk_f32_fp8((int)r[q][j], true);
            y[4 * j] += g * lo.x; y[4 * j + 1] += g * lo.y; y[4 * j + 2] += g * hi.x; y[4 * j + 3] += g * hi.y; } }
}
struct P10Ctx { const float* gates; const unsigned char* yrows; const bf16* x1; float* out; LAS float* md; LAS int* sl; int gw, NGW, nrows, lane; };
__device__ __forceinline__ void p10_issue_row(const P10Ctx& C, P10Set& S, int k) {
    const int kk = k < C.nrows ? k : C.nrows - 1, m = C.gw + kk * C.NGW, lane = C.lane;
    S.slotv = C.sl[kk * 16 + (lane & 15)]; S.slotv = (lane < 16) ? S.slotv : -1;
    S.mask = (unsigned)(__ballot(S.slotv >= 0) & 0xffffull);
    p10_gather4(S.gt, S.r, S.okb, S.mask, S.slotv, m >> 13, C.gates, C.yrows, lane, m & 32767);
    const u32x2_t* xr = (const u32x2_t*)(C.x1 + (size_t)m * DM) + lane;
#pragma unroll
    for (int j = 0; j < 4; ++j) S.x1[j] = xr[64 * j];
}
__device__ __forceinline__ void p10_finish_row(const P10Ctx& C, P10Set& S, const f32x4 (&gnq)[4], int k) {
    if (k >= C.nrows) return;
    const int m = C.gw + k * C.NGW, b = m >> 13, lane = C.lane;
    float y[16];
#pragma unroll
    for (int i = 0; i < 16; ++i) y[i] = 0.f;
    p10_accum(S.gt, S.r, S.okb, y);
    while (S.mask) { float gt[4]; unsigned r[4][4]; unsigned okb; p10_gather4(gt, r, okb, S.mask, S.slotv, b, C.gates, C.yrows, lane, m & 32767); p10_accum(gt, r, okb, y); }
    float ss = 0.f;
#pragma unroll
    for (int i = 0; i < 16; ++i) ss += y[i] * y[i];
    const float rstd = rsqrtf(wave_sum(ss) * (1.f / DM) + EPS);
    float* orow = C.out + (size_t)m * DM + 4 * lane;
#pragma unroll
    for (int j = 0; j < 4; ++j) { const u32x2_t xq = S.x1[j]; const f32x4 gg = gnq[j], ga = *(const LAS f32x4*)(C.md + b * 1024 + 4 * lane + 256 * j);
        const f32x4 yv = {y[4 * j], y[4 * j + 1], y[4 * j + 2], y[4 * j + 3]}, x1 = {bflo(xq.x), bfhi(xq.x), bflo(xq.y), bfhi(xq.y)};
        __builtin_nontemporal_store(x1 + ga * (yv * rstd * gg), (f32x4*)(orow + 256 * j)); }
}
template <int PM = 0> __device__ __forceinline__ void p9_combine(Frame& F) {
    LAS float* md = (LAS float*)(F.lds + RING_OFF);
    modf_to_lds(F, md, 5120, 1024);
    const int gw = F.vcu * NWAVES + F.wave, NGW = F.G * NWAVES, lane = F.lane;
    if (gw >= NTOK) return;
    const int nrows = (NTOK - gw + NGW - 1) / NGW;
    LAS int* sl = (LAS int*)(F.lds + RING_OFF + 16384) + F.wave * 2048;
    const int* slots = (const int*)(F.ws + WS_SLOTS);
    for (int k0 = 0; k0 < nrows && k0 < 128; k0 += 4) { const int k = k0 + (lane >> 4); if (k < nrows) sl[k * 16 + (lane & 15)] = slots[(size_t)(gw + k * NGW) * NEXP + (lane & 15)]; }
    const float* gn = F.in[IN_NPOSTFFN];
    f32x4 gnq[4];
#pragma unroll
    for (int j = 0; j < 4; ++j) gnq[j] = *(const f32x4*)(gn + 4 * lane + 256 * j);
    asm volatile("s_waitcnt vmcnt(0) lgkmcnt(0)" ::: "memory");
    const P10Ctx C{(const float*)(F.ws + WS_GATES), (const unsigned char*)(F.ws + WS_YROWS), (const bf16*)(F.ws + WS_X1), F.out, md, sl, gw, NGW, nrows < 128 ? nrows : 128, lane};
    P10Set A, B;
    p10_issue_row(C, A, 0); __builtin_amdgcn_sched_barrier(0);
#pragma unroll 1
    for (int k = 0; k < C.nrows; k += 2) {
        p10_issue_row(C, B, k + 1); __builtin_amdgcn_sched_barrier(0);
        p10_finish_row(C, A, gnq, k); __builtin_amdgcn_sched_barrier(0);
        p10_issue_row(C, A, k + 2); __builtin_amdgcn_sched_barrier(0);
        p10_finish_row(C, B, gnq, k + 1); __builtin_amdgcn_sched_barrier(0);
    }
}


__device__ __forceinline__ void ph2_inproj(Frame& F) {
    pg8::Gemm g{(const pg8::bf16_t*)(F.ws + WS_H), (const pg8::bf16_t*)(F.ws + WS_WINT), NTOK, D_IN, DM, nullptr}; pg8::StaticOrder S; S.init(NTOK, D_IN, F.G, (int)blockIdx.x);
    pg8::EpiProj E{(pg8::bf16_t*)(F.ws + WS_Q), (pg8::bf16_t*)(F.ws + WS_K), (pg8::bf16_t*)(F.ws + WS_VT), (pg8::bf16_t*)(F.ws + WS_U), (pg8::bf16_t*)(F.ws + WS_VGT), (float*)(F.ws + WS_VSTAT)};
    pg8::gemm_phase<pg8::EpiProj, pg8::StaticOrder, true, true>(F.lds + RING_OFF, g, S, E);
    { pg8::Unit u2; if (!S.next(1, u2)) {
        const int nlight = 2 * F.G - (NTOK / 256) * (D_IN / 256), first_light = F.G - nlight;
        if (nlight > 0 && (int)blockIdx.x >= first_light) p0_expert_items(F, XI_R0, XI_R1, ((int)blockIdx.x - first_light) * NWAVES + F.wave, nlight * NWAVES);
        else if (nlight <= 0 && blockIdx.x == 0) p0_expert_items(F, XI_R0, XI_R1, F.wave, NWAVES); } }
}
#ifndef PROBE_DUP
#define PROBE_DUP -1
#endif
__device__ __forceinline__ void ph3_mixer(Frame& F) { p3_attn_mfma(F); if (PROBE_DUP == 31) { __syncthreads(); p3_attn_mfma(F); } p3_gmlp_mfma(F); if (PROBE_DUP == 32) p3_gmlp_mfma(F); }
__device__ __forceinline__ void ph4_outproj(Frame& F) {
    pg8::Gemm g{(const pg8::bf16_t*)(F.ws + WS_MIX), (const pg8::bf16_t*)(F.ws + WS_WOUTT), NTOK, DM, DM, nullptr}; pg8::StaticOrder S; S.init(NTOK, DM, F.G, (int)blockIdx.x);
    pg8::EpiDown E{(pg8::bf16_t*)(F.ws + WS_T), 4};
    pg8::gemm_phase<pg8::EpiDown, pg8::StaticOrder, true, true>(F.lds + RING_OFF, g, S, E);
}
__device__ __forceinline__ void ph8_gateup(Frame& F) {
    pg8::Gemm g{(const pg8::bf16_t*)(F.ws + WS_H), (const pg8::bf16_t*)(F.ws + WS_WGUT), NROWS_E, 2 * D_FF, DM / 2, (const int*)(F.ws + WS_IDX)}; pg8::MoeOrder S; S.init(NEXP, 8, 22, F.G, (int)blockIdx.x);
    pg8::EpiSwiGLU8 E{(unsigned char*)(F.ws + WS_HID), 22, W8_INV};
    pg8::Unit u0;
    for (int base = 0; S.next(base, u0); base += 12) { pg8::SubOrder SS{S, base, 12};
        pg8::gemm_phase<pg8::EpiSwiGLU8, pg8::SubOrder, true, true, true, true, PF_DIST, true>(F.lds + RING_OFF, g, SS, E); }
}
__device__ __forceinline__ void ph9_down(Frame& F) {
    pg8::Gemm g{(const pg8::bf16_t*)(F.ws + WS_HID), (const pg8::bf16_t*)(F.ws + WS_WDT), NROWS_E, DM, D_FF / 2, nullptr}; pg8::MoeOrder S; S.init(NEXP, 8, 4, F.G, (int)blockIdx.x);
    pg8::EpiDown8 E{(unsigned char*)(F.ws + WS_YROWS), 4, W8_INV * Y8_SCALE};
    pg8::gemm_phase<pg8::EpiDown8, pg8::MoeOrder, true, true, true, false, PF_DIST, true>(F.lds + RING_OFF, g, S, E);
}
constexpr int NPHASES = 11;
#ifndef MK_N_LAUNCHES
#define MK_N_LAUNCHES 1
#endif
struct Args { const float* in[21]; float* out; unsigned char* ws; int ph_lo, ph_hi, li, pad; };
__global__ void __launch_bounds__(NWAVES * 64, 2) hymba_fwd(Args args) {
    extern __shared__ __attribute__((aligned(16))) unsigned char lds[];
    Frame F;
    F.lds = (LAS unsigned char*)lds;
    F.MISC = (volatile LAS unsigned*)(F.lds + MISC_OFF);
    F.tid = threadIdx.x; F.lane = F.tid & 63; F.wave = __builtin_amdgcn_readfirstlane(F.tid >> 6);
    F.G = gridDim.x; { const int bx = blockIdx.x; F.vcu = (F.G % 8 == 0) ? (bx % 8) * (F.G / 8) + bx / 8 : bx; }
#pragma unroll
    for (int i = 0; i < 21; ++i) F.in[i] = args.in[i];
    F.out = args.out; F.ws = args.ws; F.ctl = (gu32*)(args.ws + WS_CTL);
    for (int u = F.tid; u < (LDS_BYTES - LDSCTL_OFF) / 4; u += NWAVES * 64) ((LAS unsigned*)(F.lds + LDSCTL_OFF))[u] = 0u;
    __syncthreads();
    XcdBarrier bar; bar.bar = (unsigned*)(F.ctl + CW_BAR); bar.x = 0; bar.st = nullptr;
    const bool one_launch = (args.ph_hi - args.ph_lo) > 1;
    if (one_launch) bar = xcd_barrier_post((unsigned*)(F.ctl + CW_BAR), F.MISC + 8);
    const int lo = args.ph_lo, hi = args.ph_hi;
#ifndef PHASE_MASK
#define PHASE_MASK 0x7ff
#endif
#define IN(k) (((PHASE_MASK >> (k)) & 1) && lo <= (k) && (k) < hi)
#define BOTH(k) (IN(k) && IN((k) + 1))
#define GRID_BAR() xcd_barrier(bar)
#ifndef PROBE_DUP
#define PROBE_DUP -1
#endif
#define PHASE(k, call) if (IN(k)) { call; if (PROBE_DUP == (k)) { GRID_BAR(); call; } if (BOTH(k)) GRID_BAR(); }
    if (IN(0)) { p0_prologue(F); if (PROBE_DUP == 0) { GRID_BAR(); p0_prologue(F); } }
    PHASE(1, p1_prenorm(F))
    PHASE(2, ph2_inproj(F))
    PHASE(3, ph3_mixer(F))
    PHASE(4, ph4_outproj(F))
    PHASE(5, p5_postmix(F))
    PHASE(6, p6_topk(F))
    PHASE(8, ph8_gateup(F))
    PHASE(9, ph9_down(F))
    if (IN(10)) { if (PROBE_DUP == 10) { p9_combine<P10_MODE>(F); GRID_BAR(); } p9_combine<0>(F); }
#undef PHASE
#undef IN
#undef BOTH
#undef GRID_BAR
}

extern "C" void kernel_launch(void* const* d_in, const int* in_sizes, int n_in, void* d_out, int out_size, void* d_ws, size_t ws_size, hipStream_t stream) {
    static int grid = 0;
    if (grid == 0) {
        if (n_in != 21 || out_size != NTOK * DM || ws_size < WS_END) { fprintf(stderr, "kernel_launch: unexpected shapes (n_in %d out %d ws %zu)\n", n_in, out_size, ws_size); grid = -1; return; }
        int dev = 0, cus = 0;
        if (hipGetDevice(&dev) != hipSuccess || hipDeviceGetAttribute(&cus, hipDeviceAttributeMultiprocessorCount, dev) != hipSuccess) { grid = -1; return; }
        if (hipFuncSetAttribute((const void*)hymba_fwd, hipFuncAttributeMaxDynamicSharedMemorySize, LDS_BYTES) != hipSuccess) { fprintf(stderr, "kernel_launch: hipFuncSetAttribute failed\n"); grid = -1; return; }
        int per_cu = 0;
        if (hipOccupancyMaxActiveBlocksPerMultiprocessor(&per_cu, (const void*)hymba_fwd, NWAVES * 64, LDS_BYTES) != hipSuccess || per_cu < 1) fprintf(stderr, "kernel_launch: occupancy query reports %d\n", per_cu);
        (void)hipGetLastError();
        grid = cus;
    }
    if (grid < 0) return;
    (void)hipMemsetAsync((char*)d_ws + WS_CTL, 0, CTL_ZERO_BYTES, stream);
    Args a{};
    for (int i = 0; i < 21; ++i) a.in[i] = (const float*)d_in[i];
    a.out = (float*)d_out; a.ws = (unsigned char*)d_ws;
    if (MK_N_LAUNCHES == 1) { a.ph_lo = 0; a.ph_hi = NPHASES; a.li = 0; hipLaunchKernelGGL(hymba_fwd, dim3(grid), dim3(NWAVES * 64), LDS_BYTES, stream, a); }
    else for (int li = 0; li < NPHASES; ++li) { a.ph_lo = li; a.ph_hi = li + 1; a.li = li; hipLaunchKernelGGL(hymba_fwd, dim3(grid), dim3(NWAVES * 64), LDS_BYTES, stream, a); }
}
```

```cpp
#include <hip/hip_runtime.h>
#include <cstdio>
#include <cstdint>
namespace pg8 {
#define PG8_LAS __attribute__((address_space(3)))
typedef unsigned short bf16_t;
typedef short bf16x8 __attribute__((ext_vector_type(8)));
typedef float f32x4 __attribute__((ext_vector_type(4)));
typedef unsigned u32x4 __attribute__((ext_vector_type(4)));
constexpr int BM = 256, BK = 64, HALF = 128, HTB = HALF * BK * 2  , STAGE_BYTES = 8 * HTB, NXCD = 8, WGM = 8;

__host__ __device__ __forceinline__ int lds_byte(int r, int c) { const int st = (r >> 4) * 2 + (c >> 5), rr = r & 15, cc = c & 31, ob = rr * 64 + cc * 2; return st * 1024 + (ob ^ (((ob >> 9) & 1) << 5)); }
__host__ __device__ __forceinline__ void stage_rc(int b, int& R, int& C) { const int st = b / 1024, sb = b % 1024, swz = sb ^ (((sb >> 9) & 1) << 5); R = (st >> 1) * 16 + swz / 64; C = (st & 1) * 32 + (swz % 64) / 2; }
__host__ __device__ __forceinline__ int perm32(int rho) { const int n = rho >> 4, i = rho & 15; return 8 * (i >> 2) + 4 * n + (i & 3); }

struct Unit { int pm, pn; };
struct Gemm { const bf16_t* A; const bf16_t* Bt; int M, N, K; const int* rowmap; };

struct StaticOrder {
    int nM, nN, nwg, G, c;
    __host__ __device__ void init(int M, int N, int G_, int c_) { nM = M / BM; nN = N / BM; nwg = nM * nN; G = G_; c = c_; }
    __host__ __device__ bool next(int i, Unit& u) const {
        const long L = (long)i * G + c; if (L >= nwg) return false;
        int wgid = (int)L; { const int q = nwg / NXCD, r = nwg % NXCD, xcd = wgid % NXCD, off = wgid / NXCD; wgid = (xcd < r ? xcd * (q + 1) : r * (q + 1) + (xcd - r) * q) + off; }
        const int nig = WGM * nN, gid = wgid / nig, fm = gid * WGM, gsz = (nM - fm) < WGM ? (nM - fm) : WGM;
        u.pm = fm + ((wgid % nig) % gsz); u.pn = (wgid % nig) / gsz; return true;
    }
    __device__ __forceinline__ void a_ready(const Unit&) const {}
    __device__ __forceinline__ void done(const Unit&) const {}
};


typedef float f32x2 __attribute__((ext_vector_type(2))); typedef float f32x2_t __attribute__((ext_vector_type(2))); typedef __bf16 bf16x2_t __attribute__((ext_vector_type(2))); typedef int i32x4_t __attribute__((ext_vector_type(4)));
__device__ __forceinline__ unsigned cvtpk(float lo, float hi) { f32x2_t v = {lo, hi}; bf16x2_t b = __builtin_convertvector(v, bf16x2_t); return __builtin_bit_cast(unsigned, b); }
__device__ __forceinline__ bf16_t f2bf1(float f) { return (bf16_t)(cvtpk(f, 0.f) & 0xffffu); }
__device__ __forceinline__ void store8(bf16_t* p, const f32x4 v0, const f32x4 v1) {
    u32x4 w; w.x = cvtpk(v0[0], v0[1]); w.y = cvtpk(v0[2], v0[3]); w.z = cvtpk(v1[0], v1[1]); w.w = cvtpk(v1[2], v1[3]); *(u32x4*)p = w; }
__device__ __forceinline__ float gelu_tanh(float x) {
    const float t = x * __builtin_fmaf(x * x, -0.10294324f, -2.30220823f);
    return x * __builtin_amdgcn_rcpf(1.f + __builtin_amdgcn_exp2f(t));
}
__device__ __forceinline__ float silu_f(float x) { return x / (1.f + __expf(-x)); }

struct MoeOrder {
    int nE, nM, nN, U, G, c;
    __device__ void init(int nE_, int nM_, int nN_, int G_, int c_) { nE = nE_; nM = nM_; nN = nN_; U = nE * nM * nN; G = G_; c = c_; }
    __device__ bool next(int i, Unit& u) const {
        int gl;
        if ((G & 7) == 0 && (U & 7) == 0) { const int x = c & 7, j = c >> 3, per = G >> 3, li = i * per + j, ux = U >> 3; if (li >= ux) return false; gl = x * ux + li; }
        else { const long L = (long)i * G + c; if (L >= U) return false; gl = (int)L; }
        const int per_e = nM * nN, e = gl / per_e, r = gl % per_e;
        u.pm = e * nM + (r % nM); u.pn = e * nN + (r / nM); return true;
    }
    __device__ __forceinline__ void a_ready(const Unit&) const {}
    __device__ __forceinline__ void done(const Unit&) const {}
};

struct SubOrder {
    MoeOrder S; int base, cnt;
    __device__ bool next(int i, Unit& u) const { return i < cnt && S.next(base + i, u); }
    __device__ __forceinline__ void a_ready(const Unit&) const {}
    __device__ __forceinline__ void done(const Unit&) const {}
};

struct EpiProj {
    static constexpr bool PERM = true, AFTER_DRAIN = false;
    bf16_t *q, *k, *vT, *u, *vgT; float* vstat;
    __device__ __forceinline__ void operator()(const f32x4 (&acc)[2][2][4][2], const Unit& un, int wr, int wc, int fr, int fq) const {
        const int row0 = un.pm * BM + wr * 64 + fr, pn = un.pn, cw = wc * 32 + 8 * fq;
        const int b = (un.pm * BM) >> 13;
        if (pn < 2) {
#pragma unroll
            for (int ai = 0; ai < 2; ++ai)
#pragma unroll
                for (int m = 0; m < 4; ++m) { bf16_t* rowp = q + (size_t)(row0 + ai * HALF + m * 16) * 512 + pn * 256 + cw;
#pragma unroll
                    for (int bj = 0; bj < 2; ++bj) store8(rowp + bj * HALF, acc[ai][bj][m][0], acc[ai][bj][m][1]); }
        } else if (pn == 2) {
#pragma unroll
            for (int ai = 0; ai < 2; ++ai)
#pragma unroll
                for (int m = 0; m < 4; ++m) { const int r = row0 + ai * HALF + m * 16, s = r & 8191;
                    store8(k + (size_t)r * 128 + cw, acc[ai][0][m][0], acc[ai][0][m][1]);
#pragma unroll
                    for (int n = 0; n < 2; ++n)
#pragma unroll
                        for (int j = 0; j < 4; ++j) vT[(size_t)(b * 128 + cw + 4 * n + j) * 8192 + s] = f2bf1(acc[ai][1][m][n][j]); }
        } else if (pn < 5) {
#pragma unroll
            for (int ai = 0; ai < 2; ++ai)
#pragma unroll
                for (int m = 0; m < 4; ++m) { bf16_t* rowp = u + (size_t)(row0 + ai * HALF + m * 16) * 512 + (pn - 3) * 256 + cw;
#pragma unroll
                    for (int bj = 0; bj < 2; ++bj) { f32x4 v0 = acc[ai][bj][m][0], v1 = acc[ai][bj][m][1];
#pragma unroll
                        for (int j = 0; j < 4; ++j) { v0[j] = gelu_tanh(v0[j]); v1[j] = gelu_tanh(v1[j]); }
                        store8(rowp + bj * HALF, v0, v1); } }
        } else {
#pragma unroll
            for (int ai = 0; ai < 2; ++ai)
#pragma unroll
                for (int m = 0; m < 4; ++m) { const int r = row0 + ai * HALF + m * 16, s = r & 8191, nch = s >> 7, sl = s & 127, ks = sl >> 4, hi = (sl >> 3) & 1, jj = sl & 7;
                    float ps = 0.f, pq = 0.f;
#pragma unroll
                    for (int bj = 0; bj < 2; ++bj)
#pragma unroll
                        for (int n = 0; n < 2; ++n)
#pragma unroll
                            for (int j = 0; j < 4; ++j) { const int ch = (pn - 5) * 256 + bj * HALF + cw + 4 * n + j, g = ch >> 6, cb = (ch >> 5) & 1, r32 = ch & 31;
                                const bf16_t hb = f2bf1(gelu_tanh(acc[ai][bj][m][n][j])); const float hv = __uint_as_float((unsigned)hb << 16); ps += hv; pq += hv * hv;
                                vgT[((((size_t)(b * 64 + nch) * 8 + g) * 2 + cb) * 8 + ks) * 512 + (hi * 32 + r32) * 8 + jj] = hb; }
                    ps += __shfl_xor(ps, 16); ps += __shfl_xor(ps, 32); pq += __shfl_xor(pq, 16); pq += __shfl_xor(pq, 32);
                    if (fq == 0) { f32x2 st2 = {ps, pq}; *(f32x2*)(vstat + ((size_t)((pn - 5) * 4 + wc) * 16384 + r) * 2) = st2; } }
        }
    }
};

struct EpiF32 {
    static constexpr bool PERM = false, AFTER_DRAIN = false;
    float* C; int ldc;
    __device__ __forceinline__ void operator()(const f32x4 (&acc)[2][2][4][2], const Unit& u, int wr, int wc, int fr, int fq) const {
        const int row0 = u.pm * BM + wr * 64 + fr, col0 = u.pn * BM + wc * 32 + 4 * fq;
#pragma unroll
        for (int ai = 0; ai < 2; ++ai)
#pragma unroll
            for (int m = 0; m < 4; ++m) { float* rowp = C + (size_t)(row0 + ai * HALF + m * 16) * ldc + col0;
#pragma unroll
                for (int bj = 0; bj < 2; ++bj)
#pragma unroll
                    for (int n = 0; n < 2; ++n) *(f32x4*)(rowp + bj * HALF + n * 16) = acc[ai][bj][m][n]; }
    }
};

struct EpiSwiGLU {
    static constexpr bool PERM = true, AFTER_DRAIN = false;
    bf16_t* hid; int nN;
    __device__ __forceinline__ void operator()(const f32x4 (&acc)[2][2][4][2], const Unit& un, int wr, int wc, int fr, int fq) const {
        const int row0 = un.pm * BM + wr * 64 + fr, pnl = un.pn % nN, col0 = pnl * HALF + wc * 32 + 8 * fq;
#pragma unroll
        for (int ai = 0; ai < 2; ++ai)
#pragma unroll
            for (int m = 0; m < 4; ++m) { bf16_t* rowp = hid + (size_t)(row0 + ai * HALF + m * 16) * 2816 + col0;
                f32x4 v0, v1;
#pragma unroll
                for (int j = 0; j < 4; ++j) { v0[j] = silu_f(acc[ai][0][m][0][j]) * acc[ai][1][m][0][j]; v1[j] = silu_f(acc[ai][0][m][1][j]) * acc[ai][1][m][1][j]; }
                store8(rowp, v0, v1); }
    }
};

struct EpiDown {
    static constexpr bool PERM = true, AFTER_DRAIN = false;
    bf16_t* y; int nN;
    __device__ __forceinline__ void operator()(const f32x4 (&acc)[2][2][4][2], const Unit& un, int wr, int wc, int fr, int fq) const {
        const int row0 = un.pm * BM + wr * 64 + fr, pnl = un.pn % nN, col0 = pnl * BM + wc * 32 + 8 * fq;
#pragma unroll
        for (int ai = 0; ai < 2; ++ai)
#pragma unroll
            for (int m = 0; m < 4; ++m) { bf16_t* rowp = y + (size_t)(row0 + ai * HALF + m * 16) * 1024 + col0;
#pragma unroll
                for (int bj = 0; bj < 2; ++bj) store8(rowp + bj * HALF, acc[ai][bj][m][0], acc[ai][bj][m][1]); }
    }
};

__device__ __forceinline__ unsigned pk4_fp8(float a, float b, float c, float d) { int w = __builtin_amdgcn_cvt_pk_fp8_f32(a, b, 0, false); w = __builtin_amdgcn_cvt_pk_fp8_f32(c, d, w, true); return (unsigned)w; }
__device__ __forceinline__ float clamp448(float x) { return __builtin_fminf(__builtin_fmaxf(x, -448.f), 448.f); }
struct EpiSwiGLU8 {
    static constexpr bool PERM = true, AFTER_DRAIN = false;
    unsigned char* hid; int nN; float inv_scale;
    __device__ __forceinline__ void operator()(const f32x4 (&acc)[2][2][4][2], const Unit& un, int wr, int wc, int fr, int fq) const {
        const int row0 = un.pm * BM + wr * 64 + fr, pnl = un.pn % nN, col0 = pnl * HALF + wc * 32 + 8 * fq;
        const float c1 = -inv_scale * 1.4426950408889634f, s2 = inv_scale * inv_scale;
#pragma unroll
        for (int ai = 0; ai < 2; ++ai)
#pragma unroll
            for (int m = 0; m < 4; ++m) { unsigned char* rowp = hid + (size_t)(row0 + ai * HALF + m * 16) * 2816 + col0;
                float v[8];
#pragma unroll
                for (int n = 0; n < 2; ++n)
#pragma unroll
                    for (int j = 0; j < 4; j += 2) { const f32x2 g = {acc[ai][0][m][n][j], acc[ai][0][m][n][j + 1]}, u = {acc[ai][1][m][n][j], acc[ai][1][m][n][j + 1]};
                        const f32x2 p = (g * u) * s2, x = g * c1; f32x2 d; d.x = __builtin_amdgcn_exp2f(x.x); d.y = __builtin_amdgcn_exp2f(x.y); d = d + 1.0f;
                        f32x2 r; r.x = __builtin_amdgcn_rcpf(d.x); r.y = __builtin_amdgcn_rcpf(d.y); const f32x2 o = p * r;
                        v[4 * n + j] = __builtin_amdgcn_fmed3f(o.x, -448.f, 448.f); v[4 * n + j + 1] = __builtin_amdgcn_fmed3f(o.y, -448.f, 448.f); }
                uint2 w; w.x = pk4_fp8(v[0], v[1], v[2], v[3]); w.y = pk4_fp8(v[4], v[5], v[6], v[7]); *(uint2*)rowp = w; }
    }
};
struct EpiDown8 {
    static constexpr bool PERM = true, AFTER_DRAIN = false;
    unsigned char* y; int nN; float inv_scale;
    __device__ __forceinline__ void operator()(const f32x4 (&acc)[2][2][4][2], const Unit& un, int wr, int wc, int fr, int fq) const {
        const int row0 = un.pm * BM + wr * 64 + fr, pnl = un.pn % nN, col0 = pnl * BM + wc * 32 + 8 * fq;
#pragma unroll
        for (int ai = 0; ai < 2; ++ai)
#pragma unroll
            for (int m = 0; m < 4; ++m) { unsigned char* rowp = y + (size_t)(row0 + ai * HALF + m * 16) * 1024 + col0;
#pragma unroll
                for (int bj = 0; bj < 2; ++bj) { const f32x4 v0 = acc[ai][bj][m][0] * inv_scale, v1 = acc[ai][bj][m][1] * inv_scale;
                    uint2 w; w.x = pk4_fp8(__builtin_amdgcn_fmed3f(v0[0], -448.f, 448.f), __builtin_amdgcn_fmed3f(v0[1], -448.f, 448.f), __builtin_amdgcn_fmed3f(v0[2], -448.f, 448.f), __builtin_amdgcn_fmed3f(v0[3], -448.f, 448.f));
                    w.y = pk4_fp8(__builtin_amdgcn_fmed3f(v1[0], -448.f, 448.f), __builtin_amdgcn_fmed3f(v1[1], -448.f, 448.f), __builtin_amdgcn_fmed3f(v1[2], -448.f, 448.f), __builtin_amdgcn_fmed3f(v1[3], -448.f, 448.f));
                    *(uint2*)(rowp + bj * HALF) = w; } }
    }
};
typedef int i32x8_t __attribute__((ext_vector_type(8)));
template <bool FP8> struct OperandT { typedef bf16x8 type; };
template <> struct OperandT<true> { typedef i32x8_t type; };
__device__ __forceinline__ void ld_bf16(bf16x8& d, const PG8_LAS unsigned char* p) { d = *(const PG8_LAS bf16x8*)p; }
__device__ __forceinline__ void ld_bf16(i32x8_t&, const PG8_LAS unsigned char*) {}
__device__ __forceinline__ void ld_fp8(i32x8_t& d, const PG8_LAS unsigned char* p) { const i32x4_t lo = *(const PG8_LAS i32x4_t*)p, hi = *(const PG8_LAS i32x4_t*)(p + 1024); d = __builtin_shufflevector(lo, hi, 0, 1, 2, 3, 4, 5, 6, 7); }
__device__ __forceinline__ void ld_fp8(bf16x8&, const PG8_LAS unsigned char*) {}
__device__ __forceinline__ f32x4 mma_bf16(const bf16x8& a, const bf16x8& b, const f32x4& c) { return __builtin_amdgcn_mfma_f32_16x16x32_bf16(a, b, c, 0, 0, 0); }
__device__ __forceinline__ f32x4 mma_bf16(const i32x8_t&, const i32x8_t&, const f32x4& c) { return c; }
__device__ __forceinline__ f32x4 mma_fp8(const i32x8_t& a, const i32x8_t& b, const f32x4& c) { f32x4 d = c; const int sc = 0x7f7f7f7f;
    asm volatile("v_mfma_scale_f32_16x16x128_f8f6f4 %0, %1, %2, %0, %3, %3 op_sel_hi:[0,0,0]" : "+v"(d) : "v"(a), "v"(b), "v"(sc)); return d; }
__device__ __forceinline__ f32x4 mma_fp8(const bf16x8&, const bf16x8&, const f32x4& c) { return c; }
template <class Epi, class Sched, bool ALIGN_EPI = false, bool SP2 = false, bool FP8 = false, bool GATHER = false, int PF = 0, bool BTM = false>
__device__ __forceinline__ void gemm_phase(PG8_LAS unsigned char* lds, const Gemm g, const Sched& S, const Epi& E) {
    const int tid = threadIdx.x, wid = __builtin_amdgcn_readfirstlane(tid >> 6), lane = tid & 63, wr = wid >> 2, wc = wid & 3, fr = lane & 15, fq = lane >> 4;
    const int K = g.K, nt = K / BK;
    unsigned voffA[2], voffB[2];
#pragma unroll
    for (int i = 0; i < 2; ++i) { int R, C; stage_rc(tid * 16 + i * 8192, R, C); const int Rb = Epi::PERM ? ((R & ~31) + perm32(R & 31)) : R;
        voffA[i] = (unsigned)(R * K + C) * 2u; voffB[i] = BTM ? (unsigned)(Rb * BK + C) * 2u : (unsigned)(Rb * K + C) * 2u; }
    const size_t kstep = (size_t)(BK * 2);
    const size_t hstep = (size_t)HALF * K * 2;
    const size_t kstepB = BTM ? (size_t)BM * BK * 2 : kstep, hstepB = BTM ? (size_t)HALF * BK * 2 : hstep;
    const size_t tstep = 2 * hstep;
    const unsigned ldsw = (unsigned)wid * 1024u;
    const int aoff = lds_byte(wr * 64 + fr, fq * 8), boff = lds_byte(wc * 32 + fr, fq * 8);
#define PG8_SA(b, h) (((b) * 2 + (h)) * HTB)
#define PG8_SB(b, h) ((4 + (b) * 2 + (h)) * HTB)
#define PG8_STAGE(bufoff, gbase, voff) do { _Pragma("unroll") for (int _i = 0; _i < 2; ++_i) \
        __builtin_amdgcn_global_load_lds((const unsigned*)((const char*)(gbase) + (voff)[_i]), (PG8_LAS unsigned*)(lds + (bufoff) + ldsw + _i * 8192), 16, 0, 0); } while (0)
#define PG8_STAGE_A(bufoff, gbase, h, usenext) do { if constexpr (GATHER) { _Pragma("unroll") for (int _i = 0; _i < 2; ++_i) \
        __builtin_amdgcn_global_load_lds((const unsigned*)((const char*)(gbase) + ((usenext) ? vgn[h][_i] : vgc[h][_i])), (PG8_LAS unsigned*)(lds + (bufoff) + ldsw + _i * 8192), 16, 0, 0); } \
    else { PG8_STAGE(bufoff, (gbase) + ((h) ? hstep : 0), voffA); } } while (0)
#define PG8_LD2(base) PG8_CAT(*(const PG8_LAS i32x4_t*)(base), *(const PG8_LAS i32x4_t*)((base) + 1024))
#define PG8_LDA(dst, b, h) do { _Pragma("unroll") for (int m = 0; m < 4; ++m) { if constexpr (FP8) { ld_fp8(dst[m][0], lds + PG8_SA(b, h) + aoff + m * 2048); } else { _Pragma("unroll") for (int k = 0; k < (FP8 ? 1 : 2); ++k) ld_bf16(dst[m][k], lds + PG8_SA(b, h) + aoff + m * 2048 + k * 1024); } } } while (0)
#define PG8_LDB(dst, b, h) do { _Pragma("unroll") for (int n = 0; n < 2; ++n) { if constexpr (FP8) { ld_fp8(dst[n][0], lds + PG8_SB(b, h) + boff + n * 2048); } else { _Pragma("unroll") for (int k = 0; k < (FP8 ? 1 : 2); ++k) ld_bf16(dst[n][k], lds + PG8_SB(b, h) + boff + n * 2048 + k * 1024); } } } while (0)
#define PG8_MMA(ai, bj, At, Bt) do { __builtin_amdgcn_s_setprio(1); _Pragma("unroll") for (int m = 0; m < 4; ++m) _Pragma("unroll") for (int n = 0; n < 2; ++n) { \
        if constexpr (FP8) { acc[ai][bj][m][n] = mma_fp8(Bt[n][0], At[m][0], acc[ai][bj][m][n]); } \
        else { _Pragma("unroll") for (int k = 0; k < (FP8 ? 1 : 2); ++k) acc[ai][bj][m][n] = mma_bf16(Bt[n][k], At[m][k], acc[ai][bj][m][n]); } } __builtin_amdgcn_s_setprio(0); } while (0)
#define PG8_WAIT_V(n) asm volatile("s_waitcnt vmcnt(" #n ")" ::: "memory")
#define PG8_WAIT_L(n) asm volatile("s_waitcnt lgkmcnt(" #n ")" ::: "memory")
#define PG8_BAR __builtin_amdgcn_s_barrier()
#define PG8_SCHED __builtin_amdgcn_sched_barrier(0)
    Unit cur, nxt; int ui = 0;
    if (!S.next(0, cur)) return;
    f32x4 acc[2][2][4][2];
#pragma unroll
    for (int a = 0; a < 2; ++a)
#pragma unroll
        for (int b = 0; b < 2; ++b)
#pragma unroll
            for (int m = 0; m < 4; ++m)
#pragma unroll
                for (int n = 0; n < 2; ++n) acc[a][b][m][n] = (f32x4){0.f, 0.f, 0.f, 0.f};
    typename OperandT<FP8>::type At[4][FP8 ? 1 : 2], B0[2][FP8 ? 1 : 2], B1[2][FP8 ? 1 : 2];
    const char* cA = GATHER ? (const char*)g.A : (const char*)g.A + (size_t)cur.pm * tstep; const char* cB = (const char*)g.Bt + (size_t)cur.pn * tstep;
    unsigned vgc[2][2], vgn[2][2]; int stR[2], stC[2];
#pragma unroll
    for (int i = 0; i < 2; ++i) { stage_rc(tid * 16 + i * 8192, stR[i], stC[i]); }
    constexpr int RM_MAXU = 12; PG8_LAS int* rml = (PG8_LAS int*)(lds + STAGE_BYTES);
    if constexpr (GATHER) { Unit uu;
        for (int i = 0; i < RM_MAXU && S.next(i, uu); ++i) { if (tid < BM) rml[i * BM + tid] = g.rowmap[uu.pm * BM + tid]; }
        asm volatile("s_waitcnt vmcnt(0) lgkmcnt(0)" ::: "memory"); __builtin_amdgcn_s_barrier(); asm volatile("" ::: "memory"); }
#define PG8_GOFF(dst, uidx, pmv) do { _Pragma("unroll") for (int _h = 0; _h < 2; ++_h) _Pragma("unroll") for (int _i = 0; _i < 2; ++_i) { \
        const int _r = _h * HALF + stR[_i]; const int _row = !GATHER ? 0 : rml[(uidx) * BM + _r]; \
        dst[_h][_i] = ((unsigned)_row * (unsigned)K + (unsigned)stC[_i]) * 2u; } } while (0)
    PG8_GOFF(vgc, 0, cur.pm);
    static_assert(PF == 0 || SP2, "the L2 prefetch is wired into the super-phase loop only");
    const size_t rowb = (size_t)K * 2;
#define PG8_PFBASE(un, uidx) ((tid < BM) ? (GATHER ? (unsigned)rml[(GATHER ? (uidx) : 0) * BM + (tid & (BM - 1))] * (unsigned)rowb : ((unsigned)(un).pm * BM + tid) * (unsigned)rowb) \
                                         : ((unsigned)(un).pn * BM + (tid - BM)) * (unsigned)rowb)
    unsigned pfc = PF ? PG8_PFBASE(cur, 0) : 0u; unsigned pfn = pfc;
#define PG8_PREFETCH(tt) do { if constexpr (PF > 0) { const int _tt = (tt); const bool _in = _tt < nt; const char* _b = (tid < BM) ? (const char*)g.A : (const char*)g.Bt; \
        const char* _p = (_in || !has_next) ? _b + pfc + (size_t)(_in ? _tt : 0) * kstep : _b + pfn + (size_t)(_tt - nt) * kstep; \
        __builtin_amdgcn_global_load_lds((const unsigned*)_p, (PG8_LAS unsigned*)(lds + STAGE_BYTES + 12032), 4, 0, 0); } } while (0)
#define PG8_WAIT_VL() do { if constexpr (PF > 0) PG8_WAIT_V(9); else PG8_WAIT_V(8); } while (0)
#pragma unroll
    for (int h_ = 0; h_ < 2; ++h_) { vgn[h_][0] = vgc[h_][0]; vgn[h_][1] = vgc[h_][1]; }
    S.a_ready(cur);
    if constexpr (SP2) {
        PG8_STAGE(PG8_SB(0, 0), cB, voffB); PG8_STAGE(PG8_SB(0, 1), cB + hstepB, voffB); PG8_STAGE_A(PG8_SA(0, 0), cA, 0, false); PG8_STAGE_A(PG8_SA(0, 1), cA, 1, false);
        if (wr == 1) PG8_BAR;
        PG8_WAIT_V(2); PG8_BAR;
        PG8_STAGE(PG8_SB(1, 0), cB + kstepB, voffB); PG8_STAGE_A(PG8_SA(1, 0), cA + kstep, 0, false); PG8_STAGE(PG8_SB(1, 1), cB + hstepB + kstepB, voffB);
        PG8_WAIT_V(6); PG8_BAR;
    } else {
        PG8_STAGE(PG8_SB(0, 0), cB, voffB); PG8_STAGE_A(PG8_SA(0, 0), cA, 0, false); PG8_STAGE(PG8_SB(0, 1), cB + hstepB, voffB); PG8_STAGE_A(PG8_SA(0, 1), cA, 1, false);
        if (wr == 1) PG8_BAR;
        PG8_WAIT_V(4); PG8_BAR;
        PG8_STAGE(PG8_SB(1, 0), cB + kstepB, voffB); PG8_STAGE_A(PG8_SA(1, 0), cA + kstep, 0, false); PG8_STAGE(PG8_SB(1, 1), cB + hstepB + kstepB, voffB);
        PG8_WAIT_V(6); PG8_BAR;
    }
    for (;;) {
        const bool has_next = S.next(ui + 1, nxt);
        if constexpr (GATHER) { if (has_next) PG8_GOFF(vgn, ui + 1, nxt.pm); }
        if constexpr (PF > 0) { if (has_next) pfn = PG8_PFBASE(nxt, ui + 1); }
        const char* nA = (has_next && !GATHER) ? (const char*)g.A + (size_t)nxt.pm * tstep : cA; const char* nB = has_next ? (const char*)g.Bt + (size_t)nxt.pn * tstep : cB;
#pragma unroll 1
        for (int t = 0; t < nt; t += 2) {
            const bool last = (t == nt - 2);
            const char* a1 = cA + (size_t)(t + 1) * kstep;
            const char* a2 = last ? nA : cA + (size_t)(t + 2) * kstep; const char* b2 = last ? nB : cB + (size_t)(t + 2) * kstepB;
            const char* a3 = a2 + kstep; const char* b3 = b2 + kstepB;
            if (last && has_next) S.a_ready(nxt);
            if constexpr (SP2) {
            PG8_LDB(B0, 0, 0); PG8_LDB(B1, 0, 1); PG8_SCHED; PG8_LDA(At, 0, 0); PG8_STAGE_A(PG8_SA(1, 1), a1, 1, false); PG8_PREFETCH(t + PF);
            PG8_WAIT_VL(); PG8_WAIT_L(0); PG8_BAR; PG8_MMA(0, 0, At, B0); PG8_MMA(0, 1, At, B1); PG8_BAR; PG8_SCHED;
            PG8_LDA(At, 0, 1); PG8_STAGE(PG8_SB(0, 0), b2, voffB); PG8_STAGE(PG8_SB(0, 1), b2 + hstepB, voffB); PG8_STAGE_A(PG8_SA(0, 0), a2, 0, last);
            PG8_WAIT_VL(); PG8_WAIT_L(0); PG8_BAR; PG8_MMA(1, 0, At, B0); PG8_MMA(1, 1, At, B1); PG8_BAR; PG8_SCHED;
            PG8_LDB(B0, 1, 0); PG8_LDB(B1, 1, 1); PG8_SCHED; PG8_LDA(At, 1, 0); PG8_STAGE_A(PG8_SA(0, 1), a2, 1, last); PG8_PREFETCH(t + 1 + PF);
            PG8_WAIT_VL(); PG8_WAIT_L(0); PG8_BAR; PG8_MMA(0, 0, At, B0); PG8_MMA(0, 1, At, B1); PG8_BAR; PG8_SCHED;
            PG8_LDA(At, 1, 1); PG8_STAGE(PG8_SB(1, 0), b3, voffB); PG8_STAGE(PG8_SB(1, 1), b3 + hstepB, voffB); PG8_STAGE_A(PG8_SA(1, 0), a3, 0, last);
            PG8_WAIT_VL(); PG8_WAIT_L(0); PG8_BAR; PG8_MMA(1, 0, At, B0); PG8_MMA(1, 1, At, B1); PG8_BAR; PG8_SCHED;
            } else {
            PG8_LDB(B0, 0, 0); PG8_SCHED; PG8_LDA(At, 0, 0); PG8_STAGE_A(PG8_SA(1, 1), a1, 1, false);
            PG8_WAIT_L(8); PG8_BAR; PG8_WAIT_L(0); PG8_MMA(0, 0, At, B0); PG8_BAR; PG8_SCHED;
            PG8_LDB(B1, 0, 1); PG8_STAGE(PG8_SB(0, 0), b2, voffB);
            PG8_BAR; PG8_WAIT_L(0); PG8_MMA(0, 1, At, B1); PG8_BAR;
            PG8_LDA(At, 0, 1); PG8_STAGE_A(PG8_SA(0, 0), a2, 0, last);
            PG8_BAR; PG8_WAIT_L(0); PG8_MMA(1, 0, At, B0); PG8_BAR; PG8_SCHED;
            PG8_STAGE(PG8_SB(0, 1), b2 + hstepB, voffB);
            PG8_WAIT_V(6); PG8_BAR; PG8_MMA(1, 1, At, B1); PG8_BAR;
            PG8_LDB(B0, 1, 0); PG8_SCHED; PG8_LDA(At, 1, 0); PG8_STAGE_A(PG8_SA(0, 1), a2, 1, last);
            PG8_WAIT_L(8); PG8_BAR; PG8_WAIT_L(0); PG8_MMA(0, 0, At, B0); PG8_BAR; PG8_SCHED;
            PG8_LDB(B1, 1, 1); PG8_STAGE(PG8_SB(1, 0), b3, voffB);
            PG8_BAR; PG8_WAIT_L(0); PG8_MMA(0, 1, At, B1); PG8_BAR;
            PG8_LDA(At, 1, 1); PG8_STAGE_A(PG8_SA(1, 0), a3, 0, last);
            PG8_BAR; PG8_WAIT_L(0); PG8_MMA(1, 0, At, B0); PG8_BAR; PG8_SCHED;
            PG8_STAGE(PG8_SB(1, 1), b3 + hstepB, voffB);
            PG8_WAIT_V(6); PG8_BAR; PG8_MMA(1, 1, At, B1); PG8_BAR;
            }
        }
        if constexpr (FP8) { asm volatile("s_nop 15\n\ts_nop 15" ::: "memory"); }
        if constexpr (ALIGN_EPI) { if (wr == 0) PG8_BAR; }
        if constexpr (!Epi::AFTER_DRAIN) { E(acc, cur, wr, wc, fr, fq); S.done(cur); }
        if (!has_next) break;
#pragma unroll
        for (int a = 0; a < 2; ++a)
#pragma unroll
            for (int b = 0; b < 2; ++b)
#pragma unroll
                for (int m = 0; m < 4; ++m)
#pragma unroll
                    for (int n = 0; n < 2; ++n) acc[a][b][m][n] = (f32x4){0.f, 0.f, 0.f, 0.f};
        cur = nxt; cA = nA; cB = nB; ++ui; pfc = pfn;
        if constexpr (GATHER) {
#pragma unroll
            for (int h_ = 0; h_ < 2; ++h_) { vgc[h_][0] = vgn[h_][0]; vgc[h_][1] = vgn[h_][1]; } }
        if constexpr (ALIGN_EPI) { if (wr == 1) PG8_BAR; }
    }
    PG8_WAIT_V(0);
    if constexpr (!ALIGN_EPI) { if (wr == 0) PG8_BAR; }
    PG8_BAR;
    if constexpr (Epi::AFTER_DRAIN) { E.fused(acc, cur, wr, wc, fr, fq, lds, wid, lane); S.done(cur); }
#undef PG8_SA
#undef PG8_SB
#undef PG8_STAGE
#undef PG8_STAGE_A
#undef PG8_GOFF
#undef PG8_PFBASE
#undef PG8_PREFETCH
#undef PG8_WAIT_VL
#undef PG8_LDA
#undef PG8_LDB
#undef PG8_MMA
#undef PG8_LD2
#undef PG8_WAIT_V
#undef PG8_WAIT_L
#undef PG8_BAR
#undef PG8_SCHED
}
}
#define GAS __attribute__((address_space(1)))
#define LAS __attribute__((address_space(3)))
typedef unsigned short bf16;
typedef unsigned v4u __attribute__((ext_vector_type(4)));
typedef float f32x4 __attribute__((ext_vector_type(4)));
typedef short bf16x8 __attribute__((ext_vector_type(8)));
typedef GAS unsigned gu32;
typedef GAS unsigned long long gu64;
#define RLX_AGENT __ATOMIC_RELAXED, __HIP_MEMORY_SCOPE_AGENT
#define LDS_WAIT() asm volatile("s_waitcnt lgkmcnt(0)" ::: "memory")
#define VM_WAIT() asm volatile("s_waitcnt vmcnt(0)" ::: "memory")
__device__ __forceinline__ unsigned long long rt() { return __builtin_amdgcn_s_memrealtime(); }
__device__ __forceinline__ unsigned f2bf(float f) { unsigned u = __builtin_bit_cast(unsigned, f); return (u + 0x7fffu + ((u >> 16) & 1u)) >> 16; }
__device__ __forceinline__ unsigned pk2(float lo, float hi) { return f2bf(lo) | (f2bf(hi) << 16); }

#define XB_TMO      128
#define XB_XCNT(j)  (256  + 64 * (j))
#define XB_XSUB(j)  (1280 + 64 * (j))
#define XB_XGEN(j)  (2304 + 64 * (j))
#define XB_TOP      3328
#define XB_TOPGEN   3392
#define XCD_BAR_WORDS 3456
#define XB_SPIN_CAP (1u << 18)

__device__ __forceinline__ unsigned xb_ld(unsigned* p)              { return __hip_atomic_load(p, __ATOMIC_RELAXED, __HIP_MEMORY_SCOPE_AGENT); }
__device__ __forceinline__ unsigned xb_add(unsigned* p, unsigned v) { return __hip_atomic_fetch_add(p, v, __ATOMIC_RELAXED, __HIP_MEMORY_SCOPE_AGENT); }
__device__ __forceinline__ unsigned xb_xcc_id() { return (unsigned)__builtin_amdgcn_s_getreg((3 << 11) | 20) & 0xFu; }
#define XB_SPIN(cond, bar) do { unsigned _sp = 0; while (cond) { __builtin_amdgcn_s_sleep(1); \
    if ((++_sp & 255u) == 0u) { if (xb_ld(&(bar)[XB_TMO])) break; if (_sp > XB_SPIN_CAP) { atomicAdd(&(bar)[XB_TMO], 1u); break; } } } } while (0)

struct XcdBarrier {
    unsigned* bar; unsigned x;
    volatile LAS unsigned* st;
};

__device__ __forceinline__ XcdBarrier xcd_barrier_post(unsigned* bar, volatile LAS unsigned* st) {
    XcdBarrier b; b.bar = bar; b.x = xb_xcc_id(); b.st = st;
    if (threadIdx.x == 0) (void)xb_add(&bar[XB_XCNT(b.x)], 1u);
    return b;
}
__device__ __forceinline__ void xcd_barrier_complete(unsigned* bar, unsigned x, unsigned& nloc, unsigned& nx) {
    const unsigned G = gridDim.x * gridDim.y * gridDim.z;
    unsigned sum, cnt, mine, sp = 0u;
    for (;;) {
        sum = 0u; cnt = 0u; mine = 0u;
#pragma unroll
        for (unsigned j = 0; j < 16; ++j) { const unsigned c = xb_ld(&bar[XB_XCNT(j)]); sum += c; cnt += (c > 0u) ? 1u : 0u; mine = (j == x) ? c : mine; }
        if (sum == G) break;
        __builtin_amdgcn_s_sleep(1);
        if ((++sp & 255u) == 0u) { if (xb_ld(&bar[XB_TMO])) break; if (sp > XB_SPIN_CAP) { atomicAdd(&bar[XB_TMO], 1u); break; } }
    }
    nloc = mine > 0u ? mine : 1u; nx = cnt > 0u ? cnt : 1u;
}

__device__ __forceinline__ void xcd_barrier(const XcdBarrier& b) {
    asm volatile("s_waitcnt vmcnt(0)" ::: "memory");
    __syncthreads();
    if (threadIdx.x == 0) {
        unsigned* bar = b.bar;
        __builtin_amdgcn_s_waitcnt(0);
        unsigned nloc = b.st[0], nx = b.st[1];
        if (nloc == 0u) { xcd_barrier_complete(bar, b.x, nloc, nx); b.st[0] = nloc; b.st[1] = nx; }
        const unsigned old = xb_add(&bar[XB_XSUB(b.x)], 1u);
        const unsigned gen = old / nloc;
        if (old + 1u == (gen + 1u) * nloc) {
            __builtin_amdgcn_fence(__ATOMIC_RELEASE, "agent");
            asm volatile("s_waitcnt vmcnt(0)" ::: "memory");
            const unsigned og = xb_add(&bar[XB_TOP], 1u);
            const unsigned tg = og / nx;
            if (og + 1u == (tg + 1u) * nx) xb_add(&bar[XB_TOPGEN], 1u);
            else XB_SPIN(xb_ld(&bar[XB_TOPGEN]) == tg, bar);
            __builtin_amdgcn_fence(__ATOMIC_ACQUIRE, "agent");
            xb_add(&bar[XB_XGEN(b.x)], 1u);
            asm volatile("s_waitcnt vmcnt(0)" ::: "memory");
        } else {
            XB_SPIN(xb_ld(&bar[XB_XGEN(b.x)]) == gen, bar);
            __builtin_amdgcn_fence(__ATOMIC_ACQUIRE, "agent");
            asm volatile("s_waitcnt vmcnt(0)" ::: "memory");
        }
    }
    __syncthreads();
}

constexpr int NWAVES = 8;
constexpr int BATCH = 2, SEQ = 8192, DM = 1024, NTOK = BATCH * SEQ;
constexpr int D_IN = 1792, D_FF = 2816, NEXP = 16, CAP = 1024;
constexpr int NROWS_E = NEXP * BATCH * CAP;
constexpr float EPS = 1e-6f;
constexpr int KS_ADA = 16;
#ifndef PF_DIST
#define PF_DIST 0
#ifndef P10_MODE
#define P10_MODE 0
#endif
#endif
constexpr float Y8_SCALE = 16.f;
constexpr float W8_SCALE = 64.f, W8_INV = 1.f / 64.f;

constexpr size_t MiB = 1u << 20;
constexpr size_t WS_CTL = 0, CTL_ZERO_BYTES = 32768;
constexpr size_t WS_MODP = 1 * MiB;
constexpr size_t WS_AFF = 2 * MiB;
constexpr size_t WS_SLOTS = 3 * MiB;
constexpr size_t WS_IDX = 4 * MiB;
constexpr size_t WS_GATES = 4 * MiB + 128 * 1024;
constexpr size_t WS_WSB = 4 * MiB + 256 * 1024;
constexpr size_t WS_VSTAT = 11 * MiB;
constexpr size_t WS_WINT = 5 * MiB;
constexpr size_t WS_WOUTT = 9 * MiB;
constexpr size_t WS_WGUT = 12 * MiB;
constexpr size_t WS_WDT = 188 * MiB;
constexpr size_t WS_H = 276 * MiB;
constexpr size_t WS_YROWS = 308 * MiB;
constexpr size_t WS_HID = 372 * MiB;
constexpr size_t WS_Q = 372 * MiB;
constexpr size_t WS_K = 388 * MiB;
constexpr size_t WS_VT = 392 * MiB;
constexpr size_t WS_U = 396 * MiB;
constexpr size_t WS_VGT = 412 * MiB;
constexpr size_t WS_MIX = 428 * MiB;
constexpr size_t WS_T = 460 * MiB;
constexpr size_t WS_XS = 548 * MiB;
constexpr size_t WS_X1 = 612 * MiB;
constexpr size_t WS_END = 676 * MiB;
constexpr int CW_BAR = 4096;
constexpr int CW_P0CNT = 128;

constexpr int RING_OFF = 0, RING_BYTES = 131072;
constexpr int LDSCTL_OFF = 143360, MISC_OFF = LDSCTL_OFF + 320;
constexpr int LDS_BYTES = 147456;

struct Frame {
    LAS unsigned char* lds;
    volatile LAS unsigned* MISC;
    gu32* ctl;
    int tid, lane, wave;
    int vcu, G;
    const float* in[21];
    float* out;
    unsigned char* ws;
};
#define IN_X 0
#define IN_C 1
#define IN_WADA 2
#define IN_BADA 3
#define IN_NPREMIX 4
#define IN_NPOSTMIX 5
#define IN_WIN 6
#define IN_SINK 7
#define IN_LNG 8
#define IN_LNB 9
#define IN_WS 10
#define IN_BS 11
#define IN_NOATTN 12
#define IN_NOGMLP 13
#define IN_WOUT 14
#define IN_NPREFFN 15
#define IN_NPOSTFFN 16
#define IN_WROUTER 17
#define IN_WGATE 18
#define IN_WUP 19
#define IN_WDOWN 20

#define DPP_ADDF(v, ctrl, rmask) (v) += __builtin_bit_cast(float, __builtin_amdgcn_update_dpp(0, __builtin_bit_cast(int, (v)), (ctrl), (rmask), 0xf, true))
__device__ __forceinline__ float wave_sum(float v) {
    DPP_ADDF(v, 0xB1, 0xf); DPP_ADDF(v, 0x4E, 0xf); DPP_ADDF(v, 0x141, 0xf); DPP_ADDF(v, 0x140, 0xf); DPP_ADDF(v, 0x142, 0xa); DPP_ADDF(v, 0x143, 0xc);
    return __builtin_bit_cast(float, __builtin_amdgcn_readlane(__builtin_bit_cast(int, v), 63));
}
#define DPP_MAXF(v, ctrl, rmask) (v) = fmaxf((v), __builtin_bit_cast(float, __builtin_amdgcn_update_dpp(__builtin_bit_cast(int, (v)), __builtin_bit_cast(int, (v)), (ctrl), (rmask), 0xf, false)))
__device__ __forceinline__ float wave_max(float v) {
    DPP_MAXF(v, 0xB1, 0xf); DPP_MAXF(v, 0x4E, 0xf); DPP_MAXF(v, 0x141, 0xf); DPP_MAXF(v, 0x140, 0xf); DPP_MAXF(v, 0x142, 0xa); DPP_MAXF(v, 0x143, 0xc);
    return __builtin_bit_cast(float, __builtin_amdgcn_readlane(__builtin_bit_cast(int, v), 63));
}
__device__ __forceinline__ float bf2f(unsigned short b) { return __uint_as_float((unsigned)b << 16); }
__device__ __forceinline__ float bflo(unsigned u) { return __uint_as_float(u << 16); }
__device__ __forceinline__ float bfhi(unsigned u) { return __uint_as_float(u & 0xffff0000u); }

__device__ __forceinline__ void transpose_item(const float* W, int N, int k0, int n0, bf16* WT, int ldt, int dest_row0, LAS float* scr, int lane) {
#pragma unroll 8
    for (int i = 0; i < 32; ++i) { const int kk = 2 * i + (lane >> 5); scr[kk * 33 + (lane & 31)] = W[(size_t)(k0 + kk) * N + n0 + (lane & 31)]; }
    LDS_WAIT(); asm volatile("" ::: "memory");
    const int c = lane & 7;
#pragma unroll
    for (int j = 0; j < 4; ++j) { const int n = (lane >> 3) + 8 * j; const LAS float* s = scr + (8 * c) * 33 + n;
        v4u o; o.x = pk2(s[0 * 33], s[1 * 33]); o.y = pk2(s[2 * 33], s[3 * 33]); o.z = pk2(s[4 * 33], s[5 * 33]); o.w = pk2(s[6 * 33], s[7 * 33]);
        *(GAS v4u*)(WT + (size_t)(dest_row0 + n) * ldt + k0 + 8 * c) = o; }
    LDS_WAIT(); asm volatile("" ::: "memory");
}

constexpr int XI_PER_MAT = (DM / 128) * (D_FF / 32);
constexpr int XI_TOTAL = NEXP * 3 * XI_PER_MAT;
struct XItem { const float* src; unsigned char* dst; int N, ldt; };
__device__ __forceinline__ XItem xitem_decode(Frame& F, int it) {
    const int e = it / (3 * XI_PER_MAT), r = it % (3 * XI_PER_MAT), ty = r / XI_PER_MAT, r3 = r % XI_PER_MAT; XItem d;
    if (ty < 2) { const int kb = r3 / (D_FF / 32), n0 = 32 * (r3 % (D_FF / 32)), k0 = 128 * kb;
        d.N = D_FF; d.ldt = DM; d.src = (ty ? F.in[IN_WUP] : F.in[IN_WGATE]) + (size_t)e * DM * D_FF + (size_t)k0 * D_FF + n0;
        d.ldt = 128; d.dst = (unsigned char*)(F.ws + WS_WGUT) + (size_t)e * (2 * D_FF) * DM + ((size_t)((n0 >> 7) * (DM / 128) + kb) * 256 + ty * 128 + (n0 & 127)) * 128; }
    else { const int kb = r3 / (DM / 32), n0 = 32 * (r3 % (DM / 32)), k0 = 128 * kb;
        d.N = DM; d.ldt = D_FF; d.src = F.in[IN_WDOWN] + (size_t)e * D_FF * DM + (size_t)k0 * DM + n0;
        d.ldt = 128; d.dst = (unsigned char*)(F.ws + WS_WDT) + (size_t)e * DM * D_FF + ((size_t)((n0 >> 8) * (D_FF / 128) + kb) * 256 + (n0 & 255)) * 128; }
    return d;
}
__device__ __forceinline__ void xitem_load(const XItem& d, f32x4 (&r)[16], int lane) {
    const float* p = d.src + (size_t)(lane >> 3) * d.N + 4 * (lane & 7);
#pragma unroll
    for (int i = 0; i < 16; ++i) r[i] = __builtin_nontemporal_load((const f32x4*)(p + (size_t)(8 * i) * d.N));
}
__device__ __forceinline__ void xitem_finish(const XItem& d, const f32x4 (&r)[16], LAS float* scr, int lane) {
    LAS float* w = scr + (lane >> 3) * 33 + 4 * (lane & 7);
#pragma unroll
    for (int i = 0; i < 16; ++i) { const f32x4 v = r[i] * W8_SCALE; w[i * 264] = v.x; w[i * 264 + 1] = v.y; w[i * 264 + 2] = v.z; w[i * 264 + 3] = v.w; }
    LDS_WAIT(); asm volatile("" ::: "memory");
    const int c = lane & 7;
#pragma unroll
    for (int j = 0; j < 4; ++j) { const int n = (lane >> 3) + 8 * j; const LAS float* s = scr + (16 * c) * 33 + n;
        v4u o;
        o.x = pg8::pk4_fp8(s[0 * 33], s[1 * 33], s[2 * 33], s[3 * 33]);
        o.y = pg8::pk4_fp8(s[4 * 33], s[5 * 33], s[6 * 33], s[7 * 33]);
        o.z = pg8::pk4_fp8(s[8 * 33], s[9 * 33], s[10 * 33], s[11 * 33]);
        o.w = pg8::pk4_fp8(s[12 * 33], s[13 * 33], s[14 * 33], s[15 * 33]);
        __builtin_nontemporal_store(o, (v4u*)(d.dst + (size_t)n * d.ldt + 16 * c)); }
    LDS_WAIT(); asm volatile("" ::: "memory");
}
constexpr int XI_R0 = 24576, XI_R1 = 27648, P6_CONV = 192;
__device__ __forceinline__ void p0_expert_items(Frame& F, int first, int end, int widx, int nworkers) {
    LAS float* scr = (LAS float*)(F.lds + F.wave * 16896);
    const int lane = F.lane;
    const int it0 = first + widx; if (it0 >= end) return;
    const int n = (end - it0 + nworkers - 1) / nworkers;
    f32x4 rA[16], rB[16]; XItem dA = xitem_decode(F, it0), dB; xitem_load(dA, rA, lane);
    int j = 1;
#pragma unroll 1
    for (; j + 1 < n; j += 2) {
        dB = xitem_decode(F, it0 + j * nworkers); xitem_load(dB, rB, lane); __builtin_amdgcn_sched_barrier(0);
        xitem_finish(dA, rA, scr, lane); __builtin_amdgcn_sched_barrier(0);
        dA = xitem_decode(F, it0 + (j + 1) * nworkers); xitem_load(dA, rA, lane); __builtin_amdgcn_sched_barrier(0);
        xitem_finish(dB, rB, scr, lane); __builtin_amdgcn_sched_barrier(0);
    }
    if (j < n) { dB = xitem_decode(F, it0 + j * nworkers); xitem_load(dB, rB, lane); xitem_finish(dA, rA, scr, lane); xitem_finish(dB, rB, scr, lane); }
    else xitem_finish(dA, rA, scr, lane);
}

__device__ __forceinline__ void p0_prologue(Frame& F) {
    LAS float* scr = (LAS float*)(F.lds + F.wave * 16896);
    const int gw = F.vcu * NWAVES + F.wave, NGW = F.G * NWAVES, lane = F.lane;
    {
        const float* c = F.in[IN_C]; const float* W = F.in[IN_WADA]; float* modp = (float*)(F.ws + WS_MODP);
        constexpr int KPS = DM / KS_ADA;
        for (int it = gw; it < 96 * KS_ADA; it += NGW) {
            const int cg = it % 96, ks = it / 96, col = cg * 64 + lane;
            float a0 = 0.f, a1 = 0.f;
#pragma unroll 16
            for (int kk = 0; kk < KPS; ++kk) { const int k = ks * KPS + kk; const float w = W[(size_t)k * 6144 + col];
                const float c0 = c[k], c1 = c[DM + k];
                a0 += (c0 / (1.f + __expf(-c0))) * w; a1 += (c1 / (1.f + __expf(-c1))) * w; }
            __hip_atomic_store(modp + (size_t)(ks * 2 + 0) * 6144 + col, a0, __ATOMIC_RELAXED, __HIP_MEMORY_SCOPE_AGENT);
            __hip_atomic_store(modp + (size_t)(ks * 2 + 1) * 6144 + col, a1, __ATOMIC_RELAXED, __HIP_MEMORY_SCOPE_AGENT);
        }
        asm volatile("s_waitcnt vmcnt(0)" ::: "memory");
        if (lane == 0) __hip_atomic_fetch_add((unsigned*)(F.ctl + CW_P0CNT), 1u, __ATOMIC_RELAXED, __HIP_MEMORY_SCOPE_AGENT);
    }
    {
        const float* wsf = F.in[IN_WS]; bf16* wsb = (bf16*)(F.ws + WS_WSB);
        for (int o = gw * 64 + lane; o < 8 * 8 * 4 * 64; o += NGW * 64) { const int ln = o & 63, tb = (o >> 6) & 3, ks = (o >> 8) & 7, g = o >> 11, r32 = ln & 31, hi = ln >> 5;
            const float* src = wsf + (size_t)(g * 128 + 32 * tb + r32) * 128 + 16 * ks + 8 * hi; const f32x4 v0 = *(const f32x4*)src, v1 = *(const f32x4*)(src + 4);
            v4u pk; pk.x = pk2(v0.x, v0.y); pk.y = pk2(v0.z, v0.w); pk.z = pk2(v1.x, v1.y); pk.w = pk2(v1.z, v1.w); *(v4u*)(wsb + (size_t)o * 8) = pk; }
    }
    constexpr int I_IN = (DM / 64) * (D_IN / 32), I_OUT = (DM / 64) * (DM / 32);
    for (int it = gw; it < I_IN + I_OUT; it += NGW) {
        int r = it;
        if (r < I_IN) { const int nb = D_IN / 32, kb = r / nb, n0 = 32 * (r % nb); transpose_item(F.in[IN_WIN], D_IN, 64 * kb, n0, (bf16*)(F.ws + WS_WINT), DM, n0, scr, lane); continue; } r -= I_IN;
        { const int nb = DM / 32, kb = r / nb, n0 = 32 * (r % nb); transpose_item(F.in[IN_WOUT], DM, 64 * kb, n0, (bf16*)(F.ws + WS_WOUTT), DM, n0, scr, lane); }
    }
    p0_expert_items(F, 0, XI_R0, gw, NGW);
}
__device__ __forceinline__ void p0_wait_published(Frame& F) {
    if (F.wave == 0) { const unsigned want = (unsigned)(F.G * NWAVES); unsigned sp = 0;
        while ((unsigned)__builtin_amdgcn_readfirstlane((int)__hip_atomic_load((unsigned*)(F.ctl + CW_P0CNT), __ATOMIC_RELAXED, __HIP_MEMORY_SCOPE_AGENT)) < want) { __builtin_amdgcn_s_sleep(2); if (++sp > (1u << 22)) break; }
        __builtin_amdgcn_fence(__ATOMIC_ACQUIRE, "agent"); asm volatile("s_waitcnt vmcnt(0)" ::: "memory"); }
    __syncthreads();
}

__device__ __forceinline__ void mod_to_lds(Frame& F, LAS float* dst, int col0, int ncols) {
    const float* modp = (const float*)(F.ws + WS_MODP); const float* bada = F.in[IN_BADA];
#pragma unroll 4
    for (int i = F.tid; i < 2 * ncols; i += NWAVES * 64) { const int b = i / ncols, j = i % ncols; float s = bada[col0 + j];
#pragma unroll
        for (int ks = 0; ks < KS_ADA; ++ks) s += modp[(size_t)(ks * 2 + b) * 6144 + col0 + j];
        dst[i] = s; }
    __syncthreads();
}
constexpr size_t WS_MODF = WS_MODP + (size_t)KS_ADA * 2 * 6144 * 4;
__device__ __forceinline__ void modf_write(Frame& F) {
    const float* modp = (const float*)(F.ws + WS_MODP); const float* bada = F.in[IN_BADA]; float* modf = (float*)(F.ws + WS_MODF);
    const int i = (int)blockIdx.x * NWAVES * 64 + F.tid;
    if (i < 2 * 4096) { const int b = i >> 12, col = 2048 + (i & 4095); float s = bada[col];
#pragma unroll
        for (int ks = 0; ks < KS_ADA; ++ks) s += modp[(size_t)(ks * 2 + b) * 6144 + col];
        modf[b * 6144 + col] = s; }
}
__device__ __forceinline__ void modf_to_lds(Frame& F, LAS float* dst, int col0, int ncols) {
    const float* modf = (const float*)(F.ws + WS_MODF);
#pragma unroll 4
    for (int i = F.tid; i < 2 * ncols; i += NWAVES * 64) { const int b = i / ncols, j = i % ncols; dst[i] = modf[b * 6144 + col0 + j]; }
    __syncthreads();
}

__device__ __forceinline__ void p1_prenorm(Frame& F) {
    LAS float* md = (LAS float*)(F.lds + RING_OFF);
    p0_wait_published(F);
    modf_write(F);
    mod_to_lds(F, md, 0, 2048);
    const int gw = F.vcu * NWAVES + F.wave, NGW = F.G * NWAVES, lane = F.lane;
    const float* x = F.in[IN_X]; const float* g = F.in[IN_NPREMIX]; bf16* h = (bf16*)(F.ws + WS_H);
    f32x4 gq[4];
#pragma unroll
    for (int j = 0; j < 4; ++j) gq[j] = *(const f32x4*)(g + 4 * lane + 256 * j);
    f32x4 vn[4];
    if (gw < NTOK) { const f32x4* xr = (const f32x4*)(x + (size_t)gw * DM) + lane;
#pragma unroll
        for (int j = 0; j < 4; ++j) vn[j] = xr[64 * j]; }
    for (int m = gw; m < NTOK; m += NGW) {
        const int b = m >> 13;
        f32x4 v[4]; float ss = 0.f;
#pragma unroll
        for (int j = 0; j < 4; ++j) { v[j] = vn[j]; ss += (v[j].x * v[j].x + v[j].y * v[j].y) + (v[j].z * v[j].z + v[j].w * v[j].w); }
        const float rstd = rsqrtf(wave_sum(ss) * (1.f / DM) + EPS);
        unsigned long long* o8 = (unsigned long long*)(h + (size_t)m * DM) + lane;
#pragma unroll
        for (int j = 0; j < 4; ++j) { const int col = 4 * lane + 256 * j; const f32x4 gg = gq[j];
            const f32x4 sh = *(const LAS f32x4*)(md + b * 2048 + col), sc = *(const LAS f32x4*)(md + b * 2048 + 1024 + col);
            const f32x4 r = (v[j] * rstd * gg) * (sc + 1.f) + sh;
            o8[64 * j] = (unsigned long long)pk2(r.x, r.y) | ((unsigned long long)pk2(r.z, r.w) << 32); }
        if (m + NGW < NTOK) { const f32x4* xr = (const f32x4*)(x + (size_t)(m + NGW) * DM) + lane;
#pragma unroll
            for (int j = 0; j < 4; ++j) vn[j] = xr[64 * j]; }
    }
    __syncthreads();
}

typedef float f32x16 __attribute__((ext_vector_type(16)));
typedef short s16x4 __attribute__((ext_vector_type(4)));
typedef float f32x2_t __attribute__((ext_vector_type(2))); typedef __bf16 bf16x2_t __attribute__((ext_vector_type(2)));
__device__ __forceinline__ unsigned cvtpk(float lo, float hi) { f32x2_t v = {lo, hi}; bf16x2_t bb = __builtin_convertvector(v, bf16x2_t); return __builtin_bit_cast(unsigned, bb); }
__device__ __forceinline__ int crow(int i, int hi) { return (i & 3) + 8 * (i >> 2) + 4 * hi; }
#define MFMA32(a, b, c) __builtin_amdgcn_mfma_f32_32x32x16_bf16((a), (b), (c), 0, 0, 0)
constexpr int AT_KB = 24576, AT_VB = 25600, AT_BUF = AT_KB + AT_VB, AT_SQ = 2 * AT_BUF;
struct AtStage { v4u k[3], v[3]; };
__device__ __forceinline__ void at_load(AtStage& st, const bf16* k, const bf16* vT, int b, int q0, int c, int tid) {
#pragma unroll
    for (int i = 0; i < 3; ++i) { const int kb = q0 - 128 + 32 * (3 * c + i), kbc = kb < 0 ? 0 : (kb > SEQ - 32 ? SEQ - 32 : kb);
        st.k[i] = *(const v4u*)(k + (size_t)(b * SEQ + kbc + (tid >> 4)) * 128 + (tid & 15) * 8);
        st.v[i] = *(const v4u*)(vT + (size_t)(b * 128 + (tid >> 2)) * SEQ + kbc + (tid & 3) * 8); }
}
__device__ __forceinline__ void at_store(const AtStage& st, LAS unsigned char* buf, int tid) {
#pragma unroll
    for (int i = 0; i < 3; ++i) { const int key = 32 * i + (tid >> 4), ch16 = tid & 15, kvh = ch16 >> 3, ch = ch16 & 7;
        *(LAS v4u*)(buf + kvh * 12288 + key * 128 + ((ch ^ (key & 7)) << 4)) = st.k[i];
        const int row = tid >> 2, pc = tid & 3; LAS unsigned char* vp = buf + AT_KB + (row >> 6) * 12800 + (row & 63) * 200 + (32 * i + 8 * pc) * 2;
        typedef unsigned u32x2_t __attribute__((ext_vector_type(2)));
        *(LAS u32x2_t*)vp = (u32x2_t){st.v[i].x, st.v[i].y}; *(LAS u32x2_t*)(vp + 8) = (u32x2_t){st.v[i].z, st.v[i].w}; }
}
#define AT_TILE(KT, TL, MODE) do { const int kb_ = q0 - 128 + 32 * (KT); if (kb_ >= 0 && kb_ < SEQ) { \
    const int key_ = 32 * (TL) + r32; bf16x8 kf_[4]; \
    _Pragma("unroll") for (int ks = 0; ks < 4; ++ks) kf_[ks] = *(const LAS bf16x8*)(kimg + key_ * 128 + (((2 * ks + hi) ^ (key_ & 7)) << 4)); \
    bf16x8 va_[2][2]; \
    _Pragma("unroll") for (int db = 0; db < 2; ++db) _Pragma("unroll") for (int sx = 0; sx < 2; ++sx) { const LAS unsigned char* vp_ = vimg + (32 * db + r32) * 200 + (32 * (TL) + 16 * sx + 4 * hi) * 2; \
        const s16x4 lo_ = *(const LAS s16x4*)vp_, hv_ = *(const LAS s16x4*)(vp_ + 16); va_[db][sx] = __builtin_shufflevector(lo_, hv_, 0, 1, 2, 3, 4, 5, 6, 7); } \
    f32x16 st_; _Pragma("unroll") for (int i = 0; i < 16; ++i) st_[i] = 0.f; \
    _Pragma("unroll") for (int ks = 0; ks < 4; ++ks) st_ = MFMA32(kf_[ks], *(const LAS bf16x8*)(ot + ks * 1024 + lane * 16), st_); \
    float bt_ = 0.f; \
    if (MODE == 1) { bt_ = Bp - sl2 * (float)(128 - 32 * (KT)); _Pragma("unroll") for (int i = 0; i < 16; ++i) st_[i] = __builtin_fmaf(st_[i], c0, Kc[i]); } \
    else if (MODE == 2) { bt_ = -Bp - sl2 * (float)(32 * (KT) - 128); _Pragma("unroll") for (int i = 0; i < 16; ++i) st_[i] = __builtin_fmaf(st_[i], c0, -Kc[i]); } \
    else if (MODE == 3) { bt_ = Bp - sl2 * 128.f;              \
        _Pragma("unroll") for (int i = 0; i < 16; ++i) st_[i] = ((i & 3) + 8 * (i >> 2) + 4 * hi >= r32) ? __builtin_fmaf(st_[i], c0, Kc[i]) : -1e30f; } \
    else if (MODE == 4) { bt_ = -Bp - sl2 * 128.f;             \
        _Pragma("unroll") for (int i = 0; i < 16; ++i) st_[i] = ((i & 3) + 8 * (i >> 2) + 4 * hi <= r32) ? __builtin_fmaf(st_[i], c0, -Kc[i]) : -1e30f; } \
    else {                                                     \
        _Pragma("unroll") for (int i = 0; i < 16; ++i) st_[i] = __builtin_fmaf(-sl2, __builtin_fabsf(rh - (float)((i & 3) + 8 * (i >> 2))), st_[i] * c0); } \
    float ta_ = fmaxf(fmaxf(st_[0], st_[1]), st_[2]), tb_ = fmaxf(fmaxf(st_[3], st_[4]), st_[5]); \
    ta_ = fmaxf(fmaxf(ta_, st_[6]), st_[7]); tb_ = fmaxf(fmaxf(tb_, st_[8]), st_[9]); ta_ = fmaxf(fmaxf(ta_, st_[10]), st_[11]); tb_ = fmaxf(fmaxf(tb_, st_[12]), st_[13]); \
    float tmax_ = fmaxf(fmaxf(ta_, tb_), fmaxf(st_[14], st_[15])) + bt_; tmax_ = fmaxf(tmax_, __shfl_xor(tmax_, 32)); \
    if (__any(tmax_ > m_run)) { const float mn_ = fmaxf(m_run, tmax_), al_ = __builtin_amdgcn_exp2f(m_run - mn_); m_run = mn_; l_run *= al_; \
        _Pragma("unroll") for (int i = 0; i < 16; ++i) { o0[i] *= al_; o1[i] *= al_; } } \
    const float dl_ = bt_ - m_run; float ps_ = 0.f; \
    _Pragma("unroll") for (int i = 0; i < 16; ++i) { const float p_ = __builtin_amdgcn_exp2f(st_[i] + dl_); st_[i] = p_; ps_ += p_; } \
    ps_ += __shfl_xor(ps_, 32); l_run += ps_; \
    v4u p0_, p1_; \
    p0_.x = cvtpk(st_[0], st_[1]); p0_.y = cvtpk(st_[2], st_[3]); p0_.z = cvtpk(st_[4], st_[5]); p0_.w = cvtpk(st_[6], st_[7]); \
    p1_.x = cvtpk(st_[8], st_[9]); p1_.y = cvtpk(st_[10], st_[11]); p1_.z = cvtpk(st_[12], st_[13]); p1_.w = cvtpk(st_[14], st_[15]); \
    const bf16x8 pb0_ = __builtin_bit_cast(bf16x8, p0_), pb1_ = __builtin_bit_cast(bf16x8, p1_); \
    o0 = MFMA32(va_[0][0], pb0_, o0); o0 = MFMA32(va_[0][1], pb1_, o0); o1 = MFMA32(va_[1][0], pb0_, o1); o1 = MFMA32(va_[1][1], pb1_, o1); } } while (0)
#define AT_CHUNK(C, NC, NU, M0, M1, M2) do { LAS unsigned char* buf = ring + par * AT_BUF; par ^= 1; at_store(st, buf, tid); __syncthreads(); \
    if ((NU) < uend) at_load(st, k, vT, ((NU) * 32) >> 13, ((NU) * 32) & 8191, (NC), tid); \
    const LAS unsigned char* kimg = buf + kvh * 12288; const LAS unsigned char* vimg = buf + AT_KB + kvh * 12800; \
    AT_TILE(3 * (C) + 0, 0, M0); __builtin_amdgcn_sched_barrier(0); AT_TILE(3 * (C) + 1, 1, M1); __builtin_amdgcn_sched_barrier(0); AT_TILE(3 * (C) + 2, 2, M2); } while (0)
__device__ __forceinline__ void p3_attn_mfma(Frame& F) {
    const int tid = F.tid, lane = F.lane, r32 = lane & 31, hi = lane >> 5, hh = F.wave, kvh = hh >> 2;
    LAS unsigned char* ring = F.lds + RING_OFF; LAS float* SQ = (LAS float*)(ring + AT_SQ);
    const bf16* q = (const bf16*)(F.ws + WS_Q); const bf16* k = (const bf16*)(F.ws + WS_K); const bf16* vT = (const bf16*)(F.ws + WS_VT);
    bf16* mix = (bf16*)(F.ws + WS_MIX); const float* gn = F.in[IN_NOATTN];
    constexpr float LOG2E = 1.4426950408889634f;
    const float slope = exp2f(-(float)(hh + 1)), sl2 = slope * LOG2E, c0 = 0.125f * LOG2E, sink2 = F.in[IN_SINK][hh] * LOG2E;
    const float rh = (float)(r32 - 4 * hi), Bp = -sl2 * rh;
    float Kc[16];
#pragma unroll
    for (int i = 0; i < 16; ++i) Kc[i] = sl2 * (float)((i & 3) + 8 * (i >> 2));
    LAS unsigned char* ot = ring + AT_SQ + 1024 + hh * 4096;
    const int nunits = NTOK / 32; const bool bal = (F.G == 256); const int ustep = bal ? 128 : F.G, uend = bal ? (F.vcu < 128 ? F.vcu + 1 : nunits) : nunits;
    int unit = F.vcu; if (unit >= uend) return;
    AtStage st; at_load(st, k, vT, (unit * 32) >> 13, (unit * 32) & 8191, 1, tid);
    int par = 0;
    for (; unit < uend; unit += ustep) {
        const int tok0 = unit * 32, b = tok0 >> 13, q0 = tok0 & 8191, qpos = q0 + r32;
#pragma unroll
        for (int ks = 0; ks < 4; ++ks) *(LAS bf16x8*)(ot + ks * 1024 + lane * 16) = *(const bf16x8*)(q + (size_t)(tok0 + r32) * 512 + hh * 64 + 16 * ks + 8 * hi);
        f32x16 o0, o1;
#pragma unroll
        for (int i = 0; i < 16; ++i) { o0[i] = 0.f; o1[i] = 0.f; }
        float m_run = sink2, l_run = 1.f;
        AT_CHUNK(1, 0, unit, 1, 0, 2);
        AT_CHUNK(0, 2, unit, 3, 1, 1);
        AT_CHUNK(2, 1, unit + ustep, 2, 2, 4);
        (void)b;
        const float inv = 1.f / l_run; float sq = 0.f;
#pragma unroll
        for (int i = 0; i < 16; ++i) { o0[i] *= inv; o1[i] *= inv; sq += o0[i] * o0[i] + o1[i] * o1[i]; }
        sq += __shfl_xor(sq, 32);
        if (hi == 0) SQ[hh * 32 + r32] = sq;
        __syncthreads();
        float tot = 0.f;
#pragma unroll
        for (int w8 = 0; w8 < 8; ++w8) tot += SQ[w8 * 32 + r32];
        const float rstd = rsqrtf(tot * (1.f / 512.f) + EPS);
#pragma unroll
        for (int g4 = 0; g4 < 4; ++g4) { const int d0 = 8 * g4 + 4 * hi; const f32x4 ga = *(const GAS f32x4*)(gn + hh * 64 + d0), gb = *(const GAS f32x4*)(gn + hh * 64 + 32 + d0);
            *(LAS unsigned long long*)(ot + r32 * 128 + ((g4 ^ (r32 & 7)) << 4) + 8 * hi) = (unsigned long long)cvtpk(o0[4 * g4] * rstd * ga.x, o0[4 * g4 + 1] * rstd * ga.y) | ((unsigned long long)cvtpk(o0[4 * g4 + 2] * rstd * ga.z, o0[4 * g4 + 3] * rstd * ga.w) << 32);
            *(LAS unsigned long long*)(ot + r32 * 128 + (((4 + g4) ^ (r32 & 7)) << 4) + 8 * hi) = (unsigned long long)cvtpk(o1[4 * g4] * rstd * gb.x, o1[4 * g4 + 1] * rstd * gb.y) | ((unsigned long long)cvtpk(o1[4 * g4 + 2] * rstd * gb.z, o1[4 * g4 + 3] * rstd * gb.w) << 32); }
#pragma unroll
        for (int i = 0; i < 4; ++i) { const int qq = 8 * i + (lane >> 3); const v4u v = *(const LAS v4u*)(ot + qq * 128 + (((lane & 7) ^ (qq & 7)) << 4));
            *(v4u*)(mix + (size_t)(tok0 + qq) * DM + hh * 64 + (lane & 7) * 8) = v; }
        __syncthreads();
    }
}
#undef AT_TILE
#undef AT_CHUNK

__device__ __forceinline__ void p3_gmlp_mfma(Frame& F) {
    __syncthreads();
    const int lane = F.lane, r32 = lane & 31, hi = lane >> 5, w = F.wave, ch0 = w * 64;
    LAS float* L = (LAS float*)(F.lds + RING_OFF + 131072);
    LAS float* MU = L; LAS float* RS = L + 128; LAS float* SQ = L + 256;
    LAS unsigned char* wt = F.lds + RING_OFF + w * 16384;
    const bf16* vgT = (const bf16*)(F.ws + WS_VGT); const bf16* u = (const bf16*)(F.ws + WS_U); bf16* mix = (bf16*)(F.ws + WS_MIX); const bf16* wsb = (const bf16*)(F.ws + WS_WSB);
    const float* bs = F.in[IN_BS]; const float* lng = F.in[IN_LNG]; const float* lnb = F.in[IN_LNB]; const float* gn = F.in[IN_NOGMLP];
    for (int unit = F.vcu; unit < BATCH * (SEQ / 128); unit += F.G) {
        const int b = unit >> 6, s0 = (unit & 63) * 128;
#pragma unroll
        for (int hb = 0; hb < 2; ++hb) { v4u ur[8];
#pragma unroll
          for (int i = 0; i < 8; ++i) ur[i] = *(const v4u*)(u + ((size_t)b * SEQ + s0 + 8 * (8 * hb + i) + (lane >> 3)) * 512 + ch0 + (lane & 7) * 8);
#pragma unroll
          for (int i = 0; i < 8; ++i) { const int t = 8 * (8 * hb + i) + (lane >> 3); *(LAS v4u*)(wt + t * 128 + (((lane & 7) ^ (t & 7)) << 4)) = ur[i]; }
          asm volatile("s_waitcnt lgkmcnt(0)" ::: "memory"); }
        if (F.tid < 128) { const float* vs = (const float*)(F.ws + WS_VSTAT) + ((size_t)b * SEQ + s0 + F.tid) * 2; float s1 = 0.f, s2 = 0.f;
#pragma unroll
            for (int p = 0; p < 8; ++p) { const f32x2_t t2 = *(const f32x2_t*)(vs + (size_t)p * NTOK * 2); s1 += t2.x; s2 += t2.y; }
            const float mean = s1 * (1.f / 512.f); float var = s2 * (1.f / 512.f) - mean * mean; var = var < 0.f ? 0.f : var;
            MU[F.tid] = mean; RS[F.tid] = rsqrtf(var + EPS); }
        __syncthreads();
        f32x16 z[2][4];
#pragma unroll
        for (int cb = 0; cb < 2; ++cb)
#pragma unroll
            for (int tb = 0; tb < 4; ++tb)
#pragma unroll
                for (int i = 0; i < 16; ++i) z[cb][tb][i] = 0.f;
        const float lg0 = lng[ch0 + r32], lb0 = lnb[ch0 + r32], lg1 = lng[ch0 + 32 + r32], lb1 = lnb[ch0 + 32 + r32];
#pragma unroll 2
        for (int ks = 0; ks < 8; ++ks) {
            const int sb = 16 * ks + 8 * hi;
            const f32x4 mua = *(const LAS f32x4*)(MU + sb), mub = *(const LAS f32x4*)(MU + sb + 4), rsa = *(const LAS f32x4*)(RS + sb), rsb = *(const LAS f32x4*)(RS + sb + 4);
            bf16x8 af[2];
#pragma unroll
            for (int cb = 0; cb < 2; ++cb) { const float lg = cb ? lg1 : lg0, lb = cb ? lb1 : lb0;
                const v4u raw = *(const v4u*)(vgT + ((((size_t)(b * 64 + (unit & 63)) * 8 + w) * 2 + cb) * 8 + ks) * 512 + lane * 8);
                v4u pk;
                pk.x = cvtpk((bflo(raw.x) - mua.x) * rsa.x * lg + lb, (bfhi(raw.x) - mua.y) * rsa.y * lg + lb);
                pk.y = cvtpk((bflo(raw.y) - mua.z) * rsa.z * lg + lb, (bfhi(raw.y) - mua.w) * rsa.w * lg + lb);
                pk.z = cvtpk((bflo(raw.z) - mub.x) * rsb.x * lg + lb, (bfhi(raw.z) - mub.y) * rsb.y * lg + lb);
                pk.w = cvtpk((bflo(raw.w) - mub.z) * rsb.z * lg + lb, (bfhi(raw.w) - mub.w) * rsb.w * lg + lb);
                af[cb] = __builtin_bit_cast(bf16x8, pk); }
#pragma unroll
            for (int tb = 0; tb < 4; ++tb) { const bf16x8 bfr = *(const bf16x8*)(wsb + ((size_t)((w * 8 + ks) * 4 + tb) * 64 + lane) * 8);
                z[0][tb] = MFMA32(af[0], bfr, z[0][tb]); z[1][tb] = MFMA32(af[1], bfr, z[1][tb]); }
        }
        int lq = lane; asm volatile("" : "+v"(lq)); const int r32e = lq & 31, hie = lq >> 5, l8 = lq & 7, l3 = lq >> 3;
        const float* bsl = bs; const float* gnl = gn; asm volatile("" : "+s"(bsl), "+s"(gnl));
#pragma unroll
        for (int tb = 0; tb < 4; ++tb) { const int t = 32 * tb + r32e; const float bsv = *(const GAS float*)(bsl + w * 128 + t); float sq = 0.f;
#pragma unroll
            for (int cb = 0; cb < 2; ++cb)
#pragma unroll
                for (int g4 = 0; g4 < 4; ++g4) { typedef unsigned u32x2_t __attribute__((ext_vector_type(2))); const u32x2_t ur = *(const LAS u32x2_t*)(wt + t * 128 + (((4 * cb + g4) ^ (t & 7)) << 4) + 8 * hie);
                    const float g0 = bflo(ur.x) * (z[cb][tb][4 * g4] + bsv), g1 = bfhi(ur.x) * (z[cb][tb][4 * g4 + 1] + bsv), g2 = bflo(ur.y) * (z[cb][tb][4 * g4 + 2] + bsv), g3 = bfhi(ur.y) * (z[cb][tb][4 * g4 + 3] + bsv);
                    z[cb][tb][4 * g4] = g0; z[cb][tb][4 * g4 + 1] = g1; z[cb][tb][4 * g4 + 2] = g2; z[cb][tb][4 * g4 + 3] = g3; sq += (g0 * g0 + g1 * g1) + (g2 * g2 + g3 * g3); }
            sq += __shfl_xor(sq, 32);
            if (hie == 0) SQ[w * 128 + t] = sq; asm volatile("" ::: "memory"); }
        __syncthreads();
#pragma unroll
        for (int tb = 0; tb < 4; ++tb) { const int t = 32 * tb + r32e; float tot = 0.f;
#pragma unroll
            for (int ww = 0; ww < 8; ++ww) tot += SQ[ww * 128 + t];
            const float rstd = rsqrtf(tot * (1.f / 512.f) + EPS);
#pragma unroll
            for (int cb = 0; cb < 2; ++cb)
#pragma unroll
                for (int g4 = 0; g4 < 4; ++g4) { const int c0 = 32 * cb + 8 * g4 + 4 * hie; const f32x4 gg = *(const GAS f32x4*)(gnl + ch0 + c0);
                    *(LAS unsigned long long*)(wt + t * 128 + (((4 * cb + g4) ^ (t & 7)) << 4) + 8 * hie) = (unsigned long long)cvtpk(z[cb][tb][4 * g4] * rstd * gg.x, z[cb][tb][4 * g4 + 1] * rstd * gg.y) | ((unsigned long long)cvtpk(z[cb][tb][4 * g4 + 2] * rstd * gg.z, z[cb][tb][4 * g4 + 3] * rstd * gg.w) << 32); } asm volatile("" ::: "memory"); }
#pragma unroll
        for (int i = 0; i < 16; ++i) { const int t = 8 * i + l3; const v4u v = *(const LAS v4u*)(wt + t * 128 + ((l8 ^ (t & 7)) << 4));
            *(v4u*)(mix + ((size_t)b * SEQ + s0 + t) * DM + 512 + ch0 + l8 * 8) = v; }
        __syncthreads();
    }
}

struct P5Ctx { LAS float* md; LAS float* wrT; const float* x; const bf16* t; unsigned char* h2; float* aff; bf16* x1; int lane, NGW; };
__device__ __forceinline__ void p5_issue(const P5Ctx& C, f32x4 (&xb)[4], uint2 (&tb)[4], int row) {
    const bool in = row < NTOK; const int ln = in ? C.lane : 0; const size_t ro = in ? (size_t)row * DM : 0;
    const f32x4* xr = (const f32x4*)(C.x + ro) + ln; const uint2* tr = (const uint2*)(C.t + ro) + ln;
#pragma unroll
    for (int j = 0; j < 4; ++j) { xb[j] = __builtin_nontemporal_load(xr + 64 * j); { typedef unsigned u32x2_t __attribute__((ext_vector_type(2))); const u32x2_t tq = __builtin_nontemporal_load((const u32x2_t*)(tr + 64 * j)); tb[j].x = tq.x; tb[j].y = tq.y; } }
}
__device__ __forceinline__ void p5_row(const P5Ctx& C, const f32x4 (&g1q)[4], const f32x4 (&g2q)[4], f32x4 (&xb)[4], uint2 (&tb)[4], int m) {
    if (m >= NTOK) return;
    LAS float* md = C.md; LAS float* wrT = C.wrT; unsigned char* h2 = C.h2; float* aff = C.aff; const int lane = C.lane;
        const int b = m >> 13, s = m & 8191;
        f32x4 tv[4], xv[4]; float ss = 0.f;
#pragma unroll
        for (int j = 0; j < 4; ++j) { const uint2 tq = tb[j]; tv[j] = (f32x4){bflo(tq.x), bfhi(tq.x), bflo(tq.y), bfhi(tq.y)}; xv[j] = xb[j]; ss += (tv[j].x * tv[j].x + tv[j].y * tv[j].y) + (tv[j].z * tv[j].z + tv[j].w * tv[j].w); }
        const float rstd1 = rsqrtf(wave_sum(ss) * (1.f / DM) + EPS);
        float ss2 = 0.f; unsigned long long* orow = (unsigned long long*)(C.x1 + (size_t)m * DM) + lane;
#pragma unroll
        for (int j = 0; j < 4; ++j) { const int col = 4 * lane + 256 * j; const f32x4 gg = g1q[j], ga = *(const LAS f32x4*)(md + b * 3072 + col);
            xv[j] = xv[j] + ga * (tv[j] * rstd1 * gg); orow[64 * j] = (unsigned long long)cvtpk(xv[j].x, xv[j].y) | ((unsigned long long)cvtpk(xv[j].z, xv[j].w) << 32);
            ss2 += (xv[j].x * xv[j].x + xv[j].y * xv[j].y) + (xv[j].z * xv[j].z + xv[j].w * xv[j].w); }
        const float rstd2 = rsqrtf(wave_sum(ss2) * (1.f / DM) + EPS);
        unsigned* o8 = (unsigned*)(h2 + (size_t)m * DM) + lane;
        f32x4 hv[4];
#pragma unroll
        for (int j = 0; j < 4; ++j) { const int col = 4 * lane + 256 * j; const f32x4 gg = g2q[j];
            const f32x4 sh = *(const LAS f32x4*)(md + b * 3072 + 1024 + col), sc = *(const LAS f32x4*)(md + b * 3072 + 2048 + col);
            hv[j] = (xv[j] * rstd2 * gg) * (sc + 1.f) + sh;
            o8[64 * j] = pg8::pk4_fp8(hv[j].x, hv[j].y, hv[j].z, hv[j].w); }
        float lg[16];
#pragma unroll
        for (int eg = 0; eg < 4; ++eg) { f32x4 wv[4][4];
#pragma unroll
            for (int e4 = 0; e4 < 4; ++e4)
#pragma unroll
                for (int j = 0; j < 4; ++j) wv[e4][j] = *(const LAS f32x4*)(wrT + (4 * eg + e4) * DM + 4 * lane + 256 * j);
#pragma unroll
            for (int e4 = 0; e4 < 4; ++e4) { f32x2_t a2 = {0.f, 0.f};
#pragma unroll
                for (int j = 0; j < 4; ++j) { a2 += (f32x2_t){hv[j].x, hv[j].y} * (f32x2_t){wv[e4][j].x, wv[e4][j].y}; a2 += (f32x2_t){hv[j].z, hv[j].w} * (f32x2_t){wv[e4][j].z, wv[e4][j].w}; }
                float a = a2.x + a2.y; asm volatile("" : "+v"(a)); lg[4 * eg + e4] = a; } }
        float v8[8];
#pragma unroll
        for (int e = 0; e < 8; ++e) { const auto r = __builtin_amdgcn_permlane32_swap(__float_as_uint(lg[e]), __float_as_uint(lg[e + 8]), false, false); v8[e] = __uint_as_float(r[0]) + __uint_as_float(r[1]); }
        const bool b4 = (lane & 16) != 0, b3 = (lane & 8) != 0, b2 = (lane & 4) != 0;
        float v4[4];
#pragma unroll
        for (int i = 0; i < 4; ++i) { const float snd = b4 ? v8[i] : v8[i + 4], kp = b4 ? v8[i + 4] : v8[i]; v4[i] = kp + __shfl_xor(snd, 16); }
        float v2[2];
#pragma unroll
        for (int i = 0; i < 2; ++i) { const float snd = b3 ? v4[i] : v4[i + 2], kp = b3 ? v4[i + 2] : v4[i]; v2[i] = kp + __shfl_xor(snd, 8); }
        float tl; { const float snd = b2 ? v2[0] : v2[1], kp = b2 ? v2[1] : v2[0]; tl = kp + __shfl_xor(snd, 4); }
        DPP_ADDF(tl, 0x4E, 0xf); DPP_ADDF(tl, 0xB1, 0xf);
        const float mx = wave_max(tl), ex = __expf(tl - mx), se = wave_sum(ex) * 0.25f;
        if ((lane & 3) == 0) aff[(size_t)(b * NEXP + (lane >> 2)) * SEQ + s] = ex / se;
}
__device__ __forceinline__ void p5_postmix(Frame& F) {
    LAS float* md = (LAS float*)(F.lds + RING_OFF);
    LAS float* wrT = (LAS float*)(F.lds + RING_OFF + 32768);
#pragma unroll 16
    for (int i = F.tid; i < DM * NEXP; i += NWAVES * 64) { const int col = i >> 4, e = i & 15; wrT[e * DM + col] = F.in[IN_WROUTER][i]; }
    modf_to_lds(F, md, 2048, 3072);
    const int gw = F.vcu * NWAVES + F.wave, NGW = F.G * NWAVES, lane = F.lane;
    const float* g1 = F.in[IN_NPOSTMIX]; const float* g2 = F.in[IN_NPREFFN];
    const P5Ctx C{md, wrT, F.in[IN_X], (const bf16*)(F.ws + WS_T), (unsigned char*)(F.ws + WS_H), (float*)(F.ws + WS_AFF), (bf16*)(F.ws + WS_X1), lane, NGW};
    f32x4 g1q[4], g2q[4];
#pragma unroll
    for (int j = 0; j < 4; ++j) { g1q[j] = *(const f32x4*)(g1 + 4 * lane + 256 * j); g2q[j] = *(const f32x4*)(g2 + 4 * lane + 256 * j); }
    f32x4 xA[4], xB[4]; uint2 tA[4], tB[4];
    p5_issue(C, xA, tA, gw); __builtin_amdgcn_sched_barrier(0);
#pragma unroll 1
    for (int m = gw; m < NTOK; m += 2 * NGW) {
        p5_issue(C, xB, tB, m + NGW); __builtin_amdgcn_sched_barrier(0);
        p5_row(C, g1q, g2q, xA, tA, m); __builtin_amdgcn_sched_barrier(0);
        p5_issue(C, xA, tA, m + 2 * NGW); __builtin_amdgcn_sched_barrier(0);
        p5_row(C, g1q, g2q, xB, tB, m + NGW); __builtin_amdgcn_sched_barrier(0);
    }
    __syncthreads();
}

__device__ __forceinline__ void p6_topk(Frame& F) {
    LAS unsigned* vals = (LAS unsigned*)(F.lds + RING_OFF);
    LAS unsigned* hist = (LAS unsigned*)(F.lds + RING_OFF + 32768);
    LAS unsigned* misc = (LAS unsigned*)(F.lds + RING_OFF + 32768 + 1024);
    const int tid = F.tid, lane = F.lane, w = F.wave;
    const float* aff = (const float*)(F.ws + WS_AFF); int* slots = (int*)(F.ws + WS_SLOTS); int* idx = (int*)(F.ws + WS_IDX); float* gates = (float*)(F.ws + WS_GATES);
    if (F.vcu >= BATCH * NEXP) {
        const int ncv = (F.G - BATCH * NEXP) < P6_CONV ? (F.G - BATCH * NEXP) : P6_CONV;
        if (F.vcu - BATCH * NEXP < ncv) p0_expert_items(F, XI_R1, XI_TOTAL, (F.vcu - BATCH * NEXP) * NWAVES + F.wave, ncv * NWAVES);
        return; }
    if (F.G <= BATCH * NEXP && F.vcu == 0) p0_expert_items(F, XI_R1, XI_TOTAL, F.wave, NWAVES);
    for (int unit = F.vcu; unit < BATCH * NEXP; unit += F.G) {
        const int b = unit >> 4, e = unit & 15;
        __syncthreads();
        const unsigned* src = (const unsigned*)(aff + (size_t)unit * SEQ);
        for (int i = tid; i < SEQ; i += NWAVES * 64) vals[i] = src[i];
        unsigned prefix = 0u, mask = 0u, need = CAP;
#pragma unroll 1
        for (int pass = 0; pass < 4; ++pass) {
            const int shift = 24 - 8 * pass;
            if (tid < 256) hist[tid] = 0u;
            __syncthreads();
            for (int i = tid; i < SEQ; i += NWAVES * 64) { const unsigned v = vals[i]; if ((v & mask) == prefix) __hip_atomic_fetch_add(&hist[(v >> shift) & 255u], 1u, __ATOMIC_RELAXED, __HIP_MEMORY_SCOPE_WORKGROUP); }
            __syncthreads();
            if (w == 0) {
                const unsigned b0 = hist[4 * lane], b1 = hist[4 * lane + 1], b2 = hist[4 * lane + 2], b3 = hist[4 * lane + 3];
                const unsigned sl = b0 + b1 + b2 + b3; unsigned suf = sl;
#pragma unroll
                for (int o = 1; o < 64; o <<= 1) { const unsigned tv = __shfl_down(suf, o); if (lane + o < 64) suf += tv; }
                const unsigned above = suf - sl;
                if (above < need && need <= above + sl) {
                    unsigned cnt = above, dig, nn;
                    if (cnt + b3 >= need) { dig = 3; nn = need - cnt; } else { cnt += b3;
                    if (cnt + b2 >= need) { dig = 2; nn = need - cnt; } else { cnt += b2;
                    if (cnt + b1 >= need) { dig = 1; nn = need - cnt; } else { cnt += b1; dig = 0; nn = need - cnt; } } }
                    misc[0] = 4u * lane + dig; misc[1] = nn; }
            }
            __syncthreads();
            prefix |= misc[0] << shift; mask |= 255u << shift; need = misc[1];
            __syncthreads();
        }
        const unsigned T = prefix; unsigned gt = 0u, eq = 0u; unsigned v16[16];
#pragma unroll
        for (int i = 0; i < 16; ++i) { v16[i] = vals[16 * tid + i]; gt += (v16[i] > T) ? 1u : 0u; eq += (v16[i] == T) ? 1u : 0u; }
        unsigned pk = gt | (eq << 16), inc = pk;
#pragma unroll
        for (int o = 1; o < 64; o <<= 1) { const unsigned tv = __shfl_up(inc, o); if (lane >= o) inc += tv; }
        if (lane == 63) misc[16 + w] = inc;
        __syncthreads();
        unsigned base = 0u;
#pragma unroll
        for (int ww = 0; ww < 8; ++ww) base += (ww < w) ? misc[16 + ww] : 0u;
        const unsigned exc = base + inc - pk; unsigned gtb = exc & 0xffffu, eqb = exc >> 16;
#pragma unroll
        for (int i = 0; i < 16; ++i) { const int tok = 16 * tid + i; const unsigned v = v16[i]; int slot = -1;
            if (v > T) { slot = (int)(gtb + (eqb < need ? eqb : need)); ++gtb; }
            else if (v == T) { if (eqb < need) slot = (int)(gtb + eqb); ++eqb; }
            slots[(size_t)(b * SEQ + tok) * NEXP + e] = slot;
            if (slot >= 0) { idx[(e * BATCH + b) * CAP + slot] = b * SEQ + tok; gates[unit * CAP + slot] = __uint_as_float(v); } }
    }
    __syncthreads();
}

__device__ __forceinline__ void p6b_gather(Frame& F) {
    const int gw = F.vcu * NWAVES + F.wave, NGW = F.G * NWAVES, lane = F.lane;
    const int* idx = (const int*)(F.ws + WS_IDX); const unsigned char* h2 = (const unsigned char*)(F.ws + WS_H); unsigned char* xs = (unsigned char*)(F.ws + WS_XS);
    for (int r = gw; r < NROWS_E; r += NGW) { const int e = r >> 11, b = (r >> 10) & 1, c = r & 1023; const int tok = idx[(b * NEXP + e) * CAP + c];
        const v4u* sp = (const v4u*)(h2 + (size_t)(b * SEQ + tok) * DM) + lane; v4u* dp = (v4u*)(xs + (size_t)r * DM) + lane;
        dp[0] = sp[0]; }
}

typedef unsigned u32x2_t __attribute__((ext_vector_type(2)));
struct P10Set { float gt[4]; unsigned r[4][4]; u32x2_t x1[4]; unsigned okb, mask; int slotv; };
__device__ __forceinline__ void p10_gather4(float (&gt)[4], unsigned (&r)[4][4], unsigned& okb, unsigned& mask, int slotv, int b, const float* gates, const unsigned char* yrows, int lane, int dflt) {
    int rowi = dflt, gi = dflt; okb = 0u;
#pragma unroll
    for (int q = 0; q < 4; ++q) { const bool ok = mask != 0u; const int e = ok ? __builtin_ctz(mask) : 0; mask = ok ? (mask & (mask - 1u)) : 0u;
        const int sl = __builtin_amdgcn_readlane(slotv, e);
        rowi = ok ? e * 2048 + b * 1024 + sl : rowi; gi = ok ? (b * NEXP + e) * CAP + sl : gi; okb |= ok ? (1u << q) : 0u;
        gt[q] = gates[gi]; const unsigned* yr = (const unsigned*)(yrows + (size_t)rowi * DM) + lane;
#pragma unroll
        for (int j = 0; j < 4; ++j) r[q][j] = __builtin_nontemporal_load(yr + 64 * j); }
}
__device__ __forceinline__ void p10_accum(const float (&gt)[4], const unsigned (&r)[4][4], unsigned okb, float (&y)[16]) {
#pragma unroll
    for (int q = 0; q < 4; ++q) { const float g = ((okb >> q) & 1u) ? gt[q] * (1.f / Y8_SCALE) : 0.f;
#pragma unroll
        for (int j = 0; j < 4; ++j) { const f32x2_t lo = __builtin_amdgcn_cvt_pk_f32_fp8((int)r[q][j], false), hi = __builtin_amdgcn_cvt_pk_f32_fp8((int)r[q][j], true);
            y[4 * j] += g * lo.x; y[4 * j + 1] += g * lo.y; y[4 * j + 2] += g * hi.x; y[4 * j + 3] += g * hi.y; } }
}
struct P10Ctx { const float* gates; const unsigned char* yrows; const bf16* x1; float* out; LAS float* md; LAS int* sl; int gw, NGW, nrows, lane; };
__device__ __forceinline__ void p10_issue_row(const P10Ctx& C, P10Set& S, int k) {
    const int kk = k < C.nrows ? k : C.nrows - 1, m = C.gw + kk * C.NGW, lane = C.lane;
    S.slotv = C.sl[kk * 16 + (lane & 15)]; S.slotv = (lane < 16) ? S.slotv : -1;
    S.mask = (unsigned)(__ballot(S.slotv >= 0) & 0xffffull);
    p10_gather4(S.gt, S.r, S.okb, S.mask, S.slotv, m >> 13, C.gates, C.yrows, lane, m & 32767);
    const u32x2_t* xr = (const u32x2_t*)(C.x1 + (size_t)m * DM) + lane;
#pragma unroll
    for (int j = 0; j < 4; ++j) S.x1[j] = xr[64 * j];
}
__device__ __forceinline__ void p10_finish_row(const P10Ctx& C, P10Set& S, const f32x4 (&gnq)[4], int k) {
    if (k >= C.nrows) return;
    const int m = C.gw + k * C.NGW, b = m >> 13, lane = C.lane;
    float y[16];
#pragma unroll
    for (int i = 0; i < 16; ++i) y[i] = 0.f;
    p10_accum(S.gt, S.r, S.okb, y);
    while (S.mask) { float gt[4]; unsigned r[4][4]; unsigned okb; p10_gather4(gt, r, okb, S.mask, S.slotv, b, C.gates, C.yrows, lane, m & 32767); p10_accum(gt, r, okb, y); }
    float ss = 0.f;
#pragma unroll
    for (int i = 0; i < 16; ++i) ss += y[i] * y[i];
    const float rstd = rsqrtf(wave_sum(ss) * (1.f / DM) + EPS);
    float* orow = C.out + (size_t)m * DM + 4 * lane;
#pragma unroll
    for (int j = 0; j < 4; ++j) { const u32x2_t xq = S.x1[j]; const f32x4 gg = gnq[j], ga = *(const LAS f32x4*)(C.md + b * 1024 + 4 * lane + 256 * j);
        const f32x4 yv = {y[4 * j], y[4 * j + 1], y[4 * j + 2], y[4 * j + 3]}, x1 = {bflo(xq.x), bfhi(xq.x), bflo(xq.y), bfhi(xq.y)};
        __builtin_nontemporal_store(x1 + ga * (yv * rstd * gg), (f32x4*)(orow + 256 * j)); }
}
template <int PM = 0> __device__ __forceinline__ void p9_combine(Frame& F) {
    LAS float* md = (LAS float*)(F.lds + RING_OFF);
    modf_to_lds(F, md, 5120, 1024);
    const int gw = F.vcu * NWAVES + F.wave, NGW = F.G * NWAVES, lane = F.lane;
    if (gw >= NTOK) return;
    const int nrows = (NTOK - gw + NGW - 1) / NGW;
    LAS int* sl = (LAS int*)(F.lds + RING_OFF + 16384) + F.wave * 2048;
    const int* slots = (const int*)(F.ws + WS_SLOTS);
    for (int k0 = 0; k0 < nrows && k0 < 128; k0 += 4) { const int k = k0 + (lane >> 4); if (k < nrows) sl[k * 16 + (lane & 15)] = slots[(size_t)(gw + k * NGW) * NEXP + (lane & 15)]; }
    const float* gn = F.in[IN_NPOSTFFN];
    f32x4 gnq[4];
#pragma unroll
    for (int j = 0; j < 4; ++j) gnq[j] = *(const f32x4*)(gn + 4 * lane + 256 * j);
    asm volatile("s_waitcnt vmcnt(0) lgkmcnt(0)" ::: "memory");
    const P10Ctx C{(const float*)(F.ws + WS_GATES), (const unsigned char*)(F.ws + WS_YROWS), (const bf16*)(F.ws + WS_X1), F.out, md, sl, gw, NGW, nrows < 128 ? nrows : 128, lane};
    P10Set A, B;
    p10_issue_row(C, A, 0); __builtin_amdgcn_sched_barrier(0);
#pragma unroll 1
    for (int k = 0; k < C.nrows; k += 2) {
        p10_issue_row(C, B, k + 1); __builtin_amdgcn_sched_barrier(0);
        p10_finish_row(C, A, gnq, k); __builtin_amdgcn_sched_barrier(0);
        p10_issue_row(C, A, k + 2); __builtin_amdgcn_sched_barrier(0);
        p10_finish_row(C, B, gnq, k + 1); __builtin_amdgcn_sched_barrier(0);
    }
}


struct P2Order { pg8::StaticOrder S;
    __device__ bool next(int i, pg8::Unit& u) const { const bool ok = S.next(i, u); if (ok && (u.pn == 4 || u.pn == 6)) u.pn = 10 - u.pn; return ok; }
    __device__ __forceinline__ void a_ready(const pg8::Unit&) const {}
    __device__ __forceinline__ void done(const pg8::Unit&) const {} };
__device__ __forceinline__ void ph2_inproj(Frame& F) {
    pg8::Gemm g{(const pg8::bf16_t*)(F.ws + WS_H), (const pg8::bf16_t*)(F.ws + WS_WINT), NTOK, D_IN, DM, nullptr}; P2Order S; S.S.init(NTOK, D_IN, F.G, (int)blockIdx.x);
    pg8::EpiProj E{(pg8::bf16_t*)(F.ws + WS_Q), (pg8::bf16_t*)(F.ws + WS_K), (pg8::bf16_t*)(F.ws + WS_VT), (pg8::bf16_t*)(F.ws + WS_U), (pg8::bf16_t*)(F.ws + WS_VGT), (float*)(F.ws + WS_VSTAT)};
    pg8::gemm_phase<pg8::EpiProj, P2Order, true, true>(F.lds + RING_OFF, g, S, E);
    { pg8::Unit u2; if (!S.next(1, u2)) {
        const int nlight = 2 * F.G - (NTOK / 256) * (D_IN / 256), first_light = F.G - nlight;
        if (nlight > 0 && (int)blockIdx.x >= first_light) p0_expert_items(F, XI_R0, XI_R1, ((int)blockIdx.x - first_light) * NWAVES + F.wave, nlight * NWAVES);
        else if (nlight <= 0 && blockIdx.x == 0) p0_expert_items(F, XI_R0, XI_R1, F.wave, NWAVES); } }
}
#ifndef PROBE_DUP
#define PROBE_DUP -1
#endif
__device__ __forceinline__ void ph3_mixer(Frame& F) { p3_attn_mfma(F); if (PROBE_DUP == 31) { __syncthreads(); p3_attn_mfma(F); } p3_gmlp_mfma(F); if (PROBE_DUP == 32) p3_gmlp_mfma(F); }
__device__ __forceinline__ void ph4_outproj(Frame& F) {
    pg8::Gemm g{(const pg8::bf16_t*)(F.ws + WS_MIX), (const pg8::bf16_t*)(F.ws + WS_WOUTT), NTOK, DM, DM, nullptr}; pg8::StaticOrder S; S.init(NTOK, DM, F.G, (int)blockIdx.x);
    pg8::EpiDown E{(pg8::bf16_t*)(F.ws + WS_T), 4};
    pg8::gemm_phase<pg8::EpiDown, pg8::StaticOrder, true, true>(F.lds + RING_OFF, g, S, E);
}
__device__ __forceinline__ void ph8_gateup(Frame& F) {
    pg8::Gemm g{(const pg8::bf16_t*)(F.ws + WS_H), (const pg8::bf16_t*)(F.ws + WS_WGUT), NROWS_E, 2 * D_FF, DM / 2, (const int*)(F.ws + WS_IDX)}; pg8::MoeOrder S; S.init(NEXP, 8, 22, F.G, (int)blockIdx.x);
    pg8::EpiSwiGLU8 E{(unsigned char*)(F.ws + WS_HID), 22, W8_INV};
    pg8::Unit u0;
    for (int base = 0; S.next(base, u0); base += 12) { pg8::SubOrder SS{S, base, 12};
        pg8::gemm_phase<pg8::EpiSwiGLU8, pg8::SubOrder, true, true, true, true, PF_DIST, true>(F.lds + RING_OFF, g, SS, E); }
}
__device__ __forceinline__ void ph9_down(Frame& F) {
    pg8::Gemm g{(const pg8::bf16_t*)(F.ws + WS_HID), (const pg8::bf16_t*)(F.ws + WS_WDT), NROWS_E, DM, D_FF / 2, nullptr}; pg8::MoeOrder S; S.init(NEXP, 8, 4, F.G, (int)blockIdx.x);
    pg8::EpiDown8 E{(unsigned char*)(F.ws + WS_YROWS), 4, W8_INV * Y8_SCALE};
    pg8::gemm_phase<pg8::EpiDown8, pg8::MoeOrder, true, true, true, false, PF_DIST, true>(F.lds + RING_OFF, g, S, E);
}
constexpr int NPHASES = 11;
#ifndef MK_N_LAUNCHES
#define MK_N_LAUNCHES 1
#endif
struct Args { const float* in[21]; float* out; unsigned char* ws; int ph_lo, ph_hi, li, pad; };
__global__ void __launch_bounds__(NWAVES * 64, 2) hymba_fwd(Args args) {
    extern __shared__ __attribute__((aligned(16))) unsigned char lds[];
    Frame F;
    F.lds = (LAS unsigned char*)lds;
    F.MISC = (volatile LAS unsigned*)(F.lds + MISC_OFF);
    F.tid = threadIdx.x; F.lane = F.tid & 63; F.wave = __builtin_amdgcn_readfirstlane(F.tid >> 6);
    F.G = gridDim.x; { const int bx = blockIdx.x; F.vcu = (F.G % 8 == 0) ? (bx % 8) * (F.G / 8) + bx / 8 : bx; }
#pragma unroll
    for (int i = 0; i < 21; ++i) F.in[i] = args.in[i];
    F.out = args.out; F.ws = args.ws; F.ctl = (gu32*)(args.ws + WS_CTL);
    for (int u = F.tid; u < (LDS_BYTES - LDSCTL_OFF) / 4; u += NWAVES * 64) ((LAS unsigned*)(F.lds + LDSCTL_OFF))[u] = 0u;
    __syncthreads();
    XcdBarrier bar; bar.bar = (unsigned*)(F.ctl + CW_BAR); bar.x = 0; bar.st = nullptr;
    const bool one_launch = (args.ph_hi - args.ph_lo) > 1;
    if (one_launch) bar = xcd_barrier_post((unsigned*)(F.ctl + CW_BAR), F.MISC + 8);
    const int lo = args.ph_lo, hi = args.ph_hi;
#ifndef PHASE_MASK
#define PHASE_MASK 0x7ff
#endif
#define IN(k) (((PHASE_MASK >> (k)) & 1) && lo <= (k) && (k) < hi)
#define BOTH(k) (IN(k) && IN((k) + 1))
#define GRID_BAR() xcd_barrier(bar)
#ifndef PROBE_DUP
#define PROBE_DUP -1
#endif
#define PHASE(k, call) if (IN(k)) { call; if (PROBE_DUP == (k)) { GRID_BAR(); call; } if (BOTH(k)) GRID_BAR(); }
    if (IN(0)) { p0_prologue(F); if (PROBE_DUP == 0) { GRID_BAR(); p0_prologue(F); } }
    PHASE(1, p1_prenorm(F))
    PHASE(2, ph2_inproj(F))
    PHASE(3, ph3_mixer(F))
    PHASE(4, ph4_outproj(F))
    PHASE(5, p5_postmix(F))
    PHASE(6, p6_topk(F))
    PHASE(8, ph8_gateup(F))
    PHASE(9, ph9_down(F))
    if (IN(10)) { if (PROBE_DUP == 10) { p9_combine<P10_MODE>(F); GRID_BAR(); } p9_combine<0>(F); }
#undef PHASE
#undef IN
#undef BOTH
#undef GRID_BAR
}

extern "C" void kernel_launch(void* const* d_in, const int* in_sizes, int n_in, void* d_out, int out_size, void* d_ws, size_t ws_size, hipStream_t stream) {
    static int grid = 0;
    if (grid == 0) {
        if (n_in != 21 || out_size != NTOK * DM || ws_size < WS_END) { fprintf(stderr, "kernel_launch: unexpected shapes (n_in %d out %d ws %zu)\n", n_in, out_size, ws_size); grid = -1; return; }
        int dev = 0, cus = 0;
        if (hipGetDevice(&dev) != hipSuccess || hipDeviceGetAttribute(&cus, hipDeviceAttributeMultiprocessorCount, dev) != hipSuccess) { grid = -1; return; }
        if (hipFuncSetAttribute((const void*)hymba_fwd, hipFuncAttributeMaxDynamicSharedMemorySize, LDS_BYTES) != hipSuccess) { fprintf(stderr, "kernel_launch: hipFuncSetAttribute failed\n"); grid = -1; return; }
        int per_cu = 0;
        if (hipOccupancyMaxActiveBlocksPerMultiprocessor(&per_cu, (const void*)hymba_fwd, NWAVES * 64, LDS_BYTES) != hipSuccess || per_cu < 1) fprintf(stderr, "kernel_launch: occupancy query reports %d\n", per_cu);
        (void)hipGetLastError();
        grid = cus;
    }
    if (grid < 0) return;
    (void)hipMemsetAsync((char*)d_ws + WS_CTL, 0, CTL_ZERO_BYTES, stream);
    Args a{};
    for (int i = 0; i < 21; ++i) a.in[i] = (const float*)d_in[i];
    a.out = (float*)d_out; a.ws = (unsigned char*)d_ws;
    if (MK_N_LAUNCHES == 1) { a.ph_lo = 0; a.ph_hi = NPHASES; a.li = 0; hipLaunchKernelGGL(hymba_fwd, dim3(grid), dim3(NWAVES * 64), LDS_BYTES, stream, a); }
    else for (int li = 0; li < NPHASES; ++li) { a.ph_lo = li; a.ph_hi = li + 1; a.li = li; hipLaunchKernelGGL(hymba_fwd, dim3(grid), dim3(NWAVES * 64), LDS_BYTES, stream, a); }
}
```
